# Optimizing an MI355X kernel written in HIP

```python
import math
import jax, jax.numpy as jnp
from jax import lax
import numpy as np

D_MODEL = 2048
BATCH = 4
SEQ = 4096
DEPTH = 2

N_MIXERS = 2
CHUNK = 128
D_FFN_A = 4 * D_MODEL
D_HALF_A = D_FFN_A // 2
N_GROUPS_A = 16
D_GROUP_A = D_HALF_A // N_GROUPS_A
POOL_WINDOWS = (2, 4, 8, 16)
N_GROUPS_B = len(POOL_WINDOWS)
D_MIX_B = D_MODEL
D_GROUP_B = D_MIX_B // N_GROUPS_B
N_KEYS = 128
N_EXPERTS = N_KEYS * N_KEYS
PEER_HEADS = 8
D_KEY = 128
D_QUERY = 2 * D_KEY
TOPK_HALF = 16
TOPK = 16
PEER_BLOCK = 64
N_A_LAYERS = (DEPTH + 1) // 2
N_B_LAYERS = DEPTH // 2
ALPHA = (2 * DEPTH) ** 0.25
BETA = (8 * DEPTH) ** -0.25
LN_EPS = 1e-5

kernel_name = 'hybrid_gmlp_pool_peer_deepnorm'


def layer_norm(x, g, b):
    xf = x.astype(jnp.float32)
    mu = jnp.mean(xf, axis=-1, keepdims=True)
    xc = xf - mu
    var = jnp.mean(xc * xc, axis=-1, keepdims=True)
    y = xc * lax.rsqrt(var + LN_EPS) * g.astype(jnp.float32) + b.astype(jnp.float32)
    return y.astype(x.dtype)


def mixer_gmlp_chunked(x, w_in, b_in, v_g, v_b, w_s, b_s, w_out):
    B, S, _ = x.shape
    z = jax.nn.gelu(x @ w_in + b_in)
    u, v = z[..., :D_HALF_A], z[..., D_HALF_A:]
    v = layer_norm(v, v_g, v_b)
    v = v.reshape(B, S // CHUNK, CHUNK, N_GROUPS_A, D_GROUP_A)
    causal = jnp.tril(jnp.ones((CHUNK, CHUNK), dtype=bool))
    ws = jnp.where(causal[None], w_s, 0.0)
    sv = jnp.einsum('hts,bcshd->bcthd', ws, v) + b_s.T[None, None, :, :, None]
    gated = u * sv.reshape(B, S, D_HALF_A)
    return gated @ w_out


def mixer_pool_multiscale(x, w_in, w_grp, b_grp, scale, w_out):
    B, S, _ = x.shape
    h = (x @ w_in).reshape(B, S, N_GROUPS_B, D_GROUP_B)
    c = lax.cumsum(h.astype(jnp.float32), axis=1)
    pos = jnp.arange(S)
    pooled = []
    for g, w in enumerate(POOL_WINDOWS):
        cg = c[:, :, g]
        shifted = jnp.pad(cg, ((0, 0), (w, 0), (0, 0)))[:, :S]
        count = jnp.minimum(pos + 1, w).astype(jnp.float32)[None, :, None]
        pooled.append((cg - shifted) / count)
    pooled = jnp.stack(pooled, axis=2).astype(x.dtype) - h
    mixed = jnp.einsum('bsgc,gcd->bsgd', pooled, w_grp) + b_grp
    return (mixed.reshape(B, S, D_MIX_B) * scale) @ w_out


def peer_ffn(x, wq, subkeys, u_tab, v_tab):
    B, S, D = x.shape
    nb = S // PEER_BLOCK
    xb = x.reshape(B, nb, PEER_BLOCK, D).transpose(1, 0, 2, 3)

    def block(xc):
        q = (xc @ wq).reshape(B, PEER_BLOCK, PEER_HEADS, 2, D_KEY)
        s = jnp.einsum('bthpk,pnk->bthpn', q, subkeys).astype(jnp.float32)
        s1, i1 = lax.top_k(s[..., 0, :], TOPK_HALF)
        s2, i2 = lax.top_k(s[..., 1, :], TOPK_HALF)
        n_cand = TOPK_HALF * TOPK_HALF
        cand_s = (s1[..., :, None] + s2[..., None, :]).reshape(B, PEER_BLOCK, PEER_HEADS, n_cand)
        cand_i = (i1[..., :, None] * N_KEYS + i2[..., None, :]).reshape(B, PEER_BLOCK, PEER_HEADS, n_cand)
        top_s, sel = lax.top_k(cand_s, TOPK)
        eidx = jnp.take_along_axis(cand_i, sel, axis=-1)
        gate = jax.nn.softmax(top_s, axis=-1)
        u = u_tab[eidx]
        pre = jnp.einsum('btd,bthkd->bthk', xc, u)
        act = (gate * jax.nn.gelu(pre.astype(jnp.float32))).astype(xc.dtype)
        v = v_tab[eidx]
        return jnp.einsum('bthk,bthkd->btd', act, v)

    y = lax.map(block, xb)
    return y.transpose(1, 0, 2, 3).reshape(B, S, D)


def setup_inputs(seed: int = 0) -> dict:
    key = jax.random.key(seed)
    ks = jax.random.split(key, 24)
    f32 = jnp.float32
    nrm = lambda k, shp: jax.random.normal(k, shp, dtype=f32)
    x = nrm(ks[0], (BATCH, SEQ, D_MODEL))
    a_w_in = nrm(ks[1], (N_A_LAYERS, D_MODEL, D_FFN_A)) * D_MODEL ** -0.5
    a_b_in = 0.02 * nrm(ks[2], (N_A_LAYERS, D_FFN_A))
    a_v_g = 1.0 + 0.02 * nrm(ks[3], (N_A_LAYERS, D_HALF_A))
    a_v_b = 0.02 * nrm(ks[4], (N_A_LAYERS, D_HALF_A))
    a_w_s = nrm(ks[5], (N_A_LAYERS, N_GROUPS_A, CHUNK, CHUNK)) * CHUNK ** -0.5
    a_b_s = 1.0 + 0.02 * nrm(ks[6], (N_A_LAYERS, N_GROUPS_A, CHUNK))
    a_w_out = nrm(ks[7], (N_A_LAYERS, D_HALF_A, D_MODEL)) * (D_HALF_A ** -0.5 * BETA)
    b_w_in = nrm(ks[8], (N_B_LAYERS, D_MODEL, D_MIX_B)) * D_MODEL ** -0.5
    b_w_grp = nrm(ks[9], (N_B_LAYERS, N_GROUPS_B, D_GROUP_B, D_GROUP_B)) * D_GROUP_B ** -0.5
    b_b_grp = 0.02 * nrm(ks[10], (N_B_LAYERS, N_GROUPS_B, D_GROUP_B))
    b_scale = 1.0 + 0.02 * nrm(ks[11], (N_B_LAYERS, D_MIX_B))
    b_w_out = nrm(ks[12], (N_B_LAYERS, D_MIX_B, D_MODEL)) * (D_MIX_B ** -0.5 * BETA)
    ln_mix_g = 1.0 + 0.02 * nrm(ks[13], (DEPTH, D_MODEL))
    ln_mix_b = 0.02 * nrm(ks[14], (DEPTH, D_MODEL))
    ln_ffn_g = 1.0 + 0.02 * nrm(ks[15], (DEPTH, D_MODEL))
    ln_ffn_b = 0.02 * nrm(ks[16], (DEPTH, D_MODEL))
    peer_wq = nrm(ks[17], (DEPTH, D_MODEL, PEER_HEADS * D_QUERY)) * D_MODEL ** -0.5
    peer_subkeys = nrm(ks[18], (DEPTH, 2, N_KEYS, D_KEY)) * D_KEY ** -0.5
    peer_u = nrm(ks[19], (DEPTH, N_EXPERTS, D_MODEL)) * D_MODEL ** -0.5
    peer_v = nrm(ks[20], (DEPTH, N_EXPERTS, D_MODEL)) * BETA
    return {'x': x, 'a_w_in': a_w_in, 'a_b_in': a_b_in, 'a_v_g': a_v_g, 'a_v_b': a_v_b,
            'a_w_s': a_w_s, 'a_b_s': a_b_s, 'a_w_out': a_w_out,
            'b_w_in': b_w_in, 'b_w_grp': b_w_grp, 'b_b_grp': b_b_grp, 'b_scale': b_scale, 'b_w_out': b_w_out,
            'ln_mix_g': ln_mix_g, 'ln_mix_b': ln_mix_b, 'ln_ffn_g': ln_ffn_g, 'ln_ffn_b': ln_ffn_b,
            'peer_wq': peer_wq, 'peer_subkeys': peer_subkeys, 'peer_u': peer_u, 'peer_v': peer_v}


def reference(x, a_w_in, a_b_in, a_v_g, a_v_b, a_w_s, a_b_s, a_w_out,
              b_w_in, b_w_grp, b_b_grp, b_scale, b_w_out,
              ln_mix_g, ln_mix_b, ln_ffn_g, ln_ffn_b,
              peer_wq, peer_subkeys, peer_u, peer_v):
    for i in range(DEPTH):
        j = i // N_MIXERS
        if i % N_MIXERS == 0:
            mix = mixer_gmlp_chunked(x, a_w_in[j], a_b_in[j], a_v_g[j], a_v_b[j],
                                     a_w_s[j], a_b_s[j], a_w_out[j])
        else:
            mix = mixer_pool_multiscale(x, b_w_in[j], b_w_grp[j], b_b_grp[j], b_scale[j], b_w_out[j])
        x = layer_norm(ALPHA * x + mix, ln_mix_g[i], ln_mix_b[i])
        ffn = peer_ffn(x, peer_wq[i], peer_subkeys[i], peer_u[i], peer_v[i])
        x = layer_norm(ALPHA * x + ffn, ln_ffn_g[i], ln_ffn_b[i])
    return x
```

```cpp
#include <hip/hip_runtime.h>
#include <cstdio>
#include <cstdint>

#ifndef MK_PER_PHASE
#define MK_PER_PHASE 0
#endif

namespace pg8 {
#define PG8_LAS __attribute__((address_space(3)))
#define PG8_GAS __attribute__((address_space(1)))
typedef unsigned short bf16_t;
typedef short bf16x8 __attribute__((ext_vector_type(8)));
typedef float f32x4 __attribute__((ext_vector_type(4)));
typedef float f32x2 __attribute__((ext_vector_type(2)));
typedef unsigned u32x4 __attribute__((ext_vector_type(4)));
constexpr int BM = 256, BK = 64, HALF = 128, HTB = HALF * BK * 2  , STAGE_BYTES = 8 * HTB, NXCD = 8, WGM = 8;

__host__ __device__ __forceinline__ int lds_byte(int r, int c) { const int st = (r >> 4) * 2 + (c >> 5), rr = r & 15, cc = c & 31, ob = rr * 64 + cc * 2; return st * 1024 + (ob ^ (((ob >> 9) & 1) << 5)); }
__host__ __device__ __forceinline__ void stage_rc(int b, int& R, int& C) { const int st = b / 1024, sb = b % 1024, swz = sb ^ (((sb >> 9) & 1) << 5); R = (st >> 1) * 16 + swz / 64; C = (st & 1) * 32 + (swz % 64) / 2; }
__host__ __device__ __forceinline__ int perm32(int rho) { const int n = rho >> 4, i = rho & 15; return 8 * (i >> 2) + 4 * n + (i & 3); }

typedef int i32x8 __attribute__((ext_vector_type(8)));
typedef int i32x4v __attribute__((ext_vector_type(4)));
__device__ __forceinline__ i32x8 pk32(bf16x8 a, bf16x8 b) { return __builtin_shufflevector(__builtin_bit_cast(i32x4v, a), __builtin_bit_cast(i32x4v, b), 0, 1, 2, 3, 4, 5, 6, 7); }
struct Unit { int pm, pn; };

struct StaticOrder {
    int nM, nN, nwg, G, c;
    __host__ __device__ void init(int M, int N, int G_, int c_) { nM = M / BM; nN = N / BM; nwg = nM * nN; G = G_; c = c_; }
    __host__ __device__ bool next(int i, Unit& u) const {
        const long L = (long)i * G + c; if (L >= nwg) return false;
        int wgid = (int)L; { const int q = nwg / NXCD, r = nwg % NXCD, xcd = wgid % NXCD, off = wgid / NXCD; wgid = (xcd < r ? xcd * (q + 1) : r * (q + 1) + (xcd - r) * q) + off; }
        const int nig = WGM * nN, gid = wgid / nig, fm = gid * WGM, gsz = (nM - fm) < WGM ? (nM - fm) : WGM;
        u.pm = fm + ((wgid % nig) % gsz); u.pn = (wgid % nig) / gsz; return true;
    }
    __device__ __forceinline__ void a_ready(const Unit&) const {}
    __device__ __forceinline__ void done(const Unit&) const {}
};

struct AddrPlain { const bf16_t* A; const bf16_t* Bt; int lda, ldb, K;
    __device__ __forceinline__ const char* a(const Unit& u) const { return (const char*)(A + (size_t)u.pm * BM * lda); }
    __device__ __forceinline__ const char* b(const Unit& u) const { return (const char*)(Bt + (size_t)u.pn * BM * ldb); } };
struct AddrPlain8 { const unsigned char* A; const unsigned char* Bt; int lda, ldb, K;
    __device__ __forceinline__ const char* a(const Unit& u) const { return (const char*)(A + (size_t)u.pm * BM * lda); }
    __device__ __forceinline__ const char* b(const Unit& u) const { return (const char*)(Bt + (size_t)u.pn * BM * ldb); } };
struct AddrSpatial { const bf16_t* BD; const bf16_t* VNT; int lda, ldb, K;
    __device__ __forceinline__ const char* a(const Unit& u) const { return (const char*)(BD + (size_t)u.pn * 65536); }
    __device__ __forceinline__ const char* b(const Unit& u) const { return (const char*)(VNT + (size_t)u.pn * 256 * 16384 + (size_t)u.pm * 256); } };
struct AddrScores { const bf16_t* BDsk; const bf16_t* Q; int lda, ldb, K;
    __device__ __forceinline__ const char* a(const Unit& u) const { return (const char*)(BDsk + (size_t)(u.pm >> 3) * 65536); }
    __device__ __forceinline__ const char* b(const Unit& u) const { return (const char*)(Q + (size_t)(u.pm >> 3) * 2048 * 2048 + (size_t)u.pn * 256 * 2048 + (size_t)(u.pm & 7) * 256); } };
struct AddrGrouped { const bf16_t* P; const bf16_t* BgT; int lda, ldb, K;
    __device__ __forceinline__ const char* a(const Unit& u) const { return (const char*)(P + (size_t)u.pm * 256 * 2048 + (size_t)(u.pn >> 1) * 512); }
    __device__ __forceinline__ const char* b(const Unit& u) const { return (const char*)(BgT + (size_t)(u.pn >> 1) * 512 * 512 + (size_t)(u.pn & 1) * 256 * 512); } };

__device__ __forceinline__ unsigned cvt_pk_bf16(float lo, float hi) { unsigned r; asm volatile("v_cvt_pk_bf16_f32 %0, %1, %2" : "=v"(r) : "v"(lo), "v"(hi)); return r; }
__device__ __forceinline__ float gelu_tanh(float v) {
    const float y2 = v * (1.5957691216f + 0.0713548163f * v * v);
    const float e = __builtin_amdgcn_exp2f(-1.4426950409f * y2);
    return v * __builtin_amdgcn_rcpf(1.0f + e);
}
__device__ __forceinline__ f32x4 gelu4(f32x4 v) { return (f32x4){gelu_tanh(v[0]), gelu_tanh(v[1]), gelu_tanh(v[2]), gelu_tanh(v[3])}; }
__device__ __forceinline__ u32x4 pack8(f32x4 v0, f32x4 v1) { u32x4 w; w.x = cvt_pk_bf16(v0[0], v0[1]); w.y = cvt_pk_bf16(v0[2], v0[3]); w.z = cvt_pk_bf16(v1[0], v1[1]); w.w = cvt_pk_bf16(v1[2], v1[3]); return w; }

typedef unsigned u32x2p __attribute__((ext_vector_type(2)));
__device__ __forceinline__ u32x4 pair16(u32x2p x, u32x2p y) {
    const auto s0 = __builtin_amdgcn_permlane16_swap(x.x, y.x, false, false), s1 = __builtin_amdgcn_permlane16_swap(x.y, y.y, false, false);
    return (u32x4){s0[0], s1[0], s0[1], s1[1]};
}
__device__ __forceinline__ void unpair16(u32x4 l, u32x2p& x, u32x2p& y) {
    const auto s0 = __builtin_amdgcn_permlane16_swap(l.x, l.z, false, false), s1 = __builtin_amdgcn_permlane16_swap(l.y, l.w, false, false);
    x = (u32x2p){s0[0], s1[0]}; y = (u32x2p){s0[1], s1[1]};
}
__device__ __forceinline__ u32x2p pk8_fp8(f32x4 v0, f32x4 v1) {
    int w0 = 0, w1 = 0;
    w0 = __builtin_amdgcn_cvt_pk_fp8_f32(__builtin_amdgcn_fmed3f(v0[0], -448.f, 448.f), __builtin_amdgcn_fmed3f(v0[1], -448.f, 448.f), w0, false);
    w0 = __builtin_amdgcn_cvt_pk_fp8_f32(__builtin_amdgcn_fmed3f(v0[2], -448.f, 448.f), __builtin_amdgcn_fmed3f(v0[3], -448.f, 448.f), w0, true);
    w1 = __builtin_amdgcn_cvt_pk_fp8_f32(__builtin_amdgcn_fmed3f(v1[0], -448.f, 448.f), __builtin_amdgcn_fmed3f(v1[1], -448.f, 448.f), w1, false);
    w1 = __builtin_amdgcn_cvt_pk_fp8_f32(__builtin_amdgcn_fmed3f(v1[2], -448.f, 448.f), __builtin_amdgcn_fmed3f(v1[3], -448.f, 448.f), w1, true);
    return (u32x2p){(unsigned)w0, (unsigned)w1};
}
__device__ __forceinline__ float bf_lo(unsigned w) { return __builtin_bit_cast(float, w << 16); }
__device__ __forceinline__ float bf_hi(unsigned w) { return __builtin_bit_cast(float, w & 0xffff0000u); }

template <int ACT, bool IACC = false> struct EpiBf16 {
    static constexpr bool PERM = true, AFTER_DRAIN = false;
    bf16_t* O; int ldc; const float* cbias; const float* rbias; const float* cscale; float ascale = 1.0f;
    const float* rs = nullptr; const float* cs = nullptr;
    __device__ __forceinline__ void operator()(const f32x4 (&acc)[2][2][4][2], const Unit& u, int wr, int wc, int fr, int fq) const {
        const int row0 = u.pm * BM + wr * 64 + fr, col0 = u.pn * BM + wc * 32 + 8 * fq;
        f32x4 bv[2][2], sv[2][2], cv[2][2]; float rsc[2][4], rb[2][4];
#pragma unroll
        for (int bj = 0; bj < 2; ++bj)
#pragma unroll
            for (int n = 0; n < 2; ++n) { bv[bj][n] = cbias ? *(const PG8_GAS f32x4*)(cbias + col0 + bj * HALF + 4 * n) : (f32x4){0.f, 0.f, 0.f, 0.f};
                                          sv[bj][n] = cscale ? *(const PG8_GAS f32x4*)(cscale + col0 + bj * HALF + 4 * n) : (f32x4){1.f, 1.f, 1.f, 1.f};
                                          cv[bj][n] = cs ? *(const PG8_GAS f32x4*)(cs + col0 + bj * HALF + 4 * n) : (f32x4){1.f, 1.f, 1.f, 1.f}; }
#pragma unroll
        for (int ai = 0; ai < 2; ++ai)
#pragma unroll
            for (int m = 0; m < 4; ++m) { const int r = row0 + ai * HALF + m * 16; rsc[ai][m] = (rs ? ((const PG8_GAS float*)rs)[r] : 1.0f) * ascale; rb[ai][m] = rbias ? ((const PG8_GAS float*)rbias)[r] : 0.f; }
#pragma unroll
        for (int ai = 0; ai < 2; ++ai)
#pragma unroll
            for (int m = 0; m < 4; ++m) { const int r = row0 + ai * HALF + m * 16; PG8_GAS bf16_t* rowp = (PG8_GAS bf16_t*)O + (size_t)r * ldc + col0;
#pragma unroll
                for (int bj = 0; bj < 2; ++bj) { f32x4 a0 = acc[ai][bj][m][0], a1 = acc[ai][bj][m][1];
                    if (IACC) { a0 = __builtin_convertvector(__builtin_bit_cast(i32x4v, a0), f32x4); a1 = __builtin_convertvector(__builtin_bit_cast(i32x4v, a1), f32x4); }
                    f32x4 v0 = a0 * (cv[bj][0] * rsc[ai][m]) + bv[bj][0] + rb[ai][m], v1 = a1 * (cv[bj][1] * rsc[ai][m]) + bv[bj][1] + rb[ai][m];
                    if (ACT == 1) { v0 = gelu4(v0); v1 = gelu4(v1); }
                    v0 = v0 * sv[bj][0]; v1 = v1 * sv[bj][1];
                    *(PG8_GAS u32x4*)(rowp + bj * HALF) = pack8(v0, v1); } }
    }
};
struct EpiF32 {
    static constexpr bool PERM = false, AFTER_DRAIN = false;
    float* C; int ldc;
    __device__ __forceinline__ void operator()(const f32x4 (&acc)[2][2][4][2], const Unit& u, int wr, int wc, int fr, int fq) const {
        const int row0 = u.pm * BM + wr * 64 + fr, col0 = u.pn * BM + wc * 32 + 4 * fq;
#pragma unroll
        for (int ai = 0; ai < 2; ++ai)
#pragma unroll
            for (int m = 0; m < 4; ++m) { float* rowp = C + (size_t)(row0 + ai * HALF + m * 16) * ldc + col0;
#pragma unroll
                for (int bj = 0; bj < 2; ++bj)
#pragma unroll
                    for (int n = 0; n < 2; ++n) *(f32x4*)(rowp + bj * HALF + n * 16) = acc[ai][bj][m][n]; }
    }
};
template <bool RBF> struct EpiRes {
    static constexpr bool PERM = true, AFTER_DRAIN = false;
    bf16_t* Y; const void* R; int ldc; float alpha; float ascale = 1.0f;
    __device__ __forceinline__ void operator()(const f32x4 (&acc)[2][2][4][2], const Unit& u, int wr, int wc, int fr, int fq) const {
        const int row0 = u.pm * BM + wr * 64 + fr, col0 = u.pn * BM + wc * 32 + 8 * fq;
#pragma unroll
        for (int ai = 0; ai < 2; ++ai) {
            f32x4 rv[4][2][2];
#pragma unroll
            for (int m = 0; m < 4; ++m) { const size_t off = (size_t)(row0 + ai * HALF + m * 16) * ldc + col0;
#pragma unroll
                for (int bj = 0; bj < 2; ++bj) {
                    if constexpr (RBF) { const u32x4 w = *(const PG8_GAS u32x4*)((const bf16_t*)R + off + bj * HALF);
                        rv[m][bj][0] = (f32x4){__builtin_bit_cast(float, w.x << 16), __builtin_bit_cast(float, w.x & 0xffff0000u), __builtin_bit_cast(float, w.y << 16), __builtin_bit_cast(float, w.y & 0xffff0000u)};
                        rv[m][bj][1] = (f32x4){__builtin_bit_cast(float, w.z << 16), __builtin_bit_cast(float, w.z & 0xffff0000u), __builtin_bit_cast(float, w.w << 16), __builtin_bit_cast(float, w.w & 0xffff0000u)}; }
                    else { rv[m][bj][0] = *(const PG8_GAS f32x4*)((const float*)R + off + bj * HALF); rv[m][bj][1] = *(const PG8_GAS f32x4*)((const float*)R + off + bj * HALF + 4); } } }
#pragma unroll
            for (int m = 0; m < 4; ++m) { const size_t off = (size_t)(row0 + ai * HALF + m * 16) * ldc + col0;
#pragma unroll
                for (int bj = 0; bj < 2; ++bj) *(PG8_GAS u32x4*)(Y + off + bj * HALF) = pack8(rv[m][bj][0] * alpha + acc[ai][bj][m][0] * ascale, rv[m][bj][1] * alpha + acc[ai][bj][m][1] * ascale); } }
    }
};
struct EpiGate {
    static constexpr bool PERM = true, AFTER_DRAIN = false;
    bf16_t* UG; int ldc; const float* bs;
    __device__ __forceinline__ void operator()(const f32x4 (&acc)[2][2][4][2], const Unit& u, int wr, int wc, int fr, int fq) const {
        const int row0 = u.pm * BM + wr * 64 + fr, col0 = u.pn * BM + wc * 32 + 8 * fq;
#pragma unroll
        for (int ai = 0; ai < 2; ++ai)
#pragma unroll
            for (int m = 0; m < 4; ++m) { const int r = row0 + ai * HALF + m * 16; bf16_t* rowp = UG + (size_t)r * ldc + col0; const float rb = bs[u.pn * 128 + (r & 127)];
#pragma unroll
                for (int bj = 0; bj < 2; ++bj) { const u32x4 uu = *(const u32x4*)(rowp + bj * HALF);
                    f32x4 v0 = acc[ai][bj][m][0] + rb, v1 = acc[ai][bj][m][1] + rb;
                    v0 = v0 * (f32x4){bf_lo(uu.x), bf_hi(uu.x), bf_lo(uu.y), bf_hi(uu.y)}; v1 = v1 * (f32x4){bf_lo(uu.z), bf_hi(uu.z), bf_lo(uu.w), bf_hi(uu.w)};
                    *(u32x4*)(rowp + bj * HALF) = pack8(v0, v1); } }
    }
};

struct EpiFp8 {
    static constexpr bool PERM = true, AFTER_DRAIN = false;
    unsigned char* O; int ldc; const float* cbias; const float* cscale; float oscale;
    __device__ __forceinline__ void operator()(const f32x4 (&acc)[2][2][4][2], const Unit& u, int wr, int wc, int fr, int fq) const {
        const int row0 = u.pm * BM + wr * 64 + fr, col0 = u.pn * BM + wc * 32 + 8 * fq, odd = fq & 1;
        f32x4 bv[2][2], sv[2][2];
#pragma unroll
        for (int bj = 0; bj < 2; ++bj)
#pragma unroll
            for (int n = 0; n < 2; ++n) { bv[bj][n] = *(const PG8_GAS f32x4*)(cbias + col0 + bj * HALF + 4 * n); sv[bj][n] = *(const PG8_GAS f32x4*)(cscale + col0 + bj * HALF + 4 * n) * oscale; }
#pragma unroll
        for (int ai = 0; ai < 2; ++ai)
#pragma unroll
            for (int mp = 0; mp < 2; ++mp) { const int r = row0 + ai * HALF + mp * 32 + 16 * odd;
#pragma unroll
                for (int bj = 0; bj < 2; ++bj) {
                    const u32x2p x = pk8_fp8((acc[ai][bj][2 * mp][0] + bv[bj][0]) * sv[bj][0], (acc[ai][bj][2 * mp][1] + bv[bj][1]) * sv[bj][1]);
                    const u32x2p y = pk8_fp8((acc[ai][bj][2 * mp + 1][0] + bv[bj][0]) * sv[bj][0], (acc[ai][bj][2 * mp + 1][1] + bv[bj][1]) * sv[bj][1]);
                    *(PG8_GAS u32x4*)(O + (size_t)r * ldc + col0 - 8 * odd + bj * HALF) = pair16(x, y); } }
    }
};
struct EpiGeluFp8 {
    static constexpr bool PERM = true, AFTER_DRAIN = false;
    unsigned char* O; int ldc; const float* cbias; const float* rs; float ascale; float oscale;
    __device__ __forceinline__ void operator()(const f32x4 (&acc)[2][2][4][2], const Unit& u, int wr, int wc, int fr, int fq) const {
        const int row0 = u.pm * BM + wr * 64 + fr, col0 = u.pn * BM + wc * 32 + 8 * fq, odd = fq & 1;
        f32x4 bv[2][2]; float rsc[2][4];
#pragma unroll
        for (int bj = 0; bj < 2; ++bj)
#pragma unroll
            for (int n = 0; n < 2; ++n) bv[bj][n] = *(const PG8_GAS f32x4*)(cbias + col0 + bj * HALF + 4 * n);
#pragma unroll
        for (int ai = 0; ai < 2; ++ai)
#pragma unroll
            for (int m = 0; m < 4; ++m) rsc[ai][m] = ((const PG8_GAS float*)rs)[row0 + ai * HALF + m * 16] * ascale;
#pragma unroll
        for (int ai = 0; ai < 2; ++ai)
#pragma unroll
            for (int mp = 0; mp < 2; ++mp) { const int r = row0 + ai * HALF + mp * 32 + 16 * odd;
#pragma unroll
                for (int bj = 0; bj < 2; ++bj) { u32x2p xy[2];
#pragma unroll
                    for (int h = 0; h < 2; ++h) { const int m = 2 * mp + h;
                        f32x4 v0 = __builtin_convertvector(__builtin_bit_cast(i32x4v, acc[ai][bj][m][0]), f32x4) * rsc[ai][m] + bv[bj][0], v1 = __builtin_convertvector(__builtin_bit_cast(i32x4v, acc[ai][bj][m][1]), f32x4) * rsc[ai][m] + bv[bj][1];
                        xy[h] = pk8_fp8(gelu4(v0) * oscale, gelu4(v1) * oscale); }
                    *(PG8_GAS u32x4*)(O + (size_t)r * ldc + col0 - 8 * odd + bj * HALF) = pair16(xy[0], xy[1]); } }
    }
};
struct EpiGate8 {
    static constexpr bool PERM = true, AFTER_DRAIN = false;
    const unsigned char* U; unsigned char* GF; int ldc; const float* bs; float gscale;
    __device__ __forceinline__ void operator()(const f32x4 (&acc)[2][2][4][2], const Unit& u, int wr, int wc, int fr, int fq) const {
        const int row0 = u.pm * BM + wr * 64 + fr, col0 = u.pn * BM + wc * 32 + 8 * fq, odd = fq & 1;
        u32x4 ul[2][2][2]; float rb[2][4];
#pragma unroll
        for (int ai = 0; ai < 2; ++ai) {
#pragma unroll
            for (int m = 0; m < 4; ++m) rb[ai][m] = ((const PG8_GAS float*)bs)[u.pn * 128 + ((row0 + ai * HALF + m * 16) & 127)];
#pragma unroll
            for (int mp = 0; mp < 2; ++mp)
#pragma unroll
                for (int bj = 0; bj < 2; ++bj) ul[ai][mp][bj] = *(const PG8_GAS u32x4*)(U + (size_t)(row0 + ai * HALF + mp * 32 + 16 * odd) * ldc + col0 - 8 * odd + bj * HALF); }
#pragma unroll
        for (int ai = 0; ai < 2; ++ai)
#pragma unroll
            for (int mp = 0; mp < 2; ++mp) { const int r = row0 + ai * HALF + mp * 32 + 16 * odd;
#pragma unroll
                for (int bj = 0; bj < 2; ++bj) { u32x2p ux[2], gx[2]; unpair16(ul[ai][mp][bj], ux[0], ux[1]);
#pragma unroll
                    for (int h = 0; h < 2; ++h) { const int m = 2 * mp + h;
                        f32x4 v0 = acc[ai][bj][m][0] + rb[ai][m], v1 = acc[ai][bj][m][1] + rb[ai][m];
                        const auto u01 = __builtin_amdgcn_cvt_pk_f32_fp8((int)ux[h].x, false), u23 = __builtin_amdgcn_cvt_pk_f32_fp8((int)ux[h].x, true), u45 = __builtin_amdgcn_cvt_pk_f32_fp8((int)ux[h].y, false), u67 = __builtin_amdgcn_cvt_pk_f32_fp8((int)ux[h].y, true);
                        gx[h] = pk8_fp8(v0 * (f32x4){u01[0], u01[1], u23[0], u23[1]} * gscale, v1 * (f32x4){u45[0], u45[1], u67[0], u67[1]} * gscale); }
                    *(PG8_GAS u32x4*)(GF + (size_t)r * ldc + col0 - 8 * odd + bj * HALF) = pair16(gx[0], gx[1]); } }
    }
};

template <class Epi, class Addr, class Sched, bool ALIGN_EPI = false, bool SP2 = false, int MODE = 0  >
__device__ __forceinline__ void gemm_phase(PG8_LAS unsigned char* lds, const Addr& g, const Sched& S, const Epi& E, const int tid  ) {
    const int wid = __builtin_amdgcn_readfirstlane(tid >> 6), lane = tid & 63, wr = wid >> 2, wc = wid & 3, fr = lane & 15, fq = lane >> 4;
    constexpr bool FP8 = MODE == 1, I8 = MODE == 2; constexpr int ES = MODE ? 1 : 2;
    const int K = g.K, nt = K / (BK * 2 / ES);
    unsigned voffA[2], voffB[2];
#pragma unroll
    for (int i = 0; i < 2; ++i) { int R, C; stage_rc(tid * 16 + i * 8192, R, C); const int Rb = Epi::PERM ? ((R & ~31) + perm32(R & 31)) : R;
        voffA[i] = (unsigned)(R * g.lda * ES + C * 2); voffB[i] = (unsigned)(Rb * g.ldb * ES + C * 2); }
    const size_t kstep = (size_t)(BK * 2);
    const size_t hsA = (size_t)HALF * g.lda * ES, hsB = (size_t)HALF * g.ldb * ES;
    const unsigned ldsw = (unsigned)wid * 1024u;
    const int aoff = lds_byte(wr * 64 + fr, fq * 8), boff = lds_byte(wc * 32 + fr, fq * 8);
#define PG8_SA(b, h) (((b) * 2 + (h)) * HTB)
#define PG8_SB(b, h) ((4 + (b) * 2 + (h)) * HTB)
#define PG8_STAGE(bufoff, gbase, voff) do { _Pragma("unroll") for (int _i = 0; _i < 2; ++_i) \
        __builtin_amdgcn_global_load_lds((const unsigned*)((const char*)(gbase) + (voff)[_i]), (PG8_LAS unsigned*)(lds + (bufoff) + ldsw + _i * 8192), 16, 0, 0); } while (0)
#define PG8_LDA(dst, b, h) do { _Pragma("unroll") for (int m = 0; m < 4; ++m) { if constexpr (FP8) { dst##8[m] = pk32(*(const PG8_LAS bf16x8*)(lds + PG8_SA(b, h) + aoff + m * 2048), *(const PG8_LAS bf16x8*)(lds + PG8_SA(b, h) + aoff + m * 2048 + 1024)); } \
        else { _Pragma("unroll") for (int k = 0; k < 2; ++k) dst[m][k] = *(const PG8_LAS bf16x8*)(lds + PG8_SA(b, h) + aoff + m * 2048 + k * 1024); } } } while (0)
#define PG8_LDB(dst, b, h) do { _Pragma("unroll") for (int n = 0; n < 2; ++n) { if constexpr (FP8) { dst##8[n] = pk32(*(const PG8_LAS bf16x8*)(lds + PG8_SB(b, h) + boff + n * 2048), *(const PG8_LAS bf16x8*)(lds + PG8_SB(b, h) + boff + n * 2048 + 1024)); } \
        else { _Pragma("unroll") for (int k = 0; k < 2; ++k) dst[n][k] = *(const PG8_LAS bf16x8*)(lds + PG8_SB(b, h) + boff + n * 2048 + k * 1024); } } } while (0)
#define PG8_MMA(ai, bj, At, Bt) do { __builtin_amdgcn_s_setprio(1); _Pragma("unroll") for (int m = 0; m < 4; ++m) _Pragma("unroll") for (int n = 0; n < 2; ++n) { \
        if constexpr (FP8) { asm volatile("v_mfma_scale_f32_16x16x128_f8f6f4 %0, %1, %2, %0, %3, %3 op_sel_hi:[0,0,0]" : "+v"(acc[ai][bj][m][n]) : "v"(Bt##8[n]), "v"(At##8[m]), "v"(sc127)); } \
        else if constexpr (I8) { _Pragma("unroll") for (int k = 0; k < 2; ++k) acc[ai][bj][m][n] = __builtin_bit_cast(f32x4, __builtin_amdgcn_mfma_i32_16x16x64_i8(__builtin_bit_cast(i32x4v, Bt[n][k]), __builtin_bit_cast(i32x4v, At[m][k]), __builtin_bit_cast(i32x4v, acc[ai][bj][m][n]), 0, 0, 0)); } \
        else { _Pragma("unroll") for (int k = 0; k < 2; ++k) acc[ai][bj][m][n] = __builtin_amdgcn_mfma_f32_16x16x32_bf16(Bt[n][k], At[m][k], acc[ai][bj][m][n], 0, 0, 0); } } __builtin_amdgcn_s_setprio(0); } while (0)
#define PG8_WAIT_V(n) asm volatile("s_waitcnt vmcnt(" #n ")" ::: "memory")
#define PG8_WAIT_L(n) asm volatile("s_waitcnt lgkmcnt(" #n ")" ::: "memory")
#define PG8_BAR __builtin_amdgcn_s_barrier()
#define PG8_SCHED __builtin_amdgcn_sched_barrier(0)
    Unit cur, nxt; int ui = 0;
    if (!S.next(0, cur)) return;
    f32x4 acc[2][2][4][2];
#pragma unroll
    for (int a = 0; a < 2; ++a)
#pragma unroll
        for (int b = 0; b < 2; ++b)
#pragma unroll
            for (int m = 0; m < 4; ++m)
#pragma unroll
                for (int n = 0; n < 2; ++n) acc[a][b][m][n] = (f32x4){0.f, 0.f, 0.f, 0.f};
    bf16x8 At[4][2], B0[2][2], B1[2][2]; i32x8 At8[4], B08[2], B18[2]; int sc127 = 127; if constexpr (FP8) asm volatile("" : "+v"(sc127));
    const char* cA = g.a(cur); const char* cB = g.b(cur);
    S.a_ready(cur);
    if constexpr (SP2) {
        PG8_STAGE(PG8_SB(0, 0), cB, voffB); PG8_STAGE(PG8_SB(0, 1), cB + hsB, voffB); PG8_STAGE(PG8_SA(0, 0), cA, voffA); PG8_STAGE(PG8_SA(0, 1), cA + hsA, voffA);
        if (wr == 1) PG8_BAR;
        PG8_WAIT_V(2); PG8_BAR;
        PG8_STAGE(PG8_SB(1, 0), cB + kstep, voffB); PG8_STAGE(PG8_SA(1, 0), cA + kstep, voffA); PG8_STAGE(PG8_SB(1, 1), cB + hsB + kstep, voffB);
        PG8_WAIT_V(6); PG8_BAR;
    } else {
        PG8_STAGE(PG8_SB(0, 0), cB, voffB); PG8_STAGE(PG8_SA(0, 0), cA, voffA); PG8_STAGE(PG8_SB(0, 1), cB + hsB, voffB); PG8_STAGE(PG8_SA(0, 1), cA + hsA, voffA);
        if (wr == 1) PG8_BAR;
        PG8_WAIT_V(4); PG8_BAR;
        PG8_STAGE(PG8_SB(1, 0), cB + kstep, voffB); PG8_STAGE(PG8_SA(1, 0), cA + kstep, voffA); PG8_STAGE(PG8_SB(1, 1), cB + hsB + kstep, voffB);
        PG8_WAIT_V(6); PG8_BAR;
    }
    for (;;) {
        const bool has_next = S.next(ui + 1, nxt);
        const char* nA = has_next ? g.a(nxt) : cA; const char* nB = has_next ? g.b(nxt) : cB;
        for (int t = 0; t < nt; t += 2) {
            const bool last = (t == nt - 2);
            const char* a1 = cA + (size_t)(t + 1) * kstep;
            const char* a2 = last ? nA : cA + (size_t)(t + 2) * kstep; const char* b2 = last ? nB : cB + (size_t)(t + 2) * kstep;
            const char* a3 = a2 + kstep; const char* b3 = b2 + kstep;
            if (last && has_next) S.a_ready(nxt);
            if constexpr (SP2) {
            PG8_LDB(B0, 0, 0); PG8_LDB(B1, 0, 1); PG8_SCHED; PG8_LDA(At, 0, 0); PG8_STAGE(PG8_SA(1, 1), a1 + hsA, voffA);
            PG8_WAIT_V(8); PG8_WAIT_L(0); PG8_BAR; PG8_MMA(0, 0, At, B0); PG8_MMA(0, 1, At, B1); PG8_BAR; PG8_SCHED;
            PG8_LDA(At, 0, 1); PG8_STAGE(PG8_SB(0, 0), b2, voffB); PG8_STAGE(PG8_SB(0, 1), b2 + hsB, voffB); PG8_STAGE(PG8_SA(0, 0), a2, voffA);
            PG8_WAIT_V(8); PG8_WAIT_L(0); PG8_BAR; PG8_MMA(1, 0, At, B0); PG8_MMA(1, 1, At, B1); PG8_BAR; PG8_SCHED;
            PG8_LDB(B0, 1, 0); PG8_LDB(B1, 1, 1); PG8_SCHED; PG8_LDA(At, 1, 0); PG8_STAGE(PG8_SA(0, 1), a2 + hsA, voffA);
            PG8_WAIT_V(8); PG8_WAIT_L(0); PG8_BAR; PG8_MMA(0, 0, At, B0); PG8_MMA(0, 1, At, B1); PG8_BAR; PG8_SCHED;
            PG8_LDA(At, 1, 1); PG8_STAGE(PG8_SB(1, 0), b3, voffB); PG8_STAGE(PG8_SB(1, 1), b3 + hsB, voffB); PG8_STAGE(PG8_SA(1, 0), a3, voffA);
            PG8_WAIT_V(8); PG8_WAIT_L(0); PG8_BAR; PG8_MMA(1, 0, At, B0); PG8_MMA(1, 1, At, B1); PG8_BAR; PG8_SCHED;
            } else {
            PG8_LDB(B0, 0, 0); PG8_SCHED; PG8_LDA(At, 0, 0); PG8_STAGE(PG8_SA(1, 1), a1 + hsA, voffA);
            PG8_WAIT_L(8); PG8_BAR; PG8_WAIT_L(0); PG8_MMA(0, 0, At, B0); PG8_BAR; PG8_SCHED;
            PG8_LDB(B1, 0, 1); PG8_STAGE(PG8_SB(0, 0), b2, voffB);
            PG8_BAR; PG8_WAIT_L(0); PG8_MMA(0, 1, At, B1); PG8_BAR;
            PG8_LDA(At, 0, 1); PG8_STAGE(PG8_SA(0, 0), a2, voffA);
            PG8_BAR; PG8_WAIT_L(0); PG8_MMA(1, 0, At, B0); PG8_BAR; PG8_SCHED;
            PG8_STAGE(PG8_SB(0, 1), b2 + hsB, voffB);
            PG8_WAIT_V(6); PG8_BAR; PG8_MMA(1, 1, At, B1); PG8_BAR;
            PG8_LDB(B0, 1, 0); PG8_SCHED; PG8_LDA(At, 1, 0); PG8_STAGE(PG8_SA(0, 1), a2 + hsA, voffA);
            PG8_WAIT_L(8); PG8_BAR; PG8_WAIT_L(0); PG8_MMA(0, 0, At, B0); PG8_BAR; PG8_SCHED;
            PG8_LDB(B1, 1, 1); PG8_STAGE(PG8_SB(1, 0), b3, voffB);
            PG8_BAR; PG8_WAIT_L(0); PG8_MMA(0, 1, At, B1); PG8_BAR;
            PG8_LDA(At, 1, 1); PG8_STAGE(PG8_SA(1, 0), a3, voffA);
            PG8_BAR; PG8_WAIT_L(0); PG8_MMA(1, 0, At, B0); PG8_BAR; PG8_SCHED;
            PG8_STAGE(PG8_SB(1, 1), b3 + hsB, voffB);
            PG8_WAIT_V(6); PG8_BAR; PG8_MMA(1, 1, At, B1); PG8_BAR;
            }
        }
        if constexpr (ALIGN_EPI) { if (wr == 0) PG8_BAR; }
        if constexpr (FP8) asm volatile("s_nop 15\n\ts_nop 15" ::: "memory");
#ifdef PG8_EPI2
        if constexpr (!Epi::AFTER_DRAIN && PG8_EPI2(Epi)) { E(acc, cur, wr, wc, fr, fq); asm volatile("" ::: "memory"); }
#endif
        if constexpr (!Epi::AFTER_DRAIN) { E(acc, cur, wr, wc, fr, fq); S.done(cur); }
        if (!has_next) break;
#pragma unroll
        for (int a = 0; a < 2; ++a)
#pragma unroll
            for (int b = 0; b < 2; ++b)
#pragma unroll
                for (int m = 0; m < 4; ++m)
#pragma unroll
                    for (int n = 0; n < 2; ++n) acc[a][b][m][n] = (f32x4){0.f, 0.f, 0.f, 0.f};
        cur = nxt; cA = nA; cB = nB; ++ui;
        if constexpr (ALIGN_EPI) { if (wr == 1) PG8_BAR; }
    }
    PG8_WAIT_V(0);
    if constexpr (!ALIGN_EPI) { if (wr == 0) PG8_BAR; }
    PG8_BAR;
    if constexpr (Epi::AFTER_DRAIN) { E.fused(acc, cur, wr, wc, fr, fq, lds, wid, lane); S.done(cur); }
#undef PG8_SA
#undef PG8_SB
#undef PG8_STAGE
#undef PG8_LDA
#undef PG8_LDB
#undef PG8_MMA
#undef PG8_WAIT_V
#undef PG8_WAIT_L
#undef PG8_BAR
#undef PG8_SCHED
}
}

constexpr int NWAVES = 8, NTHREADS = NWAVES * 64;
constexpr int M_TOK = 16384, SEQ = 4096, D = 2048, FFA = 8192, HA = 4096, NGA = 16, CHUNK = 128;
constexpr int NKEYS = 128, NEXP = 16384, HEADS = 8, TOPK = 16, NSEL = HEADS * TOPK;
constexpr float ALPHA = 1.41421356237f, LN_EPS = 1e-5f;
constexpr float X4_SCALE = 1.25f;
constexpr float M_SCALE = 32.0f;
constexpr float U_SCALE = 16.0f;
constexpr float G_SCALE = 16.0f, W2_SCALE = 2048.0f;
constexpr float W1_SCALE = 1024.0f;
constexpr int N_PHASES = 17;

constexpr size_t MiB = 1u << 20;
constexpr size_t WS_CTL = 0, CTL_ZERO_BYTES = 1 * MiB;
constexpr size_t WS_W1T = 2 * MiB, WS_W2T = 34 * MiB, WS_BINT = 50 * MiB, WS_BOUTT = 58 * MiB, WS_WQT = 66 * MiB  , WS_BGT = 82 * MiB, WS_BD = 84 * MiB, WS_BDSK = 86 * MiB  ;
constexpr size_t WS_SU = 87 * MiB, WS_SV = 87 * MiB + 131072;
constexpr size_t WS_XB = 88 * MiB;
constexpr size_t WS_UT = 152 * MiB, WS_VTAB = 280 * MiB;
constexpr size_t WS_UG = 408 * MiB;
constexpr size_t WS_ST = 408 * MiB, WS_POOL = 408 * MiB, WS_MIXED = 472 * MiB;
constexpr size_t WS_VT = 536 * MiB;
constexpr size_t WS_Q = 536 * MiB, WS_H = 600 * MiB;
constexpr size_t WS_Y = 664 * MiB;
constexpr size_t WS_X1 = 792 * MiB;
constexpr size_t WS_EIDX = 920 * MiB, WS_GATE = 928 * MiB;
constexpr size_t WS_WQS = 936 * MiB;
constexpr size_t WS_XF = 952 * MiB;
constexpr size_t WS_SX0 = 984 * MiB;
constexpr size_t WS_END = 985 * MiB;
constexpr int CW_BAR = 4096;

constexpr int RING_OFF = 0, RING_BYTES = 131072;
constexpr int LDSCTL_OFF = RING_BYTES, MISC_OFF = LDSCTL_OFF + 320;
constexpr int IDS16_OFF = LDSCTL_OFF + 1024;
constexpr int IDS16_WAVE = 3584;
constexpr int LDS_BYTES = IDS16_OFF + 8 * IDS16_WAVE;
static_assert(MISC_OFF + 128 <= LDS_BYTES, "LDS map");

#define GAS __attribute__((address_space(1)))
#define LAS __attribute__((address_space(3)))
typedef unsigned short bf16;
typedef unsigned v4u __attribute__((ext_vector_type(4)));
typedef unsigned v2u __attribute__((ext_vector_type(2)));
typedef float f32x4 __attribute__((ext_vector_type(4)));
typedef __bf16 bf16x2_t __attribute__((ext_vector_type(2)));
typedef GAS unsigned gu32;
#define RLX_AGENT __ATOMIC_RELAXED, __HIP_MEMORY_SCOPE_AGENT
#define LDS_WAIT() asm volatile("s_waitcnt lgkmcnt(0)" ::: "memory")
#define VM_WAIT() asm volatile("s_waitcnt vmcnt(0)" ::: "memory")
__device__ __forceinline__ unsigned f2bf(float f) { unsigned u = __builtin_bit_cast(unsigned, f); return (u + 0x7fffu + ((u >> 16) & 1u)) >> 16; }
__device__ __forceinline__ unsigned pk2(float lo, float hi) { return f2bf(lo) | (f2bf(hi) << 16); }
__device__ __forceinline__ float bflo(unsigned w) { return __builtin_bit_cast(float, w << 16); }
__device__ __forceinline__ float bfhi(unsigned w) { return __builtin_bit_cast(float, w & 0xffff0000u); }
__device__ __forceinline__ float dot2_bf16(unsigned w, unsigned x, float acc) { return __builtin_amdgcn_fdot2_f32_bf16(__builtin_bit_cast(bf16x2_t, w), __builtin_bit_cast(bf16x2_t, x), acc, false); }
__device__ __forceinline__ float shx(float v, int m, int lane) { return __builtin_bit_cast(float, __builtin_amdgcn_ds_bpermute((lane ^ m) << 2, __builtin_bit_cast(int, v))); }
__device__ __forceinline__ float wave_sum_l(float v, int lane) {
#pragma unroll
    for (int o = 1; o < 64; o <<= 1) v += shx(v, o, lane);
    return v;
}

#define XB_TMO      128
#define XB_XCNT(j)  (256  + 64 * (j))
#define XB_XSUB(j)  (1280 + 64 * (j))
#define XB_XGEN(j)  (2304 + 64 * (j))
#define XB_TOP      3328
#define XB_TOPGEN   3392
#define XCD_BAR_WORDS 3456
#define XB_SPIN_CAP (1u << 20)

__device__ __forceinline__ unsigned xb_ld(unsigned* p)              { return __hip_atomic_load(p, __ATOMIC_RELAXED, __HIP_MEMORY_SCOPE_AGENT); }
__device__ __forceinline__ unsigned xb_add(unsigned* p, unsigned v) { return __hip_atomic_fetch_add(p, v, __ATOMIC_RELAXED, __HIP_MEMORY_SCOPE_AGENT); }
__device__ __forceinline__ unsigned xb_xcc_id() { return (unsigned)__builtin_amdgcn_s_getreg((3 << 11) | 20) & 0xFu; }
#define XB_SPIN(cond, bar) do { unsigned _sp = 0; while (cond) { __builtin_amdgcn_s_sleep(1); \
    if ((++_sp & 255u) == 0u) { if (xb_ld(&(bar)[XB_TMO])) break; if (_sp > XB_SPIN_CAP) { atomicAdd(&(bar)[XB_TMO], 1u); break; } } } } while (0)

struct XcdBarrier { unsigned* bar; unsigned x; volatile LAS unsigned* st; };

__device__ __forceinline__ XcdBarrier xcd_barrier_post(unsigned* bar, volatile LAS unsigned* st) {
    XcdBarrier b; b.bar = bar; b.x = xb_xcc_id(); b.st = st;
    if (threadIdx.x == 0) (void)xb_add(&bar[XB_XCNT(b.x)], 1u);
    return b;
}
__device__ __forceinline__ void xcd_barrier_complete(unsigned* bar, unsigned x, unsigned& nloc, unsigned& nx) {
    const unsigned G = gridDim.x * gridDim.y * gridDim.z;
    unsigned sum, cnt, mine, sp = 0u;
    for (;;) {
        sum = 0u; cnt = 0u; mine = 0u;
#pragma unroll
        for (unsigned j = 0; j < 16; ++j) { const unsigned c = xb_ld(&bar[XB_XCNT(j)]); sum += c; cnt += (c > 0u) ? 1u : 0u; mine = (j == x) ? c : mine; }
        if (sum == G) break;
        __builtin_amdgcn_s_sleep(1);
        if ((++sp & 255u) == 0u) { if (xb_ld(&bar[XB_TMO])) break; if (sp > XB_SPIN_CAP) { atomicAdd(&bar[XB_TMO], 1u); break; } }
    }
    nloc = mine > 0u ? mine : 1u; nx = cnt > 0u ? cnt : 1u;
}
__device__ __forceinline__ void xcd_barrier(const XcdBarrier& b, const int tid) {
    asm volatile("s_waitcnt vmcnt(0)" ::: "memory");
    __syncthreads();
    if (tid == 0) {
        unsigned* bar = b.bar;
        __builtin_amdgcn_s_waitcnt(0);
        unsigned nloc = b.st[0], nx = b.st[1];
        if (nloc == 0u) { xcd_barrier_complete(bar, b.x, nloc, nx); b.st[0] = nloc; b.st[1] = nx; }
        const unsigned old = xb_add(&bar[XB_XSUB(b.x)], 1u);
        const unsigned gen = old / nloc;
        if (old + 1u == (gen + 1u) * nloc) {
            __builtin_amdgcn_fence(__ATOMIC_RELEASE, "agent");
            asm volatile("s_waitcnt vmcnt(0)" ::: "memory");
            const unsigned og = xb_add(&bar[XB_TOP], 1u);
            const unsigned tg = og / nx;
            if (og + 1u == (tg + 1u) * nx) xb_add(&bar[XB_TOPGEN], 1u);
            else XB_SPIN(xb_ld(&bar[XB_TOPGEN]) == tg, bar);
            __builtin_amdgcn_fence(__ATOMIC_ACQUIRE, "agent");
            xb_add(&bar[XB_XGEN(b.x)], 1u);
            asm volatile("s_waitcnt vmcnt(0)" ::: "memory");
        } else {
            XB_SPIN(xb_ld(&bar[XB_XGEN(b.x)]) == gen, bar);
            __builtin_amdgcn_fence(__ATOMIC_ACQUIRE, "agent");
            asm volatile("s_waitcnt vmcnt(0)" ::: "memory");
        }
    }
    __syncthreads();
}

__device__ __forceinline__ void p0_transpose_item(const float* W, int K, int N, bf16* WT, LAS float* scr, int item, int lane) {
    const int nblk = N / 32, kb = item / nblk, nb = item % nblk, k0 = 64 * kb, n0 = 32 * nb;
    float t[32];
#pragma unroll
    for (int i = 0; i < 32; ++i) t[i] = W[(size_t)(k0 + 2 * i + (lane >> 5)) * N + n0 + (lane & 31)];
#pragma unroll
    for (int i = 0; i < 32; ++i) scr[(2 * i + (lane >> 5)) * 33 + (lane & 31)] = t[i];
    LDS_WAIT(); asm volatile("" ::: "memory");
    const int c = lane & 7;
#pragma unroll
    for (int j = 0; j < 4; ++j) { const int n = (lane >> 3) + 8 * j; const LAS float* s = scr + (8 * c) * 33 + n;
        v4u o; o.x = pk2(s[0 * 33], s[1 * 33]); o.y = pk2(s[2 * 33], s[3 * 33]); o.z = pk2(s[4 * 33], s[5 * 33]); o.w = pk2(s[6 * 33], s[7 * 33]);
        *(GAS v4u*)(WT + (size_t)(n0 + n) * K + k0 + 8 * c) = o; }
    LDS_WAIT(); asm volatile("" ::: "memory");
}
__device__ __forceinline__ void p0_convert(const float* src, bf16* dst, int nchunks, int gw, int NGW, int lane) {
    for (int c0 = gw; c0 < nchunks; c0 += 4 * NGW) {
        f32x4 a[4][2];
#pragma unroll
        for (int q = 0; q < 4; ++q) { const int c = c0 + q * NGW; if (c < nchunks) { const GAS f32x4* s = (const GAS f32x4*)(src + (size_t)c * 512 + lane * 8); a[q][0] = s[0]; a[q][1] = s[1]; } }
#pragma unroll
        for (int q = 0; q < 4; ++q) { const int c = c0 + q * NGW; if (c < nchunks) { v4u o; o.x = pk2(a[q][0].x, a[q][0].y); o.y = pk2(a[q][0].z, a[q][0].w); o.z = pk2(a[q][1].x, a[q][1].y); o.w = pk2(a[q][1].z, a[q][1].w);
            *(GAS v4u*)(dst + (size_t)c * 512 + lane * 8) = o; } }
    }
}

__device__ __forceinline__ float clamp448(float v) { return __builtin_amdgcn_fmed3f(v, -448.0f, 448.0f); }
__device__ __forceinline__ unsigned pk4_fp8(float a, float b, float c, float d) { int w = 0; w = __builtin_amdgcn_cvt_pk_fp8_f32(clamp448(a), clamp448(b), w, false); w = __builtin_amdgcn_cvt_pk_fp8_f32(clamp448(c), clamp448(d), w, true); return (unsigned)w; }
__device__ __forceinline__ unsigned pk4_i8c(float a, float b, float c, float d) {
    const int q0 = (int)__builtin_rintf(__builtin_amdgcn_fmed3f(a, -127.f, 127.f)), q1 = (int)__builtin_rintf(__builtin_amdgcn_fmed3f(b, -127.f, 127.f)), q2 = (int)__builtin_rintf(__builtin_amdgcn_fmed3f(c, -127.f, 127.f)), q3 = (int)__builtin_rintf(__builtin_amdgcn_fmed3f(d, -127.f, 127.f));
    return ((unsigned)q0 & 0xffu) | (((unsigned)q1 & 0xffu) << 8) | (((unsigned)q2 & 0xffu) << 16) | ((unsigned)q3 << 24);
}
template <int NR> __device__ __forceinline__ void rows_to_i8(const float* x, unsigned char* o8, float* sx, int m0, int stride, int lane) {
    f32x4 v[NR][8];
#pragma unroll
    for (int k = 0; k < NR; ++k) { const GAS f32x4* xr = (const GAS f32x4*)(x + (size_t)(m0 + k * stride) * D) + lane;
#pragma unroll
        for (int j = 0; j < 8; ++j) v[k][j] = xr[64 * j]; }
#pragma unroll
    for (int k = 0; k < NR; ++k) { float am = 0.f;
#pragma unroll
        for (int j = 0; j < 8; ++j) am = fmaxf(am, fmaxf(fmaxf(fabsf(v[k][j].x), fabsf(v[k][j].y)), fmaxf(fabsf(v[k][j].z), fabsf(v[k][j].w))));
#pragma unroll
        for (int o = 1; o < 64; o <<= 1) am = fmaxf(am, shx(am, o, lane));
        const float inv = am > 0.f ? 127.0f / am : 0.f; const size_t ro = (size_t)(m0 + k * stride) * D;
#pragma unroll
        for (int j = 0; j < 8; ++j) ((GAS unsigned*)(o8 + ro) + lane)[64 * j] = pk4_i8c(v[k][j].x * inv, v[k][j].y * inv, v[k][j].z * inv, v[k][j].w * inv);
        if (lane == 0) ((GAS float*)sx)[m0 + k * stride] = am * (1.0f / 127.0f); }
}
template <bool I8> __device__ __forceinline__ void p0_transpose_item8(const float* W, int K, int N, unsigned char* WT, float scale, LAS float* scr, int item, int lane) {
    const int nblk = N / 32, kb = item / nblk, nb = item % nblk, k0 = 64 * kb, n0 = 32 * nb;
    float t[32];
#pragma unroll
    for (int i = 0; i < 32; ++i) t[i] = W[(size_t)(k0 + 2 * i + (lane >> 5)) * N + n0 + (lane & 31)];
#pragma unroll
    for (int i = 0; i < 32; ++i) scr[(2 * i + (lane >> 5)) * 33 + (lane & 31)] = t[i] * scale;
    LDS_WAIT(); asm volatile("" ::: "memory");
    const int c = lane & 7;
#pragma unroll
    for (int j = 0; j < 4; ++j) { const int n = (lane >> 3) + 8 * j; const LAS float* s = scr + (8 * c) * 33 + n;
        v2u o; if (I8) { o.x = pk4_i8c(s[0 * 33], s[1 * 33], s[2 * 33], s[3 * 33]); o.y = pk4_i8c(s[4 * 33], s[5 * 33], s[6 * 33], s[7 * 33]); } else { o.x = pk4_fp8(s[0 * 33], s[1 * 33], s[2 * 33], s[3 * 33]); o.y = pk4_fp8(s[4 * 33], s[5 * 33], s[6 * 33], s[7 * 33]); }
        *(GAS v2u*)(WT + (size_t)(n0 + n) * K + k0 + 8 * c) = o; }
    LDS_WAIT(); asm volatile("" ::: "memory");
}
__device__ __forceinline__ void p0_convert8(const float* src, unsigned char* dst, float scale, int nchunks, int gw, int NGW, int lane) {
    for (int c0 = gw; c0 < nchunks; c0 += 8 * NGW) {
        f32x4 a[8][2];
#pragma unroll
        for (int q = 0; q < 8; ++q) { const int c = c0 + q * NGW; if (c < nchunks) { const GAS f32x4* s = (const GAS f32x4*)(src + (size_t)c * 512 + lane * 8); a[q][0] = s[0]; a[q][1] = s[1]; } }
#pragma unroll
        for (int q = 0; q < 8; ++q) { const int c = c0 + q * NGW; if (c < nchunks) { v2u o; o.x = pk4_fp8(a[q][0].x * scale, a[q][0].y * scale, a[q][0].z * scale, a[q][0].w * scale); o.y = pk4_fp8(a[q][1].x * scale, a[q][1].y * scale, a[q][1].z * scale, a[q][1].w * scale);
            *(GAS v2u*)(dst + (size_t)c * 512 + lane * 8) = o; } }
    }
}
__device__ __forceinline__ void p0_row_fp8(const float* src, unsigned char* dst, int e, float* scale, int lane) {
    f32x4 v[2][4]; float am = 0.f;
#pragma unroll
    for (int i = 0; i < 2; ++i)
#pragma unroll
        for (int q = 0; q < 4; ++q) { v[i][q] = *(const GAS f32x4*)(src + i * 1024 + lane * 16 + 4 * q);
            am = fmaxf(am, fmaxf(fmaxf(fabsf(v[i][q].x), fabsf(v[i][q].y)), fmaxf(fabsf(v[i][q].z), fabsf(v[i][q].w)))); }
#pragma unroll
    for (int o = 1; o < 64; o <<= 1) am = fmaxf(am, shx(am, o, lane));
    const float inv = am > 0.f ? 256.0f / am : 0.f;
#pragma unroll
    for (int i = 0; i < 2; ++i) { v4u w;
#pragma unroll
        for (int q = 0; q < 4; ++q) { int d = 0; d = __builtin_amdgcn_cvt_pk_fp8_f32(v[i][q].x * inv, v[i][q].y * inv, d, false); d = __builtin_amdgcn_cvt_pk_fp8_f32(v[i][q].z * inv, v[i][q].w * inv, d, true); w[q] = (unsigned)d; }
        *(GAS v4u*)(dst + (size_t)(i * 8 + (lane >> 3)) * (NEXP * 128) + (size_t)e * 128 + (lane & 7) * 16) = w; }
    if (lane == 0) *scale = am * (1.0f / 256.0f);
}

template <int NR> __device__ __forceinline__ void p0_row_fp4(const float* const (&src)[NR], unsigned char* const (&dst)[NR], const int (&e)[NR], float* const (&scale)[NR], int lane) {
    f32x4 v[NR][2][4];
#pragma unroll
    for (int k = 0; k < NR; ++k)
#pragma unroll
        for (int i = 0; i < 2; ++i)
#pragma unroll
            for (int q = 0; q < 4; ++q) v[k][i][q] = *(const GAS f32x4*)(src[k] + i * 1024 + lane * 16 + 4 * q);
#pragma unroll
    for (int k = 0; k < NR; ++k) { float am = 0.f;
#pragma unroll
        for (int i = 0; i < 2; ++i)
#pragma unroll
            for (int q = 0; q < 4; ++q) am = fmaxf(am, fmaxf(fmaxf(fabsf(v[k][i][q].x), fabsf(v[k][i][q].y)), fmaxf(fabsf(v[k][i][q].z), fabsf(v[k][i][q].w))));
#pragma unroll
        for (int o = 1; o < 64; o <<= 1) am = fmaxf(am, shx(am, o, lane));
        const float inv = am > 0.f ? 6.0f / am : 0.f;
#pragma unroll
        for (int i = 0; i < 2; ++i) { unsigned w0 = 0, w1 = 0;
            w0 = __builtin_amdgcn_cvt_scalef32_pk_fp4_f32(w0, v[k][i][0].x * inv, v[k][i][0].y * inv, 1.0f, 0); w0 = __builtin_amdgcn_cvt_scalef32_pk_fp4_f32(w0, v[k][i][0].z * inv, v[k][i][0].w * inv, 1.0f, 1);
            w0 = __builtin_amdgcn_cvt_scalef32_pk_fp4_f32(w0, v[k][i][1].x * inv, v[k][i][1].y * inv, 1.0f, 2); w0 = __builtin_amdgcn_cvt_scalef32_pk_fp4_f32(w0, v[k][i][1].z * inv, v[k][i][1].w * inv, 1.0f, 3);
            w1 = __builtin_amdgcn_cvt_scalef32_pk_fp4_f32(w1, v[k][i][2].x * inv, v[k][i][2].y * inv, 1.0f, 0); w1 = __builtin_amdgcn_cvt_scalef32_pk_fp4_f32(w1, v[k][i][2].z * inv, v[k][i][2].w * inv, 1.0f, 1);
            w1 = __builtin_amdgcn_cvt_scalef32_pk_fp4_f32(w1, v[k][i][3].x * inv, v[k][i][3].y * inv, 1.0f, 2); w1 = __builtin_amdgcn_cvt_scalef32_pk_fp4_f32(w1, v[k][i][3].z * inv, v[k][i][3].w * inv, 1.0f, 3);
            *(GAS v2u*)(dst[k] + (size_t)(i * 4 + (lane >> 4)) * (NEXP * 128) + (size_t)e[k] * 128 + (lane & 15) * 8) = (v2u){w0, w1}; }
        if (lane == 0) *(GAS float*)scale[k] = am * (1.0f / 6.0f); }
}

template <int NR> __device__ __forceinline__ void p0_row_fp4t(const float* const (&src)[NR], unsigned char* const (&dst)[NR], const int (&e)[NR], float* const (&scale)[NR], LAS unsigned char* scr, int lane) {
    f32x4 v[NR][2][4];
#pragma unroll
    for (int k = 0; k < NR; ++k)
#pragma unroll
        for (int i = 0; i < 2; ++i)
#pragma unroll
            for (int q = 0; q < 4; ++q) v[k][i][q] = *(const GAS f32x4*)(src[k] + i * 1024 + lane * 16 + 4 * q);
#pragma unroll
    for (int k = 0; k < NR; ++k) { float am = 0.f;
#pragma unroll
        for (int i = 0; i < 2; ++i)
#pragma unroll
            for (int q = 0; q < 4; ++q) am = fmaxf(am, fmaxf(fmaxf(fabsf(v[k][i][q].x), fabsf(v[k][i][q].y)), fmaxf(fabsf(v[k][i][q].z), fabsf(v[k][i][q].w))));
#pragma unroll
        for (int o = 1; o < 64; o <<= 1) am = fmaxf(am, shx(am, o, lane));
        const float inv = am > 0.f ? 6.0f / am : 0.f;
#pragma unroll
        for (int i = 0; i < 2; ++i) { unsigned w0 = 0, w1 = 0;
            w0 = __builtin_amdgcn_cvt_scalef32_pk_fp4_f32(w0, v[k][i][0].x * inv, v[k][i][0].y * inv, 1.0f, 0); w0 = __builtin_amdgcn_cvt_scalef32_pk_fp4_f32(w0, v[k][i][0].z * inv, v[k][i][0].w * inv, 1.0f, 1);
            w0 = __builtin_amdgcn_cvt_scalef32_pk_fp4_f32(w0, v[k][i][1].x * inv, v[k][i][1].y * inv, 1.0f, 2); w0 = __builtin_amdgcn_cvt_scalef32_pk_fp4_f32(w0, v[k][i][1].z * inv, v[k][i][1].w * inv, 1.0f, 3);
            w1 = __builtin_amdgcn_cvt_scalef32_pk_fp4_f32(w1, v[k][i][2].x * inv, v[k][i][2].y * inv, 1.0f, 0); w1 = __builtin_amdgcn_cvt_scalef32_pk_fp4_f32(w1, v[k][i][2].z * inv, v[k][i][2].w * inv, 1.0f, 1);
            w1 = __builtin_amdgcn_cvt_scalef32_pk_fp4_f32(w1, v[k][i][3].x * inv, v[k][i][3].y * inv, 1.0f, 2); w1 = __builtin_amdgcn_cvt_scalef32_pk_fp4_f32(w1, v[k][i][3].z * inv, v[k][i][3].w * inv, 1.0f, 3);
            *(LAS v4u*)(scr + lane * 16) = (v4u){w0 & 0x0f0f0f0fu, (w0 >> 4) & 0x0f0f0f0fu, w1 & 0x0f0f0f0fu, (w1 >> 4) & 0x0f0f0f0fu};
            const int jj = lane & 15, oo = 4 * (jj & 3) + (jj >> 2), pos = (oo & 8) + ((oo & 1) << 2) + ((oo >> 1) & 3);
            const LAS unsigned char* col = scr + (lane & 48) * 16 + pos;
            unsigned o0 = 0, o1 = 0;
#pragma unroll
            for (int n = 0; n < 8; ++n) { o0 |= (unsigned)col[n * 16] << (4 * n); o1 |= (unsigned)col[(n + 8) * 16] << (4 * n); }
            *(GAS v2u*)(dst[k] + (size_t)(i * 4 + (lane >> 4)) * (NEXP * 128) + (size_t)e[k] * 128 + jj * 8) = (v2u){o0, o1};
            asm volatile("s_waitcnt lgkmcnt(0)" ::: "memory"); }
        if (lane == 0) *(GAS float*)scale[k] = am * (1.0f / 6.0f); }
}

#define LN8_UNPACK(q_) {bflo((q_)[0]), bfhi((q_)[0]), bflo((q_)[1]), bfhi((q_)[1]), bflo((q_)[2]), bfhi((q_)[2]), bflo((q_)[3]), bfhi((q_)[3])}
template <int NR> __device__ __forceinline__ void ln_rows(const bf16* y, const float* g, const float* b, bf16* ob, unsigned char* o8h, unsigned char* o8, float* sx, int m0, int stride, int lane, LAS unsigned* scr  ) {
    float v[NR][4][8];
#pragma unroll
    for (int k = 0; k < NR; ++k) { const GAS v4u* yr = (const GAS v4u*)(y + (size_t)(m0 + k * stride) * D) + lane; v4u w[4];
#pragma unroll
        for (int j = 0; j < 4; ++j) w[j] = yr[64 * j];
#pragma unroll
        for (int j = 0; j < 4; ++j) { const float f[8] = LN8_UNPACK(w[j]);
#pragma unroll
            for (int e = 0; e < 8; ++e) v[k][j][e] = f[e]; } }
    const GAS f32x4* g4 = (const GAS f32x4*)g + 2 * lane; const GAS f32x4* b4 = (const GAS f32x4*)b + 2 * lane;
#pragma unroll
    for (int k = 0; k < NR; ++k) { float s = 0.f;
#pragma unroll
        for (int j = 0; j < 4; ++j) s += ((v[k][j][0] + v[k][j][1]) + (v[k][j][2] + v[k][j][3])) + ((v[k][j][4] + v[k][j][5]) + (v[k][j][6] + v[k][j][7]));
        const float mean = wave_sum_l(s, lane) * (1.f / D); float s2 = 0.f;
#pragma unroll
        for (int j = 0; j < 4; ++j)
#pragma unroll
            for (int e = 0; e < 8; ++e) { v[k][j][e] -= mean; s2 += v[k][j][e] * v[k][j][e]; }
        const float rstd = 1.f / sqrtf(wave_sum_l(s2, lane) * (1.f / D) + LN_EPS);
        const size_t ro = (size_t)(m0 + k * stride) * D; float am = 0.f;
#pragma unroll
        for (int j = 0; j < 4; ++j) { const f32x4 ga = g4[128 * j], gb = g4[128 * j + 1], ba = b4[128 * j], bb = b4[128 * j + 1];
            const float gg[8] = {ga.x, ga.y, ga.z, ga.w, gb.x, gb.y, gb.z, gb.w}, be[8] = {ba.x, ba.y, ba.z, ba.w, bb.x, bb.y, bb.z, bb.w}; float o[8];
#pragma unroll
            for (int e = 0; e < 8; ++e) { o[e] = v[k][j][e] * rstd * gg[e] + be[e]; v[k][j][e] = o[e]; am = fmaxf(am, fabsf(o[e])); }
            ((GAS v4u*)(ob + ro) + lane)[64 * j] = (v4u){pk2(o[0], o[1]), pk2(o[2], o[3]), pk2(o[4], o[5]), pk2(o[6], o[7])};
            {
                unsigned hi = 0, lo = 0;
#define LN8_HI(e) hi = __builtin_amdgcn_cvt_scalef32_pk_fp4_f32(hi, o[2 * e] * X4_SCALE, o[2 * e + 1] * X4_SCALE, 1.0f, e)
#define LN8_LO(e) { const auto hv = __builtin_amdgcn_cvt_scalef32_pk_f32_fp4(hi, 1.0f, e); lo = __builtin_amdgcn_cvt_scalef32_pk_fp4_f32(lo, (o[2 * e] * X4_SCALE - hv[0]) * 4.0f, (o[2 * e + 1] * X4_SCALE - hv[1]) * 4.0f, 1.0f, e); }
                LN8_HI(0); LN8_HI(1); LN8_HI(2); LN8_HI(3); LN8_LO(0) LN8_LO(1) LN8_LO(2) LN8_LO(3)
                scr[64 * j + lane] = hi; scr[256 + 64 * j + lane] = lo; } }
        { const v4u h4 = *(const LAS v4u*)(scr + 4 * lane), l4 = *(const LAS v4u*)(scr + 256 + 4 * lane);
          ((GAS v4u*)(o8h + ro / 2))[lane] = h4; ((GAS v4u*)(o8h + (size_t)M_TOK * (D / 2) + ro / 2))[lane] = l4; }
        {
#pragma unroll
            for (int o2 = 1; o2 < 64; o2 <<= 1) am = fmaxf(am, shx(am, o2, lane));
            const float inv = am > 0.f ? 127.0f / am : 0.f;
#pragma unroll
            for (int j = 0; j < 4; ++j) *(LAS v2u*)(scr + 512 + 2 * (64 * j + lane)) = (v2u){pk4_i8c(v[k][j][0] * inv, v[k][j][1] * inv, v[k][j][2] * inv, v[k][j][3] * inv), pk4_i8c(v[k][j][4] * inv, v[k][j][5] * inv, v[k][j][6] * inv, v[k][j][7] * inv)};
            { const v4u a4 = *(const LAS v4u*)(scr + 512 + 4 * lane), b4q = *(const LAS v4u*)(scr + 768 + 4 * lane); ((GAS v4u*)(o8 + ro))[lane] = a4; ((GAS v4u*)(o8 + ro))[64 + lane] = b4q; }
            if (lane == 0) ((GAS float*)sx)[ro / D] = am * (1.0f / 127.0f); }
    }
}
template <int NR> __device__ __forceinline__ void rows_bf16_to_i8(const bf16* x, unsigned char* o8, float* sx, int m0, int stride, int lane) {
#pragma unroll
    for (int k = 0; k < NR; ++k) { const size_t ro = (size_t)(m0 + k * stride) * D; const GAS v2u* xr = (const GAS v2u*)(x + ro) + lane; f32x4 v[8]; float am = 0.f;
#pragma unroll
        for (int j = 0; j < 8; ++j) { const v2u w = xr[64 * j]; v[j] = (f32x4){bflo(w.x), bfhi(w.x), bflo(w.y), bfhi(w.y)};
            am = fmaxf(am, fmaxf(fmaxf(fabsf(v[j].x), fabsf(v[j].y)), fmaxf(fabsf(v[j].z), fabsf(v[j].w)))); }
#pragma unroll
        for (int o = 1; o < 64; o <<= 1) am = fmaxf(am, shx(am, o, lane));
        const float inv = am > 0.f ? 127.0f / am : 0.f;
#pragma unroll
        for (int j = 0; j < 8; ++j) ((GAS unsigned*)(o8 + ro) + lane)[64 * j] = pk4_i8c(v[j].x * inv, v[j].y * inv, v[j].z * inv, v[j].w * inv);
        if (lane == 0) ((GAS float*)sx)[m0 + k * stride] = am * (1.0f / 127.0f); }
}

__device__ __forceinline__ void ins16(float (&L)[16], float key) {
#pragma unroll
    for (int j = 15; j >= 1; --j) L[j] = __builtin_amdgcn_fmed3f(L[j - 1], L[j], key);
    L[0] = fmaxf(L[0], key);
}
#define FENCE16(L) do { _Pragma("unroll") for (int _j = 0; _j < 16; ++_j) asm("" : "+v"(L[_j])); } while (0)
__device__ __forceinline__ void topk_lane(const bf16* ST, int h, int t, int* eidx, float* gate) {
    const float NEG = -__builtin_inff();
    float L1[16], L2[16];
#pragma unroll
    for (int j = 0; j < 16; ++j) { L1[j] = NEG; L2[j] = NEG; }
    const GAS bf16* s1 = (const GAS bf16*)ST + (size_t)(h * 256) * M_TOK + t;
    const GAS bf16* s2 = s1 + (size_t)128 * M_TOK;
#pragma nounroll
    for (int n0 = 0; n0 < NKEYS; n0 += 32) {
        unsigned ca[32], cb[32];
#pragma unroll
        for (int q = 0; q < 32; ++q) { ca[q] = s1[(size_t)(n0 + q) * M_TOK]; cb[q] = s2[(size_t)(n0 + q) * M_TOK]; }
#pragma unroll
        for (int q = 0; q < 32; ++q) {
            const unsigned tag = (unsigned)(127 - n0 - q);
            const float ka = __builtin_bit_cast(float, (ca[q] << 16) | tag);
            const float kb = __builtin_bit_cast(float, (cb[q] << 16) | tag);
            ins16(L1, ka); ins16(L2, kb);
            FENCE16(L1); FENCE16(L2);
        }
    }
    unsigned long long p1lo = 0, p1hi = 0, p2lo = 0, p2hi = 0;
#pragma unroll
    for (int j = 0; j < 8; ++j) {
        p1lo |= (unsigned long long)(127u - (__builtin_bit_cast(unsigned, L1[j]) & 127u)) << (8 * j); p1hi |= (unsigned long long)(127u - (__builtin_bit_cast(unsigned, L1[j + 8]) & 127u)) << (8 * j);
        p2lo |= (unsigned long long)(127u - (__builtin_bit_cast(unsigned, L2[j]) & 127u)) << (8 * j); p2hi |= (unsigned long long)(127u - (__builtin_bit_cast(unsigned, L2[j + 8]) & 127u)) << (8 * j); }
    float T[16];
#pragma unroll
    for (int j = 0; j < 16; ++j) T[j] = NEG;
#pragma unroll
    for (int a = 0; a < 16; ++a)
#pragma unroll
        for (int b = 0; b < 16; ++b)
            if ((a + 1) * (b + 1) <= 16) { const float sm = L1[a] + L2[b];
                ins16(T, __builtin_bit_cast(float, (__builtin_bit_cast(unsigned, sm) & ~255u) | (unsigned)(255 - (a * 16 + b)))); FENCE16(T); }
    float e[16], sum = 0.f; int I[16];
#pragma unroll
    for (int j = 0; j < 16; ++j) { e[j] = __builtin_amdgcn_exp2f((T[j] - T[0]) * 1.4426950409f); sum += e[j];
        const unsigned code = 255u - (__builtin_bit_cast(unsigned, T[j]) & 255u); const unsigned a = code >> 4, b = code & 15u;
        const unsigned long long wa = (a & 8u) ? p1hi : p1lo, wb = (b & 8u) ? p2hi : p2lo;
        const unsigned ia = (unsigned)(wa >> ((a & 7u) * 8u)) & 127u, ib = (unsigned)(wb >> ((b & 7u) * 8u)) & 127u;
        I[j] = (int)(ia * NKEYS + ib); }
    const float inv = 1.0f / sum;
    GAS int* eo = (GAS int*)eidx + (size_t)t * NSEL + h * TOPK; GAS float* go = (GAS float*)gate + (size_t)t * NSEL + h * TOPK;
#pragma unroll
    for (int j = 0; j < 16; j += 4) { typedef int i32x4 __attribute__((ext_vector_type(4)));
        *(GAS i32x4*)(eo + j) = (i32x4){I[j], I[j + 1], I[j + 2], I[j + 3]}; *(GAS f32x4*)(go + j) = (f32x4){e[j] * inv, e[j + 1] * inv, e[j + 2] * inv, e[j + 3] * inv}; }
}

constexpr int CHUNK_STRIDE = NEXP * 128;
typedef float f32x2 __attribute__((ext_vector_type(2)));
typedef int i32x4 __attribute__((ext_vector_type(4)));
#define PIN8(a, b) asm volatile("" : "+v"(a[b]), "+v"(a[b + 1]), "+v"(a[b + 2]), "+v"(a[b + 3]), "+v"(a[b + 4]), "+v"(a[b + 5]), "+v"(a[b + 6]), "+v"(a[b + 7]) :: "memory")
__device__ __forceinline__ f32x2 shx2(f32x2 v, int m, int lane) { return (f32x2){shx(v.x, m, lane), shx(v.y, m, lane)}; }

#define GAT_FETCHV(dst, rs, voff, soff) dst = __builtin_bit_cast(v4u, __builtin_amdgcn_raw_buffer_load_b128(rs, (int)(voff), soff, 0))
template <int NR> __device__ __forceinline__ void ln_res_rows(const bf16* x, const bf16* o, const float* g, const float* b, float* of, bf16* ob, unsigned char* o8, float* sx, size_t ro0, size_t rstride, int lane, LAS unsigned* scr  ) {
    float v[NR][4][8];
#pragma unroll
    for (int k = 0; k < NR; ++k) { const GAS v4u* xr = (const GAS v4u*)(x + ro0 + k * rstride) + lane; const GAS v4u* orr = (const GAS v4u*)(o + ro0 + k * rstride) + lane; v4u xw[4], ow[4];
#pragma unroll
        for (int j = 0; j < 4; ++j) { xw[j] = xr[64 * j]; ow[j] = orr[64 * j]; }
#pragma unroll
        for (int j = 0; j < 4; ++j) { const float xf[8] = LN8_UNPACK(xw[j]), of8[8] = LN8_UNPACK(ow[j]);
#pragma unroll
            for (int e = 0; e < 8; ++e) v[k][j][e] = xf[e] * ALPHA + of8[e]; } }
    const GAS f32x4* g4 = (const GAS f32x4*)g + 2 * lane; const GAS f32x4* b4 = (const GAS f32x4*)b + 2 * lane;
#pragma unroll
    for (int k = 0; k < NR; ++k) { float s = 0.f;
#pragma unroll
        for (int j = 0; j < 4; ++j) s += ((v[k][j][0] + v[k][j][1]) + (v[k][j][2] + v[k][j][3])) + ((v[k][j][4] + v[k][j][5]) + (v[k][j][6] + v[k][j][7]));
        const float mean = wave_sum_l(s, lane) * (1.f / D); float s2 = 0.f;
#pragma unroll
        for (int j = 0; j < 4; ++j)
#pragma unroll
            for (int e = 0; e < 8; ++e) { v[k][j][e] -= mean; s2 += v[k][j][e] * v[k][j][e]; }
        const float rstd = 1.f / sqrtf(wave_sum_l(s2, lane) * (1.f / D) + LN_EPS);
        const size_t ro = ro0 + k * rstride;
        float am = 0.f;
#pragma unroll
        for (int j = 0; j < 4; ++j) { const f32x4 ga = g4[128 * j], gb = g4[128 * j + 1], ba = b4[128 * j], bb = b4[128 * j + 1];
            const float gg[8] = {ga.x, ga.y, ga.z, ga.w, gb.x, gb.y, gb.z, gb.w}, be[8] = {ba.x, ba.y, ba.z, ba.w, bb.x, bb.y, bb.z, bb.w}; float q[8];
#pragma unroll
            for (int e = 0; e < 8; ++e) { q[e] = v[k][j][e] * rstd * gg[e] + be[e]; v[k][j][e] = q[e]; am = fmaxf(am, fabsf(q[e])); }
            if (of) { ((GAS f32x4*)(of + ro) + 2 * lane)[128 * j] = (f32x4){q[0], q[1], q[2], q[3]}; ((GAS f32x4*)(of + ro) + 2 * lane)[128 * j + 1] = (f32x4){q[4], q[5], q[6], q[7]}; }
            if (ob) ((GAS v4u*)(ob + ro) + lane)[64 * j] = (v4u){pk2(q[0], q[1]), pk2(q[2], q[3]), pk2(q[4], q[5]), pk2(q[6], q[7])}; }
        if (o8) {
#pragma unroll
            for (int o2 = 1; o2 < 64; o2 <<= 1) am = fmaxf(am, shx(am, o2, lane));
            const float inv = am > 0.f ? 127.0f / am : 0.f;
#pragma unroll
            for (int j = 0; j < 4; ++j) *(LAS v2u*)(scr + 2 * (64 * j + lane)) = (v2u){pk4_i8c(v[k][j][0] * inv, v[k][j][1] * inv, v[k][j][2] * inv, v[k][j][3] * inv), pk4_i8c(v[k][j][4] * inv, v[k][j][5] * inv, v[k][j][6] * inv, v[k][j][7] * inv)};
            { const v4u a4 = *(const LAS v4u*)(scr + 4 * lane), b4q = *(const LAS v4u*)(scr + 256 + 4 * lane); ((GAS v4u*)(o8 + ro))[lane] = a4; ((GAS v4u*)(o8 + ro))[64 + lane] = b4q; }
            if (lane == 0) ((GAS float*)sx)[ro / D] = am * (1.0f / 127.0f); }
    }
}
#if defined(GAT_PMASK)
#define GAT_PM(R) (rep + 1 < (R) ? (unsigned)GAT_PMASK : 0x3fffu)
#else
#define GAT_PM(R) 0xffffffffu
#endif
#define GAT_FETCH4(rs, voff, soff) __builtin_amdgcn_raw_buffer_load_b128(rs, (int)(voff), soff, 0)
#define GAT_ACC(c, d) c = __builtin_fmaf(d.x, wq.x, __builtin_fmaf(d.y, wq.y, __builtin_fmaf(d.z, wq.z, __builtin_fmaf(d.w, wq.w, c))))
#define GAT_A8(a4) __builtin_shufflevector(a4, a4, 0, 1, 2, 3, -1, -1, -1, -1)
__device__ __forceinline__ void gat_u_mfma(float (&ccur)[8], float (&cprev)[8], f32x4 (&dp)[2], i32x4 (&A)[16], const i32x4 b1h, const i32x4 b2h, const i32x4 b1l, const i32x4 b2l, const LAS unsigned* enx, __amdgpu_buffer_rsrc_t rs, int soffn,
                                           const unsigned pofs, const f32x4 wq, const int s127, const int s125, const unsigned pm = 0xffffffffu) {
    v2u en0 = *(const LAS v2u*)(enx), en1 = *(const LAS v2u*)(enx + 16);
    f32x4 d0 = dp[0], d1 = dp[1];
#pragma unroll
    for (int g = 0; g < 8; ++g) {
        const v2u en2 = *(const LAS v2u*)(enx + ((g + 2) & 7) * 16);
        f32x4 d = __builtin_amdgcn_mfma_scale_f32_16x16x128_f8f6f4(GAT_A8(A[2 * g]), GAT_A8(b1h), (f32x4){0.f, 0.f, 0.f, 0.f}, 4, 4, 0, s127, 0, s127);
        d = __builtin_amdgcn_mfma_scale_f32_16x16x128_f8f6f4(GAT_A8(A[2 * g + 1]), GAT_A8(b2h), d, 4, 4, 0, s127, 0, s127);
        d = __builtin_amdgcn_mfma_scale_f32_16x16x128_f8f6f4(GAT_A8(A[2 * g]), GAT_A8(b1l), d, 4, 4, 0, s127, 0, s125);
        d = __builtin_amdgcn_mfma_scale_f32_16x16x128_f8f6f4(GAT_A8(A[2 * g + 1]), GAT_A8(b2l), d, 4, 4, 0, s127, 0, s125);
        A[2 * g] = __builtin_bit_cast(i32x4, GAT_FETCH4(rs, ((en0.x & pm) << 7) + pofs, soffn)); A[2 * g + 1] = __builtin_bit_cast(i32x4, GAT_FETCH4(rs, ((en0.y & pm) << 7) + pofs, soffn));
        if (g == 0) GAT_ACC(cprev[6], d0); else if (g == 1) GAT_ACC(cprev[7], d0); else GAT_ACC(ccur[g - 2], d0);
        d0 = d1; d1 = d; en0 = en1; en1 = en2;
        __builtin_amdgcn_sched_barrier(0);
    }
    dp[0] = d0; dp[1] = d1;
}
__device__ __forceinline__ float quad_sum(float v) {
    v += __builtin_bit_cast(float, __builtin_amdgcn_update_dpp(0, __builtin_bit_cast(int, v), 0xB1, 0xf, 0xf, false));
    v += __builtin_bit_cast(float, __builtin_amdgcn_update_dpp(0, __builtin_bit_cast(int, v), 0x4E, 0xf, 0xf, false));
    return v;
}
__device__ __forceinline__ f32x2 gat_v_step8(const float (&act)[16], float (&actn)[16], const LAS float* apn, v4u (&w)[16], const LAS unsigned* enx, __amdgpu_buffer_rsrc_t rs, int soffn, const unsigned jofs, int lane, const unsigned pm = 0xffffffffu) {
    f32x2 acc[8];
#pragma unroll
    for (int p = 0; p < 8; ++p) acc[p] = (f32x2){0.f, 0.f};
    v4u e0 = *(const LAS v4u*)(enx), e1 = e0;
#pragma unroll
    for (int i = 0; i < 16; ++i) { const f32x2 aa = {act[i], act[i]};
        if ((i & 3) == 0 && i < 12) e1 = *(const LAS v4u*)(enx + i + 4);
        if ((i & 3) == 1) { const f32x4 a4 = *(const LAS f32x4*)(apn + (i >> 2) * 4); actn[(i >> 2) * 4] = a4.x; actn[(i >> 2) * 4 + 1] = a4.y; actn[(i >> 2) * 4 + 2] = a4.z; actn[(i >> 2) * 4 + 3] = a4.w; }
#pragma unroll
        for (int c = 0; c < 4; ++c) { const f32x2 lo = __builtin_amdgcn_cvt_pk_f32_fp8((int)w[i][c], false), hi = __builtin_amdgcn_cvt_pk_f32_fp8((int)w[i][c], true);
            acc[2 * c] = __builtin_elementwise_fma(lo, aa, acc[2 * c]); acc[2 * c + 1] = __builtin_elementwise_fma(hi, aa, acc[2 * c + 1]); }
        asm volatile("" : "+v"(acc[0]), "+v"(acc[1]), "+v"(acc[2]), "+v"(acc[3]), "+v"(acc[4]), "+v"(acc[5]), "+v"(acc[6]), "+v"(acc[7]) :: "memory");
        GAT_FETCHV(w[i], rs, ((e0[i & 3] & pm) << 7) + jofs, soffn);
        if ((i & 3) == 3) e0 = e1;
        __builtin_amdgcn_sched_barrier(0);
    }
    const bool b3 = lane & 8, b4 = lane & 16, b5 = lane & 32;
    f32x2 ka[4], kb[2];
#pragma unroll
    for (int i = 0; i < 4; ++i) { const f32x2 keep = b3 ? acc[4 + i] : acc[i], send = b3 ? acc[i] : acc[4 + i]; ka[i] = keep + shx2(send, 8, lane); }
#pragma unroll
    for (int i = 0; i < 2; ++i) { const f32x2 keep = b4 ? ka[2 + i] : ka[i], send = b4 ? ka[i] : ka[2 + i]; kb[i] = keep + shx2(send, 16, lane); }
    const f32x2 keep = b5 ? kb[1] : kb[0], send = b5 ? kb[0] : kb[1];
    return keep + shx2(send, 32, lane);
}
__device__ __forceinline__ void peer_chunked(const unsigned char* utab, const unsigned char* vtab, const float* su, const float* sv, const int* eidx, const float* gate, const bf16* xres, const unsigned char* x8h,
                                             float* ybuf, const float* lng, const float* lnb, float* of, bf16* ob, unsigned char* o8, float* sx8, int gw, int NGW, LAS unsigned* vol, LAS unsigned* vids, const unsigned emask = 0x3fffu) {
    const __amdgpu_buffer_rsrc_t rsxh = __builtin_amdgcn_make_buffer_rsrc((void*)x8h, (short)0, M_TOK * (D / 2), 0x00020000), rsxl = __builtin_amdgcn_make_buffer_rsrc((void*)(x8h + (size_t)M_TOK * (D / 2)), (short)0, M_TOK * (D / 2), 0x00020000);
    const __amdgpu_buffer_rsrc_t rsy = __builtin_amdgcn_make_buffer_rsrc((void*)ybuf, (short)0, M_TOK * D * 2, 0x00020000);
    const __amdgpu_buffer_rsrc_t rsu = __builtin_amdgcn_make_buffer_rsrc((void*)utab, (short)0, NEXP * (D / 2), 0x00020000), rsv = __builtin_amdgcn_make_buffer_rsrc((void*)vtab, (short)0, NEXP * (D / 2), 0x00020000);
    LAS unsigned* et = vol; LAS float* actl = (LAS float*)(vol + 1024);
    {   int zz = 0; asm volatile("" : "+s"(zz));
        const int lane = __builtin_amdgcn_mbcnt_hi(-1, __builtin_amdgcn_mbcnt_lo(-1, zz));
#pragma unroll
        for (int q = 0; q < 8; ++q) { const v2u v = *(const GAS v2u*)(eidx + (size_t)(gw + q * NGW) * NSEL + 2 * lane); *(LAS v2u*)(et + q * 128 + 2 * lane) = (v2u){v.x & emask, v.y & emask}; }
        asm volatile("s_waitcnt lgkmcnt(0)" ::: "memory");
    }
    float osc[8];
#ifdef GAT_UREP
#pragma nounroll
    for (int rep = 0; rep < GAT_UREP; ++rep)
#endif
    {   int zz = 0; asm volatile("" : "+s"(zz));
        const int lu = __builtin_amdgcn_mbcnt_hi(-1, __builtin_amdgcn_mbcnt_lo(-1, zz));
        const int kbu = lu >> 4, q4 = lu & 3;
        const LAS unsigned* eu = et + 4 * ((lu >> 2) & 3) + 2 * (kbu >> 1);
        const unsigned pofs = (unsigned)(4 * (kbu & 1) + q4) * 16u;
        const bool bon = (kbu >> 1) == ((lu >> 3) & 1);
        const int m1 = (bon && ((lu >> 2) & 1) == 0) ? -1 : 0, m2 = (bon && ((lu >> 2) & 1) == 1) ? -1 : 0;
        int s127 = 127, s125 = 125; asm volatile("" : "+v"(s127), "+v"(s125));
        f32x4 wq = {q4 == 0 ? 1.f : 0.f, q4 == 1 ? 1.f : 0.f, q4 == 2 ? 1.f : 0.f, q4 == 3 ? 1.f : 0.f}; asm volatile("" : "+v"(wq));
        float cacc[8][8]; f32x4 dp[2] = {{0.f, 0.f, 0.f, 0.f}, {0.f, 0.f, 0.f, 0.f}};
#pragma unroll
        for (int q = 0; q < 8; ++q)
#pragma unroll
            for (int g = 0; g < 8; ++g) cacc[q][g] = 0.f;
        i32x4 A[16], xh0, xl0, xh1, xl1;
#define GAT_XLOAD8(dh, dl, q, cc) do { dh = __builtin_bit_cast(i32x4, __builtin_amdgcn_raw_buffer_load_b128(rsxh, (gw + (q) * NGW) * (D / 2) + (int)pofs, (cc) * 128, 0)); dl = __builtin_bit_cast(i32x4, __builtin_amdgcn_raw_buffer_load_b128(rsxl, (gw + (q) * NGW) * (D / 2) + (int)pofs, (cc) * 128, 0)); } while (0)
#define GAT_BUILD(b, r, m) const i32x4 b = {r[0] & m, r[1] & m, r[2] & m, r[3] & m}
#define GAT_USTEP(q, qn, cc, xhc, xlc, xhn, xln) { GAT_XLOAD8(xhn, xln, qn, cc); GAT_BUILD(b1h, xhc, m1); GAT_BUILD(b2h, xhc, m2); GAT_BUILD(b1l, xlc, m1); GAT_BUILD(b2l, xlc, m2); \
            gat_u_mfma(cacc[q], cacc[((q) + 7) & 7], dp, A, b1h, b2h, b1l, b2l, eu + (qn) * 128, rsu, (cc) * CHUNK_STRIDE, pofs, wq, s127, s125, GAT_PM(GAT_UREP)); }
        GAT_XLOAD8(xh0, xl0, 0, 0);
#pragma unroll
        for (int g = 0; g < 8; ++g) { const v2u en = *(const LAS v2u*)(eu + g * 16);
            A[2 * g] = __builtin_bit_cast(i32x4, GAT_FETCH4(rsu, (en.x << 7) + pofs, 0)); A[2 * g + 1] = __builtin_bit_cast(i32x4, GAT_FETCH4(rsu, (en.y << 7) + pofs, 0)); }
#pragma nounroll
        for (int c = 0; c < 8; ++c) {
            const int cn = c < 7 ? c + 1 : 7;
            GAT_USTEP(0, 1, c, xh0, xl0, xh1, xl1) GAT_USTEP(1, 2, c, xh1, xl1, xh0, xl0) GAT_USTEP(2, 3, c, xh0, xl0, xh1, xl1) GAT_USTEP(3, 4, c, xh1, xl1, xh0, xl0)
            GAT_USTEP(4, 5, c, xh0, xl0, xh1, xl1) GAT_USTEP(5, 6, c, xh1, xl1, xh0, xl0) GAT_USTEP(6, 7, c, xh0, xl0, xh1, xl1) GAT_USTEP(7, 0, cn, xh1, xl1, xh0, xl0)
        }
        GAT_ACC(cacc[7][6], dp[0]); GAT_ACC(cacc[7][7], dp[1]);
        const int ei = lu >> 2;
        LAS unsigned char* codes = (LAS unsigned char*)vol + 4096;
#pragma unroll
        for (int q = 0; q < 8; ++q) {
            float pe = 0.f, po = 0.f;
#pragma unroll
            for (int g = 0; g < 8; ++g) { const float s = quad_sum(cacc[q][g]);
                if (g & 1) po = (q4 == (g >> 1)) ? s : po; else pe = (q4 == (g >> 1)) ? s : pe; }
            const int pb = (2 * q4) * 16 + ei;
            const unsigned e0 = et[q * 128 + pb], e1 = et[q * 128 + pb + 16];
            const GAS float* gp = (const GAS float*)(gate + (size_t)(gw + q * NGW) * NSEL + pb);
            const float g0 = gp[0], g1 = gp[16];
            const float a0 = g0 * pg8::gelu_tanh(pe * (((const GAS float*)su)[e0] * (1.0f / X4_SCALE))) * ((const GAS float*)sv)[e0], a1 = g1 * pg8::gelu_tanh(po * (((const GAS float*)su)[e1] * (1.0f / X4_SCALE))) * ((const GAS float*)sv)[e1];
            float mx = fmaxf(fabsf(a0), fabsf(a1));
#pragma unroll
            for (int o = 1; o < 64; o <<= 1) mx = fmaxf(mx, shx(mx, o, lu));
            const float sc = mx > 0.f ? 6.0f / mx : 0.f;
            osc[q] = __builtin_bit_cast(float, __builtin_amdgcn_readfirstlane(__builtin_bit_cast(int, mx * (1.0f / 6.0f))));
            const float t0 = a0 * sc, t1 = a1 * sc;
            const unsigned ch = __builtin_amdgcn_cvt_scalef32_pk_fp4_f32(0u, t0, t1, 1.0f, 0); const auto vh = __builtin_amdgcn_cvt_scalef32_pk_f32_fp4(ch, 1.0f, 0);
            const float r0 = (t0 - vh[0]) * 4.0f, r1 = (t1 - vh[1]) * 4.0f;
            const unsigned cm = __builtin_amdgcn_cvt_scalef32_pk_fp4_f32(0u, r0, r1, 1.0f, 0); const auto vm = __builtin_amdgcn_cvt_scalef32_pk_f32_fp4(cm, 1.0f, 0);
            const unsigned cl = __builtin_amdgcn_cvt_scalef32_pk_fp4_f32(0u, (r0 - vm[0]) * 4.0f, (r1 - vm[1]) * 4.0f, 1.0f, 0);
            LAS unsigned char* cq = codes + q * 384 + pb;
            cq[0] = (unsigned char)(ch & 15u); cq[16] = (unsigned char)((ch >> 4) & 15u); cq[128] = (unsigned char)(cm & 15u); cq[144] = (unsigned char)((cm >> 4) & 15u);
            cq[256] = (unsigned char)(cl & 15u); cq[272] = (unsigned char)((cl >> 4) & 15u);
        }
        {   const int qq = lu >> 3, r8 = lu & 7; unsigned pk[8];
#pragma unroll
            for (int k = 0; k < 8; ++k) pk[k] = et[qq * 128 + 16 * k + r8] | (et[qq * 128 + 16 * k + 8 + r8] << 16);
            *(LAS v4u*)(vids + lu * 8) = (v4u){pk[0], pk[1], pk[2], pk[3]}; *(LAS v4u*)(vids + lu * 8 + 4) = (v4u){pk[4], pk[5], pk[6], pk[7]}; }
        {   const int mrow = lu & 15, kbv = lu >> 4;
            const LAS unsigned char* cb = (const LAS unsigned char*)vol + 4096 + (mrow < 3 ? mrow : 2) * 128 + kbv * 32;
#pragma unroll
            for (int q = 0; q < 8; ++q) { const v4u c0 = *(const LAS v4u*)(cb + q * 384), c1 = *(const LAS v4u*)(cb + q * 384 + 16); unsigned h[8];
#pragma unroll
                for (int k = 0; k < 8; ++k) { const unsigned w = k < 4 ? c0[k] : c1[k - 4]; const unsigned t = (w | (w >> 4)) & 0x00ff00ffu; h[k] = (t | (t >> 8)) & 0xffffu; }
                *(LAS v4u*)((LAS unsigned char*)vids + 2048 + q * 192 + (mrow < 3 ? mrow : 2) * 64 + kbv * 16) = (v4u){h[0] | (h[1] << 16), h[2] | (h[3] << 16), h[4] | (h[5] << 16), h[6] | (h[7] << 16)}; }
        }
        __builtin_amdgcn_sched_barrier(0);
    }
#ifdef GAT_VREP
#pragma nounroll
    for (int rep = 0; rep < GAT_VREP; ++rep)
#endif
    {   int zz = 0; asm volatile("" : "+s"(zz));
        const int lv = __builtin_amdgcn_mbcnt_hi(-1, __builtin_amdgcn_mbcnt_lo(-1, zz));
        const int r8 = lv >> 3, kbv = lv >> 4, mrow = lv & 15;
        const unsigned pofsE = 16u * (unsigned)((lv & 7) ^ (r8 >> 1)), pofsO = pofsE ^ 64u;
        const unsigned ringa = (unsigned)(size_t)(LAS unsigned char*)vol;
        const unsigned idsa = (unsigned)(size_t)(LAS unsigned char*)vids + (unsigned)r8 * 32u;
        const unsigned apx = (((ringa + (unsigned)mrow * 128u) | (16u * (unsigned)(mrow >> 1))) ^ (16u * (unsigned)(kbv >> 1))) + 8u * (unsigned)(kbv & 1);
        const int term = mrow & 3;
        const unsigned keep = (term < 3 && (mrow >> 2) == kbv) ? 0xffffffffu : 0u;
        const unsigned acta = (unsigned)(size_t)(LAS unsigned char*)vids + 2048u + (unsigned)(term < 3 ? term : 2) * 64u;
        int sA = 127 - 2 * (term < 2 ? term : 2), s127 = 127; asm volatile("" : "+v"(sA), "+v"(s127));
        asm volatile("s_waitcnt lgkmcnt(0)" ::: "memory");
        __builtin_amdgcn_sched_barrier(0);
        v4u idn0, idn1;
#define GATV_IDS(d0, d1, q) asm volatile("ds_read_b128 %0, %2\n\tds_read_b128 %1, %2 offset:16\n\ts_waitcnt lgkmcnt(0)" : "=&v"(d0), "=&v"(d1) : "v"(idsa + (unsigned)(q) * 256u) : "memory")
#define GATV_ACT(d, q) do { asm volatile("ds_read_b128 %0, %4\n\tds_read_b128 %1, %4 offset:16\n\tds_read_b128 %2, %4 offset:32\n\tds_read_b128 %3, %4 offset:48\n\ts_waitcnt lgkmcnt(0)" : "=&v"(d[0]), "=&v"(d[1]), "=&v"(d[2]), "=&v"(d[3]) : "v"(acta + (unsigned)(q) * 192u) : "memory"); \
            _Pragma("unroll") for (int u_ = 0; u_ < 4; ++u_) d[u_] = (v4u){d[u_].x & keep, d[u_].y & keep, d[u_].z & keep, d[u_].w & keep}; } while (0)
#define GATV_ID(d0, d1, k) ((((k) < 8 ? d0[(k) >> 1] : d1[((k) - 8) >> 1]) >> (16 * ((k) & 1))) & 0xffffu)
#define GATV_DMA(u, d0, d1, soff) do { _Pragma("unroll") for (int w_ = 0; w_ < 4; ++w_) \
            __builtin_amdgcn_raw_ptr_buffer_load_lds(rsv, (LAS void*)((LAS unsigned char*)vol + (u) * 4096 + w_ * 1024), 16, (int)(((GATV_ID(d0, d1, (u) * 4 + w_) & GAT_PM(GAT_VREP)) << 7) + ((w_ & 1) ? pofsO : pofsE)), soff, 0, 0); } while (0)
#define GATV_TR(dst, areg, off) asm volatile("ds_read_b64_tr_b4 %0, %1 offset:%2" : "=v"(dst) : "v"(areg), "i"(off))
#define GATV_RD(r, u, g) do { unsigned a0_ = apx ^ (32u * (g)); asm volatile("" : "+v"(a0_));        \
            GATV_TR(r[0], a0_, (u) * 4096); GATV_TR(r[1], a0_, (u) * 4096 + 2048); } while (0)
#define GATV_WAIT(r, n) asm volatile("s_waitcnt lgkmcnt(" #n ")" : "+v"(r[0]), "+v"(r[1]) :: "memory")
#define GATV_MM(r, u, g, au) do { const i32x4 b_ = {(int)r[0].x, (int)r[0].y, (int)r[1].x, (int)r[1].y}; \
            acc[g] = __builtin_amdgcn_mfma_scale_f32_16x16x128_f8f6f4(GAT_A8(au), GAT_A8(b_), (u) == 0 ? (f32x4){0.f, 0.f, 0.f, 0.f} : acc[g], 4, 4, 0, sA, 0, s127); } while (0)
#define GATV_UNIT(u, aq, d0, d1, soffn) { asm volatile("s_waitcnt vmcnt(12)" ::: "memory"); \
            GATV_RD(ra, u, 0); GATV_RD(rb, u, 1); GATV_RD(rc, u, 2); GATV_RD(rd, u, 3); const i32x4 au_ = {(int)aq[u].x, (int)aq[u].y, (int)aq[u].z, (int)aq[u].w}; \
            GATV_WAIT(ra, 6); GATV_MM(ra, u, 0, au_); GATV_WAIT(rb, 4); GATV_MM(rb, u, 1, au_); GATV_WAIT(rc, 2); GATV_MM(rc, u, 2, au_); GATV_WAIT(rd, 0); GATV_MM(rd, u, 3, au_); \
            __builtin_amdgcn_sched_barrier(0); GATV_DMA(u, d0, d1, soffn); __builtin_amdgcn_sched_barrier(0); }
#define GATV_STEP(q, qn, cc, ccn, in0, in1) { GATV_IDS(in0, in1, qn); v4u aq_[4]; GATV_ACT(aq_, q); \
            GATV_UNIT(0, aq_, in0, in1, (ccn) * CHUNK_STRIDE) GATV_UNIT(1, aq_, in0, in1, (ccn) * CHUNK_STRIDE) GATV_UNIT(2, aq_, in0, in1, (ccn) * CHUNK_STRIDE) GATV_UNIT(3, aq_, in0, in1, (ccn) * CHUNK_STRIDE) \
            { float o_[4]; _Pragma("unroll") for (int g_ = 0; g_ < 4; ++g_) o_[g_] = ((acc[g_].x + acc[g_].y) + acc[g_].z) * osc[q]; \
              __builtin_amdgcn_raw_buffer_store_b64((v2u){pg8::cvt_pk_bf16(o_[0], o_[1]), pg8::cvt_pk_bf16(o_[2], o_[3])}, rsy, sto, (gw + (q) * NGW) * (D * 2) + (cc) * 512, 0); } \
            __builtin_amdgcn_sched_barrier(0); }
        f32x4 acc[4]; v2u ra[2], rb[2], rc[2], rd[2];
        const int sto = (lv & 15) * 32 + kbv * 8;
        GATV_IDS(idn0, idn1, 0);
        GATV_DMA(0, idn0, idn1, 0); GATV_DMA(1, idn0, idn1, 0); GATV_DMA(2, idn0, idn1, 0); GATV_DMA(3, idn0, idn1, 0);
#pragma nounroll
        for (int c = 0; c < 8; ++c) {
            const int cn = c < 7 ? c + 1 : 7;
            GATV_STEP(0, 1, c, c, idn0, idn1) GATV_STEP(1, 2, c, c, idn0, idn1) GATV_STEP(2, 3, c, c, idn0, idn1) GATV_STEP(3, 4, c, c, idn0, idn1)
            GATV_STEP(4, 5, c, c, idn0, idn1) GATV_STEP(5, 6, c, c, idn0, idn1) GATV_STEP(6, 7, c, c, idn0, idn1) GATV_STEP(7, 0, c, cn, idn0, idn1)
        }
    }
    asm volatile("s_waitcnt vmcnt(0)" ::: "memory");
    __builtin_amdgcn_fence(__ATOMIC_ACQUIRE, "agent");
#pragma nounroll
    for (int k = 0; k < 2; ++k) { int zz = 0; asm volatile("" : "+s"(zz));
        const int ll = __builtin_amdgcn_mbcnt_hi(-1, __builtin_amdgcn_mbcnt_lo(-1, zz));
        ln_res_rows<4>(xres, (const bf16*)ybuf, lng, lnb, of, ob, o8, sx8, (size_t)(gw + 4 * k * NGW) * D, (size_t)NGW * D, ll, vol); }
}

template <int W> __device__ __forceinline__ void pool_item(const GAS v4u* hp, GAS v4u* op, int pos0) {
    constexpr int NR = 7 + W;
    v4u r[NR];
    const bool head = pos0 == 0;
#pragma unroll
    for (int k = 0; k < NR; ++k) { const int rel = k - (W - 1);
        const bool ok = rel >= 0 || (!head && (pos0 + rel >= 0));
        r[k] = ok ? hp[(long)rel * (D / 8)] : (v4u){0u, 0u, 0u, 0u}; }
    float run[8];
#pragma unroll
    for (int e = 0; e < 8; ++e) run[e] = 0.f;
#pragma unroll
    for (int k = 0; k < W - 1; ++k) { run[0] += bflo(r[k].x); run[1] += bfhi(r[k].x); run[2] += bflo(r[k].y); run[3] += bfhi(r[k].y); run[4] += bflo(r[k].z); run[5] += bfhi(r[k].z); run[6] += bflo(r[k].w); run[7] += bfhi(r[k].w); }
#pragma unroll
    for (int i = 0; i < 8; ++i) { const v4u c = r[W - 1 + i];
        const float cv[8] = {bflo(c.x), bfhi(c.x), bflo(c.y), bfhi(c.y), bflo(c.z), bfhi(c.z), bflo(c.w), bfhi(c.w)};
#pragma unroll
        for (int e = 0; e < 8; ++e) run[e] += cv[e];
        const int pos = pos0 + i; const int cnt = pos + 1 < W ? pos + 1 : W; const float ic = 1.0f / (float)cnt;
        v4u o; o.x = pk2(run[0] * ic - cv[0], run[1] * ic - cv[1]); o.y = pk2(run[2] * ic - cv[2], run[3] * ic - cv[3]); o.z = pk2(run[4] * ic - cv[4], run[5] * ic - cv[5]); o.w = pk2(run[6] * ic - cv[6], run[7] * ic - cv[7]);
        op[(long)i * (D / 8)] = o;
        const v4u d = r[i];
        run[0] -= bflo(d.x); run[1] -= bfhi(d.x); run[2] -= bflo(d.y); run[3] -= bfhi(d.y); run[4] -= bflo(d.z); run[5] -= bfhi(d.z); run[6] -= bflo(d.w); run[7] -= bfhi(d.w); }
}

#ifndef PHMASK
#define PHMASK 0xFFFFFFFFu
#endif
#define PHON(k) ((PHMASK >> (k)) & 1u)
#define x_in KARG(const float*, 0)
#define a_w_in KARG(const float*, 8)
#define a_b_in KARG(const float*, 16)
#define a_v_g KARG(const float*, 24)
#define a_v_b KARG(const float*, 32)
#define a_w_s KARG(const float*, 40)
#define a_b_s KARG(const float*, 48)
#define a_w_out KARG(const float*, 56)
#define b_w_in KARG(const float*, 64)
#define b_w_grp KARG(const float*, 72)
#define b_b_grp KARG(const float*, 80)
#define b_scale KARG(const float*, 88)
#define b_w_out KARG(const float*, 96)
#define ln_mix_g KARG(const float*, 104)
#define ln_mix_b KARG(const float*, 112)
#define ln_ffn_g KARG(const float*, 120)
#define ln_ffn_b KARG(const float*, 128)
#define peer_wq KARG(const float*, 136)
#define peer_sk KARG(const float*, 144)
#define peer_u KARG(const float*, 152)
#define peer_v KARG(const float*, 160)
#define W1I ((unsigned char*)(ws + WS_W1T))
#define XI0 ((unsigned char*)(ws + WS_XF))
#define SX0 ((float*)(ws + WS_SX0))
#define W2F ((unsigned char*)(ws + WS_W2T))
#define GF ((unsigned char*)(ws + WS_X1))
#define BINI ((unsigned char*)(ws + WS_BINT))
#define BOUTF ((unsigned char*)(ws + WS_BOUTT))
#define MIXED8 ((unsigned char*)(ws + WS_MIXED))
#define WQB ((bf16*)(ws + WS_WQT))
#define WQS ((bf16*)(ws + WS_WQS))
#define WQSI ((unsigned char*)(ws + WS_WQT))
#define SW ((float*)(ws + WS_SV + 131072))
#define BGT ((bf16*)(ws + WS_BGT))
#define BD ((bf16*)(ws + WS_BD))
#define BDSK ((bf16*)(ws + WS_BDSK))
#define XB ((bf16*)(ws + WS_XB))
#define UT ((unsigned char*)(ws + WS_UT))
#define SU ((float*)(ws + WS_SU))
#define SV ((float*)(ws + WS_SV))
#define VTAB ((unsigned char*)(ws + WS_VTAB))
#define UG ((bf16*)(ws + WS_UG))
#define ST ((float*)(ws + WS_ST))
#define POOL ((bf16*)(ws + WS_POOL))
#define MIXED ((bf16*)(ws + WS_MIXED))
#define VT ((bf16*)(ws + WS_VT))
#define Q ((bf16*)(ws + WS_Q))
#define X8H ((unsigned char*)(ws + WS_Q))
#define H ((bf16*)(ws + WS_H))
#define Y ((float*)(ws + WS_Y))
#define X1 ((float*)(ws + WS_X1))
#define EIDX ((int*)(ws + WS_EIDX))
#define GATE ((float*)(ws + WS_GATE))
struct Args { const float* in[21]; float* out; unsigned char* ws; int ph_lo, ph_hi; };
__global__ void __launch_bounds__(NTHREADS, 2) mega_fwd(Args args) {
    extern __shared__ __attribute__((aligned(16))) unsigned char lds_raw[];
    LAS unsigned char* lds = (LAS unsigned char*)lds_raw;
    volatile LAS unsigned* MISC = (volatile LAS unsigned*)(lds + MISC_OFF);
    typedef const char __attribute__((address_space(4)))* kap_t;
#define KARG(T, off) (*(T const __attribute__((address_space(4)))*)(ka + (off)))
#define PH_BEGIN kap_t ka = (kap_t)__builtin_amdgcn_kernarg_segment_ptr(); asm volatile("" : "+s"(ka)); unsigned char* ws = KARG(unsigned char*, 176); asm volatile("" : "+s"(ws));
#define OUT_PTR KARG(float*, 168)
#define IDX_BEGIN int bx = blockIdx.x, G = gridDim.x, wave = wave0, zero = 0; asm volatile("" : "+s"(bx), "+s"(G), "+s"(wave), "+s"(zero)); \
        const int lane = __builtin_amdgcn_mbcnt_hi(-1, __builtin_amdgcn_mbcnt_lo(-1, zero)), tid = wave * 64 + lane; \
        const int vcu = (G % 8 == 0) ? (bx % 8) * (G / 8) + bx / 8 : bx; const int gw = vcu * NWAVES + wave, NGW = G * NWAVES; (void)tid; (void)gw; (void)NGW; (void)vcu; (void)lane;
    for (int u = threadIdx.x; u < (LDS_BYTES - LDSCTL_OFF) / 4; u += NTHREADS) ((LAS unsigned*)(lds + LDSCTL_OFF))[u] = 0u;
    __syncthreads();
    int lo, hi; unsigned xcc; const int wave0 = __builtin_amdgcn_readfirstlane(threadIdx.x >> 6);
    { PH_BEGIN; lo = KARG(int, 184); hi = KARG(int, 188);
      xcc = xb_xcc_id();
      if (!MK_PER_PHASE && threadIdx.x == 0) (void)xb_add((unsigned*)(ws + WS_CTL) + CW_BAR + XB_XCNT(xcc), 1u); }
#pragma nounroll
    for (int ph = lo; ph < hi; ++ph) {
        const int ly = ph >= 13 ? 1 : 0;
        const int pk = ph >= 17 ? 14 : (ph >= 13 ? ph - 8 : ph);
#ifdef RPT_MASK
        for (int rep = 0; rep < (((RPT_MASK >> ph) & 1u) ? 2 : 1); ++rep)
#endif
        switch (pk) {
        case 0: if (PHON(0)) { PH_BEGIN; IDX_BEGIN;
            LAS float* scr = (LAS float*)(lds + RING_OFF + wave * 16384);
            constexpr int I_W1 = (D / 64) * (FFA / 32), I_W2 = (HA / 64) * (D / 32), I_SQ = (D / 64) * (D / 32), I_G = (512 / 64) * (512 / 32);
            constexpr int NITEMS = I_W1 + I_W2 + 2 * I_SQ + 4 * I_G;
            for (int it = gw; it < NITEMS; it += NGW) {
                int r = it;
                if (r < I_W1) { p0_transpose_item8<true>(a_w_in, D, FFA, W1I, W1_SCALE, scr, r, lane); continue; } r -= I_W1;
                if (r < I_W2) { p0_transpose_item8<false>(a_w_out, HA, D, W2F, W2_SCALE, scr, r, lane); continue; } r -= I_W2;
                if (r < I_SQ) { p0_transpose_item8<true>(b_w_in, D, D, BINI, W1_SCALE, scr, r, lane); continue; } r -= I_SQ;
                if (r < I_SQ) { p0_transpose_item8<false>(b_w_out, D, D, BOUTF, W2_SCALE, scr, r, lane); continue; } r -= I_SQ;
                { const int g = r / I_G; p0_transpose_item(b_w_grp + (size_t)g * 512 * 512, 512, 512, BGT + (size_t)g * 512 * 512, scr, r % I_G, lane); }
            }
            for (int m = gw; m < M_TOK; m += 4 * NGW) rows_to_i8<4>(x_in, XI0, SX0, m, NGW, lane);
            p0_convert(peer_wq, WQB, 2 * D * D / 512, gw, NGW, lane);
            for (int r = gw; r < 2 * NEXP; r += 2 * NGW) { const int r1 = r + NGW, la = r >= NEXP ? 1 : 0, lb = r1 >= NEXP ? 1 : 0;
                const float* const s2[2] = {peer_u + (size_t)r * D, peer_u + (size_t)r1 * D}; unsigned char* const d2[2] = {UT + (size_t)la * NEXP * (D / 2), UT + (size_t)lb * NEXP * (D / 2)};
                const int e2[2] = {r - la * NEXP, r1 - lb * NEXP}; float* const c2[2] = {SU + r, SU + r1};
                p0_row_fp4<2>(s2, d2, e2, c2, lane); }
            for (int r = gw; r < 2 * NEXP; r += 2 * NGW) { const int r1 = r + NGW, la = r >= NEXP ? 1 : 0, lb = r1 >= NEXP ? 1 : 0;
                const float* const s2[2] = {peer_v + (size_t)r * D, peer_v + (size_t)r1 * D}; unsigned char* const d2[2] = {VTAB + (size_t)la * NEXP * (D / 2), VTAB + (size_t)lb * NEXP * (D / 2)};
                const int e2[2] = {r - la * NEXP, r1 - lb * NEXP}; float* const c2[2] = {SV + r, SV + r1};
                p0_row_fp4t<2>(s2, d2, e2, c2, (LAS unsigned char*)scr, lane); }
            for (int i0 = gw * 64 + lane; i0 < NGA * 65536; i0 += 8 * NGW * 64) { float wv[8];
#pragma unroll
                for (int k = 0; k < 8; ++k) { int i = i0 + k * NGW * 64; i = i < NGA * 65536 ? i : NGA * 65536 - 1; const int h = i >> 16, t = (i >> 8) & 127, s = i & 127;
                    wv[k] = ((const GAS float*)a_w_s)[(h * 128 + t) * 128 + s]; }
                asm volatile("" : "+v"(wv[0]), "+v"(wv[1]), "+v"(wv[2]), "+v"(wv[3]), "+v"(wv[4]), "+v"(wv[5]), "+v"(wv[6]), "+v"(wv[7]));
#pragma unroll
                for (int k = 0; k < 8; ++k) { const int i = i0 + k * NGW * 64; const int tp = (i >> 8) & 255, sp = i & 255;
                    const float v = ((tp >> 7) == (sp >> 7) && (sp & 127) <= (tp & 127)) ? wv[k] : 0.f; if (i < NGA * 65536) ((GAS bf16*)BD)[i] = (bf16)f2bf(v); } }
            for (int i = gw * 64 + lane; i < 2 * 65536; i += NGW * 64) { const int l2 = i >> 16, r = (i >> 8) & 255, c = i & 255;
                const float kv = ((const GAS float*)peer_sk)[((l2 * 2 + (r >> 7)) * 128 + (r & 127)) * 128 + (c & 127)];
                const float v = ((r >> 7) == (c >> 7)) ? kv : 0.f; ((GAS bf16*)BDSK)[i] = (bf16)f2bf(v); }
        } break;
        case 1: if (PHON(1)) { PH_BEGIN; IDX_BEGIN;
            { pg8::AddrScores g{BDSK, WQB, 256, D, 256}; pg8::StaticOrder S; S.init(2 * D, D, G, bx); pg8::EpiBf16<0> E{WQS, D, nullptr, nullptr, nullptr};
              pg8::gemm_phase<pg8::EpiBf16<0>, pg8::AddrScores, pg8::StaticOrder, true, true>(lds + RING_OFF, g, S, E, tid); }
#ifdef G1_STAGGER
            { const int xs_ = (int)(xcc & 7u); for (int s_ = 0; s_ < xs_ * G1_STAGGER; ++s_) __builtin_amdgcn_s_sleep(75); }
#endif
            { pg8::AddrPlain8 g{XI0, W1I, D, D, D}; pg8::StaticOrder S; S.init(M_TOK, HA, G, bx); pg8::EpiGeluFp8 E{(unsigned char*)UG, HA, a_b_in, SX0, 1.0f / W1_SCALE, U_SCALE};
              pg8::gemm_phase<pg8::EpiGeluFp8, pg8::AddrPlain8, pg8::StaticOrder, true, true, 2>(lds + RING_OFF, g, S, E, tid); }
            { pg8::AddrPlain8 g{W1I + (size_t)HA * D, XI0, D, D, D}; pg8::StaticOrder S; S.init(HA, M_TOK, G, bx); pg8::EpiBf16<1, true> E{VT, M_TOK, nullptr, a_b_in + HA, nullptr, 1.0f / W1_SCALE, nullptr, SX0};
              pg8::gemm_phase<pg8::EpiBf16<1, true>, pg8::AddrPlain8, pg8::StaticOrder, true, true, 2>(lds + RING_OFF, g, S, E, tid); }
        } break;
        case 2: if (PHON(2)) { PH_BEGIN; IDX_BEGIN;
            for (int r = gw; r < 2 * D; r += 2 * NGW) rows_bf16_to_i8<2>(WQS, WQSI, SW, r, NGW, lane);
            LAS float* red = (LAS float*)(lds + RING_OFF);
            LAS float* stat = red + 64 * 64 * 2;
            const int rg = tid >> 3, j8 = tid & 7;
            for (int tb = vcu; tb < M_TOK / 64; tb += G) {
                const int t0 = tb * 64;
                float s[8], q[8];
#pragma unroll
                for (int e = 0; e < 8; ++e) { s[e] = 0.f; q[e] = 0.f; }
#pragma unroll 16
                for (int i = 0; i < 64; ++i) { const v4u w = *(const GAS v4u*)(VT + (size_t)(rg + 64 * i) * M_TOK + t0 + 8 * j8);
                    const float f[8] = {bflo(w.x), bfhi(w.x), bflo(w.y), bfhi(w.y), bflo(w.z), bfhi(w.z), bflo(w.w), bfhi(w.w)};
#pragma unroll
                    for (int e = 0; e < 8; ++e) { s[e] += f[e]; q[e] += f[e] * f[e]; } }
#pragma unroll
                for (int e = 0; e < 8; ++e) { red[(rg * 64 + 8 * j8 + e) * 2] = s[e]; red[(rg * 64 + 8 * j8 + e) * 2 + 1] = q[e]; }
                __syncthreads();
                if (tid < 128) { const int tok = tid & 63, wh = tid >> 6; float a = 0.f;
                    for (int r = 0; r < 64; ++r) a += red[(r * 64 + tok) * 2 + wh];
                    stat[tok * 2 + wh] = a; }
                __syncthreads();
                float mu[8], rs[8]; float inv_ha = 1.f / HA; asm volatile("" : "+v"(inv_ha));
#pragma unroll
                for (int e = 0; e < 8; ++e) { const float m = stat[(8 * j8 + e) * 2] * inv_ha; const float var = stat[(8 * j8 + e) * 2 + 1] * inv_ha - m * m; mu[e] = m; rs[e] = 1.f / sqrtf(fmaxf(var, 0.f) + LN_EPS); }
#pragma unroll 8
                for (int i = 0; i < 64; ++i) { const int c = rg + 64 * i; GAS v4u* p = (GAS v4u*)(VT + (size_t)c * M_TOK + t0 + 8 * j8); const v4u w = *p; const float gg = a_v_g[c], bb = a_v_b[c];
                    const float f[8] = {bflo(w.x), bfhi(w.x), bflo(w.y), bfhi(w.y), bflo(w.z), bfhi(w.z), bflo(w.w), bfhi(w.w)}; float o[8];
#pragma unroll
                    for (int e = 0; e < 8; ++e) o[e] = (f[e] - mu[e]) * rs[e] * gg + bb;
                    v4u ow; ow.x = pk2(o[0], o[1]); ow.y = pk2(o[2], o[3]); ow.z = pk2(o[4], o[5]); ow.w = pk2(o[6], o[7]); *p = ow; }
                __syncthreads();
            }
        } break;
        case 3: if (PHON(3)) { PH_BEGIN; IDX_BEGIN;
            pg8::AddrSpatial g{BD, VT, 256, M_TOK, 256}; pg8::StaticOrder S; S.init(M_TOK, HA, G, bx); pg8::EpiGate8 E{(const unsigned char*)UG, GF, HA, a_b_s, G_SCALE / U_SCALE};
            pg8::gemm_phase<pg8::EpiGate8, pg8::AddrSpatial, pg8::StaticOrder, true, true>(lds + RING_OFF, g, S, E, tid);
        } break;
        case 4: if (PHON(4)) { PH_BEGIN; IDX_BEGIN;
            pg8::AddrPlain8 g{GF, W2F, HA, HA, HA}; pg8::StaticOrder S; S.init(M_TOK, D, G, bx); pg8::EpiRes<false> E{(bf16*)Y, x_in, D, ALPHA, 1.0f / (G_SCALE * W2_SCALE)};
            pg8::gemm_phase<pg8::EpiRes<false>, pg8::AddrPlain8, pg8::StaticOrder, true, true, 1>(lds + RING_OFF, g, S, E, tid);
        } break;
        case 5: if (PHON(5)) { PH_BEGIN; IDX_BEGIN;
            for (int m = gw; m < M_TOK; m += 4 * NGW) ln_rows<4>((const bf16*)Y, ln_mix_g + ly * D, ln_mix_b + ly * D, XB, X8H, XI0, SX0, m, NGW, lane, (LAS unsigned*)(lds + RING_OFF + wave * 16384));
        } break;
        case 6: if (PHON(6)) { PH_BEGIN; IDX_BEGIN;
            pg8::AddrPlain8 g{WQSI + (size_t)ly * D * D, XI0, D, D, D}; pg8::StaticOrder S; S.init(D, M_TOK, G, bx); pg8::EpiBf16<0, true> E{(bf16*)ST, M_TOK, nullptr, nullptr, nullptr, 1.0f, SW + ly * D, SX0};
            pg8::gemm_phase<pg8::EpiBf16<0, true>, pg8::AddrPlain8, pg8::StaticOrder, true, true, 2>(lds + RING_OFF, g, S, E, tid);
        } break;
        case 7: if (PHON(7)) { PH_BEGIN; IDX_BEGIN;
            for (int it = gw; it < (M_TOK / 64) * HEADS; it += NGW) { const int h = it & 7, t = (it >> 3) * 64 + lane; topk_lane((const bf16*)ST, h, t, EIDX, GATE); }
        } break;
        case 8: if (PHON(8)) { PH_BEGIN; IDX_BEGIN;
            const unsigned char* ut = UT + (size_t)ly * NEXP * (D / 2); const unsigned char* vt = VTAB + (size_t)ly * NEXP * (D / 2);
            peer_chunked(ut, vt, SU + ly * NEXP, SV + ly * NEXP, EIDX, GATE, XB, X8H, Y, ln_ffn_g + ly * D, ln_ffn_b + ly * D, ly == 0 ? nullptr : OUT_PTR, ly == 0 ? XB : nullptr, ly == 0 ? XI0 : nullptr, SX0, gw, NGW, (LAS unsigned*)(lds + RING_OFF + wave * 16384), (LAS unsigned*)(lds + IDS16_OFF + wave * IDS16_WAVE));
        } break;
        case 9: if (PHON(9)) { PH_BEGIN; IDX_BEGIN;
            pg8::AddrPlain8 g{XI0, BINI, D, D, D}; pg8::StaticOrder S; S.init(M_TOK, D, G, bx); pg8::EpiBf16<0, true> E{H, D, nullptr, nullptr, nullptr, 1.0f / W1_SCALE, SX0, nullptr};
            pg8::gemm_phase<pg8::EpiBf16<0, true>, pg8::AddrPlain8, pg8::StaticOrder, true, true, 2>(lds + RING_OFF, g, S, E, tid);
        } break;
        case 10: if (PHON(10)) { PH_BEGIN; IDX_BEGIN;
            for (int it = gw; it < (M_TOK / 8) * 4; it += NGW) { const int t0 = (it >> 2) * 8, qd = it & 3, pos0 = t0 & (SEQ - 1);
                const GAS v4u* hp = (const GAS v4u*)(H + (size_t)t0 * D + qd * 512) + lane;
                if (qd == 0) pool_item<2>(hp, (GAS v4u*)(POOL + (size_t)t0 * D + qd * 512) + lane, pos0);
                else if (qd == 1) pool_item<4>(hp, (GAS v4u*)(POOL + (size_t)t0 * D + qd * 512) + lane, pos0);
                else if (qd == 2) pool_item<8>(hp, (GAS v4u*)(POOL + (size_t)t0 * D + qd * 512) + lane, pos0);
                else pool_item<16>(hp, (GAS v4u*)(POOL + (size_t)t0 * D + qd * 512) + lane, pos0); }
        } break;
        case 11: if (PHON(11)) { PH_BEGIN; IDX_BEGIN;
            pg8::AddrGrouped g{POOL, BGT, D, 512, 512}; pg8::StaticOrder S; S.init(M_TOK, D, G, bx); pg8::EpiFp8 E{MIXED8, D, b_b_grp, b_scale, M_SCALE};
            pg8::gemm_phase<pg8::EpiFp8, pg8::AddrGrouped, pg8::StaticOrder, true, true>(lds + RING_OFF, g, S, E, tid);
        } break;
#ifdef PROBE_L2
        case 14: { PH_BEGIN; IDX_BEGIN;
            peer_chunked(UT, VTAB, SU, SV, EIDX, GATE, XB, X8H, Y, ln_ffn_g, ln_ffn_b, nullptr, nullptr, nullptr, nullptr, gw, NGW, (LAS unsigned*)(lds + RING_OFF + wave * 16384), (LAS unsigned*)(lds + IDS16_OFF + wave * IDS16_WAVE), PROBE_L2);
        } break;
#endif
        default: if (PHON(12)) { PH_BEGIN; IDX_BEGIN;
            pg8::AddrPlain8 g{MIXED8, BOUTF, D, D, D}; pg8::StaticOrder S; S.init(M_TOK, D, G, bx); pg8::EpiRes<true> E{(bf16*)Y, XB, D, ALPHA, 1.0f / (M_SCALE * W2_SCALE)};
            pg8::gemm_phase<pg8::EpiRes<true>, pg8::AddrPlain8, pg8::StaticOrder, true, true, 1>(lds + RING_OFF, g, S, E, tid);
        } break;
        }
        if (ph + 1 < hi) { PH_BEGIN; unsigned xl = xcc; int w2 = wave0, z2 = 0; asm volatile("" : "+s"(xl), "+s"(w2), "+s"(z2));
            const int tidb = w2 * 64 + __builtin_amdgcn_mbcnt_hi(-1, __builtin_amdgcn_mbcnt_lo(-1, z2));
            XcdBarrier bar; bar.bar = (unsigned*)(ws + WS_CTL) + CW_BAR; bar.x = xl; bar.st = MISC + 8; xcd_barrier(bar, tidb); }
    }
}

extern "C" void kernel_launch(void* const* d_in, const int* in_sizes, int n_in, void* d_out, int out_size, void* d_ws, size_t ws_size, hipStream_t stream) {
    static int grid = 0;
    if (grid == 0) {
        if (n_in != 21 || out_size != M_TOK * D || ws_size < WS_END) { fprintf(stderr, "kernel_launch: unexpected problem (n_in %d, out %d, ws %zu)\n", n_in, out_size, ws_size); grid = -1; return; }
        int dev = 0, cus = 0, per_cu = 0;
        if (hipGetDevice(&dev) != hipSuccess || hipDeviceGetAttribute(&cus, hipDeviceAttributeMultiprocessorCount, dev) != hipSuccess) { grid = -1; return; }
        if (hipFuncSetAttribute((const void*)mega_fwd, hipFuncAttributeMaxDynamicSharedMemorySize, LDS_BYTES) != hipSuccess) { fprintf(stderr, "kernel_launch: hipFuncSetAttribute failed\n"); grid = -1; return; }
        if (hipOccupancyMaxActiveBlocksPerMultiprocessor(&per_cu, (const void*)mega_fwd, NTHREADS, LDS_BYTES) != hipSuccess || per_cu < 1) { fprintf(stderr, "kernel_launch: occupancy query says %d blocks per CU\n", per_cu); (void)hipGetLastError(); }
        grid = cus;
    }
    if (grid < 0) return;
    if (hipMemsetAsync((char*)d_ws + WS_CTL, 0, CTL_ZERO_BYTES, stream) != hipSuccess) return;
    Args a{};
    for (int i = 0; i < 21; ++i) a.in[i] = (const float*)d_in[i];
    a.out = (float*)d_out; a.ws = (unsigned char*)d_ws;
#if MK_PER_PHASE
    for (int p = 0; p < N_PHASES; ++p) { a.ph_lo = p; a.ph_hi = p + 1; hipLaunchKernelGGL(mega_fwd, dim3(grid), dim3(NTHREADS), LDS_BYTES, stream, a); }
#else
    a.ph_lo = 0; a.ph_hi = N_PHASES;
#ifdef PROBE_L2
    a.ph_hi = N_PHASES + 1;
#endif
    hipLaunchKernelGGL(mega_fwd, dim3(grid), dim3(NTHREADS), LDS_BYTES, stream, a);
#endif
}
```

```cpp
#include <hip/hip_runtime.h>
#include <cstdio>
#include <cstdint>

#ifndef MK_PER_PHASE
#define MK_PER_PHASE 0
#endif

namespace pg8 {
#define PG8_LAS __attribute__((address_space(3)))
#define PG8_GAS __attribute__((address_space(1)))
typedef unsigned short bf16_t;
typedef short bf16x8 __attribute__((ext_vector_type(8)));
typedef float f32x4 __attribute__((ext_vector_type(4)));
typedef float f32x2 __attribute__((ext_vector_type(2)));
typedef unsigned u32x4 __attribute__((ext_vector_type(4)));
constexpr int BM = 256, BK = 64, HALF = 128, HTB = HALF * BK * 2  , STAGE_BYTES = 8 * HTB, NXCD = 8, WGM = 8;

__host__ __device__ __forceinline__ int lds_byte(int r, int c) { const int st = (r >> 4) * 2 + (c >> 5), rr = r & 15, cc = c & 31, ob = rr * 64 + cc * 2; return st * 1024 + (ob ^ (((ob >> 9) & 1) << 5)); }
__host__ __device__ __forceinline__ void stage_rc(int b, int& R, int& C) { const int st = b / 1024, sb = b % 1024, swz = sb ^ (((sb >> 9) & 1) << 5); R = (st >> 1) * 16 + swz / 64; C = (st & 1) * 32 + (swz % 64) / 2; }
__host__ __device__ __forceinline__ int perm32(int rho) { const int n = rho >> 4, i = rho & 15; return 8 * (i >> 2) + 4 * n + (i & 3); }

typedef int i32x8 __attribute__((ext_vector_type(8)));
typedef int i32x4v __attribute__((ext_vector_type(4)));
__device__ __forceinline__ i32x8 pk32(bf16x8 a, bf16x8 b) { return __builtin_shufflevector(__builtin_bit_cast(i32x4v, a), __builtin_bit_cast(i32x4v, b), 0, 1, 2, 3, 4, 5, 6, 7); }
struct Unit { int pm, pn; };

struct StaticOrder {
    int nM, nN, nwg, G, c;
    __host__ __device__ void init(int M, int N, int G_, int c_) { nM = M / BM; nN = N / BM; nwg = nM * nN; G = G_; c = c_; }
    __host__ __device__ bool next(int i, Unit& u) const {
        const long L = (long)i * G + c; if (L >= nwg) return false;
        int wgid = (int)L; { const int q = nwg / NXCD, r = nwg % NXCD, xcd = wgid % NXCD, off = wgid / NXCD; wgid = (xcd < r ? xcd * (q + 1) : r * (q + 1) + (xcd - r) * q) + off; }
        const int nig = WGM * nN, gid = wgid / nig, fm = gid * WGM, gsz = (nM - fm) < WGM ? (nM - fm) : WGM;
        u.pm = fm + ((wgid % nig) % gsz); u.pn = (wgid % nig) / gsz; return true;
    }
    __device__ __forceinline__ void a_ready(const Unit&) const {}
    __device__ __forceinline__ void done(const Unit&) const {}
};

struct AddrPlain { const bf16_t* A; const bf16_t* Bt; int lda, ldb, K;
    __device__ __forceinline__ const char* a(const Unit& u) const { return (const char*)(A + (size_t)u.pm * BM * lda); }
    __device__ __forceinline__ const char* b(const Unit& u) const { return (const char*)(Bt + (size_t)u.pn * BM * ldb); } };
struct AddrPlain8 { const unsigned char* A; const unsigned char* Bt; int lda, ldb, K;
    __device__ __forceinline__ const char* a(const Unit& u) const { return (const char*)(A + (size_t)u.pm * BM * lda); }
    __device__ __forceinline__ const char* b(const Unit& u) const { return (const char*)(Bt + (size_t)u.pn * BM * ldb); } };
struct AddrSpatial { const bf16_t* BD; const bf16_t* VNT; int lda, ldb, K;
    __device__ __forceinline__ const char* a(const Unit& u) const { return (const char*)(BD + (size_t)u.pn * 65536); }
    __device__ __forceinline__ const char* b(const Unit& u) const { return (const char*)(VNT + (size_t)u.pn * 256 * 16384 + (size_t)u.pm * 256); } };
struct AddrScores { const bf16_t* BDsk; const bf16_t* Q; int lda, ldb, K;
    __device__ __forceinline__ const char* a(const Unit& u) const { return (const char*)(BDsk + (size_t)(u.pm >> 3) * 65536); }
    __device__ __forceinline__ const char* b(const Unit& u) const { return (const char*)(Q + (size_t)(u.pm >> 3) * 2048 * 2048 + (size_t)u.pn * 256 * 2048 + (size_t)(u.pm & 7) * 256); } };
struct AddrGrouped { const bf16_t* P; const bf16_t* BgT; int lda, ldb, K;
    __device__ __forceinline__ const char* a(const Unit& u) const { return (const char*)(P + (size_t)u.pm * 256 * 2048 + (size_t)(u.pn >> 1) * 512); }
    __device__ __forceinline__ const char* b(const Unit& u) const { return (const char*)(BgT + (size_t)(u.pn >> 1) * 512 * 512 + (size_t)(u.pn & 1) * 256 * 512); } };

__device__ __forceinline__ unsigned cvt_pk_bf16(float lo, float hi) { unsigned r; asm volatile("v_cvt_pk_bf16_f32 %0, %1, %2" : "=v"(r) : "v"(lo), "v"(hi)); return r; }
__device__ __forceinline__ float gelu_tanh(float v) {
    const float y2 = v * (1.5957691216f + 0.0713548163f * v * v);
    const float e = __builtin_amdgcn_exp2f(-1.4426950409f * y2);
    return v * __builtin_amdgcn_rcpf(1.0f + e);
}
__device__ __forceinline__ f32x4 gelu4(f32x4 v) { return (f32x4){gelu_tanh(v[0]), gelu_tanh(v[1]), gelu_tanh(v[2]), gelu_tanh(v[3])}; }
__device__ __forceinline__ u32x4 pack8(f32x4 v0, f32x4 v1) { u32x4 w; w.x = cvt_pk_bf16(v0[0], v0[1]); w.y = cvt_pk_bf16(v0[2], v0[3]); w.z = cvt_pk_bf16(v1[0], v1[1]); w.w = cvt_pk_bf16(v1[2], v1[3]); return w; }

typedef unsigned u32x2p __attribute__((ext_vector_type(2)));
__device__ __forceinline__ u32x4 pair16(u32x2p x, u32x2p y) {
    const auto s0 = __builtin_amdgcn_permlane16_swap(x.x, y.x, false, false), s1 = __builtin_amdgcn_permlane16_swap(x.y, y.y, false, false);
    return (u32x4){s0[0], s1[0], s0[1], s1[1]};
}
__device__ __forceinline__ void unpair16(u32x4 l, u32x2p& x, u32x2p& y) {
    const auto s0 = __builtin_amdgcn_permlane16_swap(l.x, l.z, false, false), s1 = __builtin_amdgcn_permlane16_swap(l.y, l.w, false, false);
    x = (u32x2p){s0[0], s1[0]}; y = (u32x2p){s0[1], s1[1]};
}
__device__ __forceinline__ u32x2p pk8_fp8(f32x4 v0, f32x4 v1) {
    int w0 = 0, w1 = 0;
    w0 = __builtin_amdgcn_cvt_pk_fp8_f32(__builtin_amdgcn_fmed3f(v0[0], -448.f, 448.f), __builtin_amdgcn_fmed3f(v0[1], -448.f, 448.f), w0, false);
    w0 = __builtin_amdgcn_cvt_pk_fp8_f32(__builtin_amdgcn_fmed3f(v0[2], -448.f, 448.f), __builtin_amdgcn_fmed3f(v0[3], -448.f, 448.f), w0, true);
    w1 = __builtin_amdgcn_cvt_pk_fp8_f32(__builtin_amdgcn_fmed3f(v1[0], -448.f, 448.f), __builtin_amdgcn_fmed3f(v1[1], -448.f, 448.f), w1, false);
    w1 = __builtin_amdgcn_cvt_pk_fp8_f32(__builtin_amdgcn_fmed3f(v1[2], -448.f, 448.f), __builtin_amdgcn_fmed3f(v1[3], -448.f, 448.f), w1, true);
    return (u32x2p){(unsigned)w0, (unsigned)w1};
}
__device__ __forceinline__ float bf_lo(unsigned w) { return __builtin_bit_cast(float, w << 16); }
__device__ __forceinline__ float bf_hi(unsigned w) { return __builtin_bit_cast(float, w & 0xffff0000u); }

template <int ACT, bool IACC = false> struct EpiBf16 {
    static constexpr bool PERM = true, AFTER_DRAIN = false;
    bf16_t* O; int ldc; const float* cbias; const float* rbias; const float* cscale; float ascale = 1.0f;
    const float* rs = nullptr; const float* cs = nullptr;
    __device__ __forceinline__ void operator()(const f32x4 (&acc)[2][2][4][2], const Unit& u, int wr, int wc, int fr, int fq) const {
        const int row0 = u.pm * BM + wr * 64 + fr, col0 = u.pn * BM + wc * 32 + 8 * fq;
        f32x4 bv[2][2], sv[2][2], cv[2][2]; float rsc[2][4], rb[2][4];
#pragma unroll
        for (int bj = 0; bj < 2; ++bj)
#pragma unroll
            for (int n = 0; n < 2; ++n) { bv[bj][n] = cbias ? *(const PG8_GAS f32x4*)(cbias + col0 + bj * HALF + 4 * n) : (f32x4){0.f, 0.f, 0.f, 0.f};
                                          sv[bj][n] = cscale ? *(const PG8_GAS f32x4*)(cscale + col0 + bj * HALF + 4 * n) : (f32x4){1.f, 1.f, 1.f, 1.f};
                                          cv[bj][n] = cs ? *(const PG8_GAS f32x4*)(cs + col0 + bj * HALF + 4 * n) : (f32x4){1.f, 1.f, 1.f, 1.f}; }
#pragma unroll
        for (int ai = 0; ai < 2; ++ai)
#pragma unroll
            for (int m = 0; m < 4; ++m) { const int r = row0 + ai * HALF + m * 16; rsc[ai][m] = (rs ? ((const PG8_GAS float*)rs)[r] : 1.0f) * ascale; rb[ai][m] = rbias ? ((const PG8_GAS float*)rbias)[r] : 0.f; }
#pragma unroll
        for (int ai = 0; ai < 2; ++ai)
#pragma unroll
            for (int m = 0; m < 4; ++m) { const int r = row0 + ai * HALF + m * 16; PG8_GAS bf16_t* rowp = (PG8_GAS bf16_t*)O + (size_t)r * ldc + col0;
#pragma unroll
                for (int bj = 0; bj < 2; ++bj) { f32x4 a0 = acc[ai][bj][m][0], a1 = acc[ai][bj][m][1];
                    if (IACC) { a0 = __builtin_convertvector(__builtin_bit_cast(i32x4v, a0), f32x4); a1 = __builtin_convertvector(__builtin_bit_cast(i32x4v, a1), f32x4); }
                    f32x4 v0 = a0 * (cv[bj][0] * rsc[ai][m]) + bv[bj][0] + rb[ai][m], v1 = a1 * (cv[bj][1] * rsc[ai][m]) + bv[bj][1] + rb[ai][m];
                    if (ACT == 1) { v0 = gelu4(v0); v1 = gelu4(v1); }
                    v0 = v0 * sv[bj][0]; v1 = v1 * sv[bj][1];
                    *(PG8_GAS u32x4*)(rowp + bj * HALF) = pack8(v0, v1); } }
    }
};
struct EpiF32 {
    static constexpr bool PERM = false, AFTER_DRAIN = false;
    float* C; int ldc;
    __device__ __forceinline__ void operator()(const f32x4 (&acc)[2][2][4][2], const Unit& u, int wr, int wc, int fr, int fq) const {
        const int row0 = u.pm * BM + wr * 64 + fr, col0 = u.pn * BM + wc * 32 + 4 * fq;
#pragma unroll
        for (int ai = 0; ai < 2; ++ai)
#pragma unroll
            for (int m = 0; m < 4; ++m) { float* rowp = C + (size_t)(row0 + ai * HALF + m * 16) * ldc + col0;
#pragma unroll
                for (int bj = 0; bj < 2; ++bj)
#pragma unroll
                    for (int n = 0; n < 2; ++n) *(f32x4*)(rowp + bj * HALF + n * 16) = acc[ai][bj][m][n]; }
    }
};
template <bool RBF> struct EpiRes {
    static constexpr bool PERM = true, AFTER_DRAIN = false;
    bf16_t* Y; const void* R; int ldc; float alpha; float ascale = 1.0f;
    __device__ __forceinline__ void operator()(const f32x4 (&acc)[2][2][4][2], const Unit& u, int wr, int wc, int fr, int fq) const {
        const int row0 = u.pm * BM + wr * 64 + fr, col0 = u.pn * BM + wc * 32 + 8 * fq;
#pragma unroll
        for (int ai = 0; ai < 2; ++ai) {
            f32x4 rv[4][2][2];
#pragma unroll
            for (int m = 0; m < 4; ++m) { const size_t off = (size_t)(row0 + ai * HALF + m * 16) * ldc + col0;
#pragma unroll
                for (int bj = 0; bj < 2; ++bj) {
                    if constexpr (RBF) { const u32x4 w = *(const PG8_GAS u32x4*)((const bf16_t*)R + off + bj * HALF);
                        rv[m][bj][0] = (f32x4){__builtin_bit_cast(float, w.x << 16), __builtin_bit_cast(float, w.x & 0xffff0000u), __builtin_bit_cast(float, w.y << 16), __builtin_bit_cast(float, w.y & 0xffff0000u)};
                        rv[m][bj][1] = (f32x4){__builtin_bit_cast(float, w.z << 16), __builtin_bit_cast(float, w.z & 0xffff0000u), __builtin_bit_cast(float, w.w << 16), __builtin_bit_cast(float, w.w & 0xffff0000u)}; }
                    else { rv[m][bj][0] = *(const PG8_GAS f32x4*)((const float*)R + off + bj * HALF); rv[m][bj][1] = *(const PG8_GAS f32x4*)((const float*)R + off + bj * HALF + 4); } } }
#pragma unroll
            for (int m = 0; m < 4; ++m) { const size_t off = (size_t)(row0 + ai * HALF + m * 16) * ldc + col0;
#pragma unroll
                for (int bj = 0; bj < 2; ++bj) *(PG8_GAS u32x4*)(Y + off + bj * HALF) = pack8(rv[m][bj][0] * alpha + acc[ai][bj][m][0] * ascale, rv[m][bj][1] * alpha + acc[ai][bj][m][1] * ascale); } }
    }
};
struct EpiGate {
    static constexpr bool PERM = true, AFTER_DRAIN = false;
    bf16_t* UG; int ldc; const float* bs;
    __device__ __forceinline__ void operator()(const f32x4 (&acc)[2][2][4][2], const Unit& u, int wr, int wc, int fr, int fq) const {
        const int row0 = u.pm * BM + wr * 64 + fr, col0 = u.pn * BM + wc * 32 + 8 * fq;
#pragma unroll
        for (int ai = 0; ai < 2; ++ai)
#pragma unroll
            for (int m = 0; m < 4; ++m) { const int r = row0 + ai * HALF + m * 16; bf16_t* rowp = UG + (size_t)r * ldc + col0; const float rb = bs[u.pn * 128 + (r & 127)];
#pragma unroll
                for (int bj = 0; bj < 2; ++bj) { const u32x4 uu = *(const u32x4*)(rowp + bj * HALF);
                    f32x4 v0 = acc[ai][bj][m][0] + rb, v1 = acc[ai][bj][m][1] + rb;
                    v0 = v0 * (f32x4){bf_lo(uu.x), bf_hi(uu.x), bf_lo(uu.y), bf_hi(uu.y)}; v1 = v1 * (f32x4){bf_lo(uu.z), bf_hi(uu.z), bf_lo(uu.w), bf_hi(uu.w)};
                    *(u32x4*)(rowp + bj * HALF) = pack8(v0, v1); } }
    }
};

struct EpiFp8 {
    static constexpr bool PERM = true, AFTER_DRAIN = false;
    unsigned char* O; int ldc; const float* cbias; const float* cscale; float oscale;
    __device__ __forceinline__ void operator()(const f32x4 (&acc)[2][2][4][2], const Unit& u, int wr, int wc, int fr, int fq) const {
        const int row0 = u.pm * BM + wr * 64 + fr, col0 = u.pn * BM + wc * 32 + 8 * fq, odd = fq & 1;
        f32x4 bv[2][2], sv[2][2];
#pragma unroll
        for (int bj = 0; bj < 2; ++bj)
#pragma unroll
            for (int n = 0; n < 2; ++n) { bv[bj][n] = *(const PG8_GAS f32x4*)(cbias + col0 + bj * HALF + 4 * n); sv[bj][n] = *(const PG8_GAS f32x4*)(cscale + col0 + bj * HALF + 4 * n) * oscale; }
#pragma unroll
        for (int ai = 0; ai < 2; ++ai)
#pragma unroll
            for (int mp = 0; mp < 2; ++mp) { const int r = row0 + ai * HALF + mp * 32 + 16 * odd;
#pragma unroll
                for (int bj = 0; bj < 2; ++bj) {
                    const u32x2p x = pk8_fp8((acc[ai][bj][2 * mp][0] + bv[bj][0]) * sv[bj][0], (acc[ai][bj][2 * mp][1] + bv[bj][1]) * sv[bj][1]);
                    const u32x2p y = pk8_fp8((acc[ai][bj][2 * mp + 1][0] + bv[bj][0]) * sv[bj][0], (acc[ai][bj][2 * mp + 1][1] + bv[bj][1]) * sv[bj][1]);
                    *(PG8_GAS u32x4*)(O + (size_t)r * ldc + col0 - 8 * odd + bj * HALF) = pair16(x, y); } }
    }
};
struct EpiGeluFp8 {
    static constexpr bool PERM = true, AFTER_DRAIN = false;
    unsigned char* O; int ldc; const float* cbias; const float* rs; float ascale; float oscale;
    __device__ __forceinline__ void operator()(const f32x4 (&acc)[2][2][4][2], const Unit& u, int wr, int wc, int fr, int fq) const {
        const int row0 = u.pm * BM + wr * 64 + fr, col0 = u.pn * BM + wc * 32 + 8 * fq, odd = fq & 1;
        f32x4 bv[2][2]; float rsc[2][4];
#pragma unroll
        for (int bj = 0; bj < 2; ++bj)
#pragma unroll
            for (int n = 0; n < 2; ++n) bv[bj][n] = *(const PG8_GAS f32x4*)(cbias + col0 + bj * HALF + 4 * n);
#pragma unroll
        for (int ai = 0; ai < 2; ++ai)
#pragma unroll
            for (int m = 0; m < 4; ++m) rsc[ai][m] = ((const PG8_GAS float*)rs)[row0 + ai * HALF + m * 16] * ascale;
#pragma unroll
        for (int ai = 0; ai < 2; ++ai)
#pragma unroll
            for (int mp = 0; mp < 2; ++mp) { const int r = row0 + ai * HALF + mp * 32 + 16 * odd;
#pragma unroll
                for (int bj = 0; bj < 2; ++bj) { u32x2p xy[2];
#pragma unroll
                    for (int h = 0; h < 2; ++h) { const int m = 2 * mp + h;
                        f32x4 v0 = __builtin_convertvector(__builtin_bit_cast(i32x4v, acc[ai][bj][m][0]), f32x4) * rsc[ai][m] + bv[bj][0], v1 = __builtin_convertvector(__builtin_bit_cast(i32x4v, acc[ai][bj][m][1]), f32x4) * rsc[ai][m] + bv[bj][1];
                        xy[h] = pk8_fp8(gelu4(v0) * oscale, gelu4(v1) * oscale); }
                    *(PG8_GAS u32x4*)(O + (size_t)r * ldc + col0 - 8 * odd + bj * HALF) = pair16(xy[0], xy[1]); } }
    }
};
struct EpiGate8 {
    static constexpr bool PERM = true, AFTER_DRAIN = false;
    const unsigned char* U; unsigned char* GF; int ldc; const float* bs; float gscale;
    __device__ __forceinline__ void operator()(const f32x4 (&acc)[2][2][4][2], const Unit& u, int wr, int wc, int fr, int fq) const {
        const int row0 = u.pm * BM + wr * 64 + fr, col0 = u.pn * BM + wc * 32 + 8 * fq, odd = fq & 1;
        u32x4 ul[2][2][2]; float rb[2][4];
#pragma unroll
        for (int ai = 0; ai < 2; ++ai) {
#pragma unroll
            for (int m = 0; m < 4; ++m) rb[ai][m] = ((const PG8_GAS float*)bs)[u.pn * 128 + ((row0 + ai * HALF + m * 16) & 127)];
#pragma unroll
            for (int mp = 0; mp < 2; ++mp)
#pragma unroll
                for (int bj = 0; bj < 2; ++bj) ul[ai][mp][bj] = *(const PG8_GAS u32x4*)(U + (size_t)(row0 + ai * HALF + mp * 32 + 16 * odd) * ldc + col0 - 8 * odd + bj * HALF); }
#pragma unroll
        for (int ai = 0; ai < 2; ++ai)
#pragma unroll
            for (int mp = 0; mp < 2; ++mp) { const int r = row0 + ai * HALF + mp * 32 + 16 * odd;
#pragma unroll
                for (int bj = 0; bj < 2; ++bj) { u32x2p ux[2], gx[2]; unpair16(ul[ai][mp][bj], ux[0], ux[1]);
#pragma unroll
                    for (int h = 0; h < 2; ++h) { const int m = 2 * mp + h;
                        f32x4 v0 = acc[ai][bj][m][0] + rb[ai][m], v1 = acc[ai][bj][m][1] + rb[ai][m];
                        const auto u01 = __builtin_amdgcn_cvt_pk_f32_fp8((int)ux[h].x, false), u23 = __builtin_amdgcn_cvt_pk_f32_fp8((int)ux[h].x, true), u45 = __builtin_amdgcn_cvt_pk_f32_fp8((int)ux[h].y, false), u67 = __builtin_amdgcn_cvt_pk_f32_fp8((int)ux[h].y, true);
                        gx[h] = pk8_fp8(v0 * (f32x4){u01[0], u01[1], u23[0], u23[1]} * gscale, v1 * (f32x4){u45[0], u45[1], u67[0], u67[1]} * gscale); }
                    *(PG8_GAS u32x4*)(GF + (size_t)r * ldc + col0 - 8 * odd + bj * HALF) = pair16(gx[0], gx[1]); } }
    }
};

template <class Epi, class Addr, class Sched, bool ALIGN_EPI = false, bool SP2 = false, int MODE = 0  >
__device__ __forceinline__ void gemm_phase(PG8_LAS unsigned char* lds, const Addr& g, const Sched& S, const Epi& E, const int tid  ) {
    const int wid = __builtin_amdgcn_readfirstlane(tid >> 6), lane = tid & 63, wr = wid >> 2, wc = wid & 3, fr = lane & 15, fq = lane >> 4;
    constexpr bool FP8 = MODE == 1, I8 = MODE == 2; constexpr int ES = MODE ? 1 : 2;
    const int K = g.K, nt = K / (BK * 2 / ES);
    unsigned voffA[2], voffB[2];
#pragma unroll
    for (int i = 0; i < 2; ++i) { int R, C; stage_rc(tid * 16 + i * 8192, R, C); const int Rb = Epi::PERM ? ((R & ~31) + perm32(R & 31)) : R;
        voffA[i] = (unsigned)(R * g.lda * ES + C * 2); voffB[i] = (unsigned)(Rb * g.ldb * ES + C * 2); }
    const size_t kstep = (size_t)(BK * 2);
    const size_t hsA = (size_t)HALF * g.lda * ES, hsB = (size_t)HALF * g.ldb * ES;
    const unsigned ldsw = (unsigned)wid * 1024u;
    const int aoff = lds_byte(wr * 64 + fr, fq * 8), boff = lds_byte(wc * 32 + fr, fq * 8);
#define PG8_SA(b, h) (((b) * 2 + (h)) * HTB)
#define PG8_SB(b, h) ((4 + (b) * 2 + (h)) * HTB)
#define PG8_STAGE(bufoff, gbase, voff) do { _Pragma("unroll") for (int _i = 0; _i < 2; ++_i) \
        __builtin_amdgcn_global_load_lds((const unsigned*)((const char*)(gbase) + (voff)[_i]), (PG8_LAS unsigned*)(lds + (bufoff) + ldsw + _i * 8192), 16, 0, 0); } while (0)
#define PG8_LDA(dst, b, h) do { _Pragma("unroll") for (int m = 0; m < 4; ++m) { if constexpr (FP8) { dst##8[m] = pk32(*(const PG8_LAS bf16x8*)(lds + PG8_SA(b, h) + aoff + m * 2048), *(const PG8_LAS bf16x8*)(lds + PG8_SA(b, h) + aoff + m * 2048 + 1024)); } \
        else { _Pragma("unroll") for (int k = 0; k < 2; ++k) dst[m][k] = *(const PG8_LAS bf16x8*)(lds + PG8_SA(b, h) + aoff + m * 2048 + k * 1024); } } } while (0)
#define PG8_LDB(dst, b, h) do { _Pragma("unroll") for (int n = 0; n < 2; ++n) { if constexpr (FP8) { dst##8[n] = pk32(*(const PG8_LAS bf16x8*)(lds + PG8_SB(b, h) + boff + n * 2048), *(const PG8_LAS bf16x8*)(lds + PG8_SB(b, h) + boff + n * 2048 + 1024)); } \
        else { _Pragma("unroll") for (int k = 0; k < 2; ++k) dst[n][k] = *(const PG8_LAS bf16x8*)(lds + PG8_SB(b, h) + boff + n * 2048 + k * 1024); } } } while (0)
#define PG8_MMA(ai, bj, At, Bt) do { __builtin_amdgcn_s_setprio(1); _Pragma("unroll") for (int m = 0; m < 4; ++m) _Pragma("unroll") for (int n = 0; n < 2; ++n) { \
        if constexpr (FP8) { asm volatile("v_mfma_scale_f32_16x16x128_f8f6f4 %0, %1, %2, %0, %3, %3 op_sel_hi:[0,0,0]" : "+v"(acc[ai][bj][m][n]) : "v"(Bt##8[n]), "v"(At##8[m]), "v"(sc127)); } \
        else if constexpr (I8) { _Pragma("unroll") for (int k = 0; k < 2; ++k) acc[ai][bj][m][n] = __builtin_bit_cast(f32x4, __builtin_amdgcn_mfma_i32_16x16x64_i8(__builtin_bit_cast(i32x4v, Bt[n][k]), __builtin_bit_cast(i32x4v, At[m][k]), __builtin_bit_cast(i32x4v, acc[ai][bj][m][n]), 0, 0, 0)); } \
        else { _Pragma("unroll") for (int k = 0; k < 2; ++k) acc[ai][bj][m][n] = __builtin_amdgcn_mfma_f32_16x16x32_bf16(Bt[n][k], At[m][k], acc[ai][bj][m][n], 0, 0, 0); } } __builtin_amdgcn_s_setprio(0); } while (0)
#define PG8_WAIT_V(n) asm volatile("s_waitcnt vmcnt(" #n ")" ::: "memory")
#define PG8_WAIT_L(n) asm volatile("s_waitcnt lgkmcnt(" #n ")" ::: "memory")
#define PG8_BAR __builtin_amdgcn_s_barrier()
#define PG8_SCHED __builtin_amdgcn_sched_barrier(0)
    Unit cur, nxt; int ui = 0;
    if (!S.next(0, cur)) return;
    f32x4 acc[2][2][4][2];
#pragma unroll
    for (int a = 0; a < 2; ++a)
#pragma unroll
        for (int b = 0; b < 2; ++b)
#pragma unroll
            for (int m = 0; m < 4; ++m)
#pragma unroll
                for (int n = 0; n < 2; ++n) acc[a][b][m][n] = (f32x4){0.f, 0.f, 0.f, 0.f};
    bf16x8 At[4][2], B0[2][2], B1[2][2]; i32x8 At8[4], B08[2], B18[2]; int sc127 = 127; if constexpr (FP8) asm volatile("" : "+v"(sc127));
    const char* cA = g.a(cur); const char* cB = g.b(cur);
    S.a_ready(cur);
    if constexpr (SP2) {
        PG8_STAGE(PG8_SB(0, 0), cB, voffB); PG8_STAGE(PG8_SB(0, 1), cB + hsB, voffB); PG8_STAGE(PG8_SA(0, 0), cA, voffA); PG8_STAGE(PG8_SA(0, 1), cA + hsA, voffA);
        if (wr == 1) PG8_BAR;
        PG8_WAIT_V(2); PG8_BAR;
        PG8_STAGE(PG8_SB(1, 0), cB + kstep, voffB); PG8_STAGE(PG8_SA(1, 0), cA + kstep, voffA); PG8_STAGE(PG8_SB(1, 1), cB + hsB + kstep, voffB);
        PG8_WAIT_V(6); PG8_BAR;
    } else {
        PG8_STAGE(PG8_SB(0, 0), cB, voffB); PG8_STAGE(PG8_SA(0, 0), cA, voffA); PG8_STAGE(PG8_SB(0, 1), cB + hsB, voffB); PG8_STAGE(PG8_SA(0, 1), cA + hsA, voffA);
        if (wr == 1) PG8_BAR;
        PG8_WAIT_V(4); PG8_BAR;
        PG8_STAGE(PG8_SB(1, 0), cB + kstep, voffB); PG8_STAGE(PG8_SA(1, 0), cA + kstep, voffA); PG8_STAGE(PG8_SB(1, 1), cB + hsB + kstep, voffB);
        PG8_WAIT_V(6); PG8_BAR;
    }
    for (;;) {
        const bool has_next = S.next(ui + 1, nxt);
        const char* nA = has_next ? g.a(nxt) : cA; const char* nB = has_next ? g.b(nxt) : cB;
        for (int t = 0; t < nt; t += 2) {
            const bool last = (t == nt - 2);
            const char* a1 = cA + (size_t)(t + 1) * kstep;
            const char* a2 = last ? nA : cA + (size_t)(t + 2) * kstep; const char* b2 = last ? nB : cB + (size_t)(t + 2) * kstep;
            const char* a3 = a2 + kstep; const char* b3 = b2 + kstep;
            if (last && has_next) S.a_ready(nxt);
            if constexpr (SP2) {
            PG8_LDB(B0, 0, 0); PG8_LDB(B1, 0, 1); PG8_SCHED; PG8_LDA(At, 0, 0); PG8_STAGE(PG8_SA(1, 1), a1 + hsA, voffA);
            PG8_WAIT_V(8); PG8_WAIT_L(0); PG8_BAR; PG8_MMA(0, 0, At, B0); PG8_MMA(0, 1, At, B1); PG8_BAR; PG8_SCHED;
            PG8_LDA(At, 0, 1); PG8_STAGE(PG8_SB(0, 0), b2, voffB); PG8_STAGE(PG8_SB(0, 1), b2 + hsB, voffB); PG8_STAGE(PG8_SA(0, 0), a2, voffA);
            PG8_WAIT_V(8); PG8_WAIT_L(0); PG8_BAR; PG8_MMA(1, 0, At, B0); PG8_MMA(1, 1, At, B1); PG8_BAR; PG8_SCHED;
            PG8_LDB(B0, 1, 0); PG8_LDB(B1, 1, 1); PG8_SCHED; PG8_LDA(At, 1, 0); PG8_STAGE(PG8_SA(0, 1), a2 + hsA, voffA);
            PG8_WAIT_V(8); PG8_WAIT_L(0); PG8_BAR; PG8_MMA(0, 0, At, B0); PG8_MMA(0, 1, At, B1); PG8_BAR; PG8_SCHED;
            PG8_LDA(At, 1, 1); PG8_STAGE(PG8_SB(1, 0), b3, voffB); PG8_STAGE(PG8_SB(1, 1), b3 + hsB, voffB); PG8_STAGE(PG8_SA(1, 0), a3, voffA);
            PG8_WAIT_V(8); PG8_WAIT_L(0); PG8_BAR; PG8_MMA(1, 0, At, B0); PG8_MMA(1, 1, At, B1); PG8_BAR; PG8_SCHED;
            } else {
            PG8_LDB(B0, 0, 0); PG8_SCHED; PG8_LDA(At, 0, 0); PG8_STAGE(PG8_SA(1, 1), a1 + hsA, voffA);
            PG8_WAIT_L(8); PG8_BAR; PG8_WAIT_L(0); PG8_MMA(0, 0, At, B0); PG8_BAR; PG8_SCHED;
            PG8_LDB(B1, 0, 1); PG8_STAGE(PG8_SB(0, 0), b2, voffB);
            PG8_BAR; PG8_WAIT_L(0); PG8_MMA(0, 1, At, B1); PG8_BAR;
            PG8_LDA(At, 0, 1); PG8_STAGE(PG8_SA(0, 0), a2, voffA);
            PG8_BAR; PG8_WAIT_L(0); PG8_MMA(1, 0, At, B0); PG8_BAR; PG8_SCHED;
            PG8_STAGE(PG8_SB(0, 1), b2 + hsB, voffB);
            PG8_WAIT_V(6); PG8_BAR; PG8_MMA(1, 1, At, B1); PG8_BAR;
            PG8_LDB(B0, 1, 0); PG8_SCHED; PG8_LDA(At, 1, 0); PG8_STAGE(PG8_SA(0, 1), a2 + hsA, voffA);
            PG8_WAIT_L(8); PG8_BAR; PG8_WAIT_L(0); PG8_MMA(0, 0, At, B0); PG8_BAR; PG8_SCHED;
            PG8_LDB(B1, 1, 1); PG8_STAGE(PG8_SB(1, 0), b3, voffB);
            PG8_BAR; PG8_WAIT_L(0); PG8_MMA(0, 1, At, B1); PG8_BAR;
            PG8_LDA(At, 1, 1); PG8_STAGE(PG8_SA(1, 0), a3, voffA);
            PG8_BAR; PG8_WAIT_L(0); PG8_MMA(1, 0, At, B0); PG8_BAR; PG8_SCHED;
            PG8_STAGE(PG8_SB(1, 1), b3 + hsB, voffB);
            PG8_WAIT_V(6); PG8_BAR; PG8_MMA(1, 1, At, B1); PG8_BAR;
            }
        }
        if constexpr (ALIGN_EPI) { if (wr == 0) PG8_BAR; }
        if constexpr (FP8) asm volatile("s_nop 15\n\ts_nop 15" ::: "memory");
#ifdef PG8_EPI2
        if constexpr (!Epi::AFTER_DRAIN && PG8_EPI2(Epi)) { E(acc, cur, wr, wc, fr, fq); asm volatile("" ::: "memory"); }
#endif
        if constexpr (!Epi::AFTER_DRAIN) { E(acc, cur, wr, wc, fr, fq); S.done(cur); }
        if (!has_next) break;
#pragma unroll
        for (int a = 0; a < 2; ++a)
#pragma unroll
            for (int b = 0; b < 2; ++b)
#pragma unroll
                for (int m = 0; m < 4; ++m)
#pragma unroll
                    for (int n = 0; n < 2; ++n) acc[a][b][m][n] = (f32x4){0.f, 0.f, 0.f, 0.f};
        cur = nxt; cA = nA; cB = nB; ++ui;
        if constexpr (ALIGN_EPI) { if (wr == 1) PG8_BAR; }
    }
    PG8_WAIT_V(0);
    if constexpr (!ALIGN_EPI) { if (wr == 0) PG8_BAR; }
    PG8_BAR;
    if constexpr (Epi::AFTER_DRAIN) { E.fused(acc, cur, wr, wc, fr, fq, lds, wid, lane); S.done(cur); }
#undef PG8_SA
#undef PG8_SB
#undef PG8_STAGE
#undef PG8_LDA
#undef PG8_LDB
#undef PG8_MMA
#undef PG8_WAIT_V
#undef PG8_WAIT_L
#undef PG8_BAR
#undef PG8_SCHED
}
}

constexpr int NWAVES = 8, NTHREADS = NWAVES * 64;
constexpr int M_TOK = 16384, SEQ = 4096, D = 2048, FFA = 8192, HA = 4096, NGA = 16, CHUNK = 128;
constexpr int NKEYS = 128, NEXP = 16384, HEADS = 8, TOPK = 16, NSEL = HEADS * TOPK;
constexpr float ALPHA = 1.41421356237f, LN_EPS = 1e-5f;
constexpr float X4_SCALE = 1.25f;
constexpr float M_SCALE = 32.0f;
constexpr float U_SCALE = 16.0f;
constexpr float G_SCALE = 16.0f, W2_SCALE = 2048.0f;
constexpr float W1_SCALE = 1024.0f;
constexpr int N_PHASES = 17;

constexpr size_t MiB = 1u << 20;
constexpr size_t WS_CTL = 0, CTL_ZERO_BYTES = 1 * MiB;
constexpr size_t WS_W1T = 2 * MiB, WS_W2T = 34 * MiB, WS_BINT = 50 * MiB, WS_BOUTT = 58 * MiB, WS_WQT = 66 * MiB  , WS_BGT = 82 * MiB, WS_BD = 84 * MiB, WS_BDSK = 86 * MiB  ;
constexpr size_t WS_SU = 87 * MiB, WS_SV = 87 * MiB + 131072;
constexpr size_t WS_XB = 88 * MiB;
constexpr size_t WS_UT = 152 * MiB, WS_VTAB = 280 * MiB;
constexpr size_t WS_UG = 408 * MiB;
constexpr size_t WS_ST = 408 * MiB, WS_POOL = 408 * MiB, WS_MIXED = 472 * MiB;
constexpr size_t WS_VT = 536 * MiB;
constexpr size_t WS_Q = 536 * MiB, WS_H = 600 * MiB;
constexpr size_t WS_Y = 664 * MiB;
constexpr size_t WS_X1 = 792 * MiB;
constexpr size_t WS_EIDX = 920 * MiB, WS_GATE = 928 * MiB;
constexpr size_t WS_WQS = 936 * MiB;
constexpr size_t WS_XF = 952 * MiB;
constexpr size_t WS_SX0 = 984 * MiB;
constexpr size_t WS_END = 985 * MiB;
constexpr int CW_BAR = 4096;

constexpr int RING_OFF = 0, RING_BYTES = 131072;
constexpr int LDSCTL_OFF = RING_BYTES, MISC_OFF = LDSCTL_OFF + 320;
constexpr int IDS16_OFF = LDSCTL_OFF + 1024;
constexpr int IDS16_WAVE = 3584;
constexpr int LDS_BYTES = IDS16_OFF + 8 * IDS16_WAVE;
static_assert(MISC_OFF + 128 <= LDS_BYTES, "LDS map");

#define GAS __attribute__((address_space(1)))
#define LAS __attribute__((address_space(3)))
typedef unsigned short bf16;
typedef unsigned v4u __attribute__((ext_vector_type(4)));
typedef unsigned v2u __attribute__((ext_vector_type(2)));
typedef float f32x4 __attribute__((ext_vector_type(4)));
typedef __bf16 bf16x2_t __attribute__((ext_vector_type(2)));
typedef GAS unsigned gu32;
#define RLX_AGENT __ATOMIC_RELAXED, __HIP_MEMORY_SCOPE_AGENT
#define LDS_WAIT() asm volatile("s_waitcnt lgkmcnt(0)" ::: "memory")
#define VM_WAIT() asm volatile("s_waitcnt vmcnt(0)" ::: "memory")
__device__ __forceinline__ unsigned f2bf(float f) { unsigned u = __builtin_bit_cast(unsigned, f); return (u + 0x7fffu + ((u >> 16) & 1u)) >> 16; }
__device__ __forceinline__ unsigned pk2(float lo, float hi) { return f2bf(lo) | (f2bf(hi) << 16); }
__device__ __forceinline__ float bflo(unsigned w) { return __builtin_bit_cast(float, w << 16); }
__device__ __forceinline__ float bfhi(unsigned w) { return __builtin_bit_cast(float, w & 0xffff0000u); }
__device__ __forceinline__ float dot2_bf16(unsigned w, unsigned x, float acc) { return __builtin_amdgcn_fdot2_f32_bf16(__builtin_bit_cast(bf16x2_t, w), __builtin_bit_cast(bf16x2_t, x), acc, false); }
__device__ __forceinline__ float shx(float v, int m, int lane) { return __builtin_bit_cast(float, __builtin_amdgcn_ds_bpermute((lane ^ m) << 2, __builtin_bit_cast(int, v))); }
__device__ __forceinline__ float wave_sum_l(float v, int lane) {
#pragma unroll
    for (int o = 1; o < 64; o <<= 1) v += shx(v, o, lane);
    return v;
}

#define XB_TMO      128
#define XB_XCNT(j)  (256  + 64 * (j))
#define XB_XSUB(j)  (1280 + 64 * (j))
#define XB_XGEN(j)  (2304 + 64 * (j))
#define XB_TOP      3328
#define XB_TOPGEN   3392
#define XCD_BAR_WORDS 3456
#define XB_SPIN_CAP (1u << 20)

__device__ __forceinline__ unsigned xb_ld(unsigned* p)              { return __hip_atomic_load(p, __ATOMIC_RELAXED, __HIP_MEMORY_SCOPE_AGENT); }
__device__ __forceinline__ unsigned xb_add(unsigned* p, unsigned v) { return __hip_atomic_fetch_add(p, v, __ATOMIC_RELAXED, __HIP_MEMORY_SCOPE_AGENT); }
__device__ __forceinline__ unsigned xb_xcc_id() { return (unsigned)__builtin_amdgcn_s_getreg((3 << 11) | 20) & 0xFu; }
#define XB_SPIN(cond, bar) do { unsigned _sp = 0; while (cond) { __builtin_amdgcn_s_sleep(1); \
    if ((++_sp & 255u) == 0u) { if (xb_ld(&(bar)[XB_TMO])) break; if (_sp > XB_SPIN_CAP) { atomicAdd(&(bar)[XB_TMO], 1u); break; } } } } while (0)

struct XcdBarrier { unsigned* bar; unsigned x; volatile LAS unsigned* st; };

__device__ __forceinline__ XcdBarrier xcd_barrier_post(unsigned* bar, volatile LAS unsigned* st) {
    XcdBarrier b; b.bar = bar; b.x = xb_xcc_id(); b.st = st;
    if (threadIdx.x == 0) (void)xb_add(&bar[XB_XCNT(b.x)], 1u);
    return b;
}
__device__ __forceinline__ void xcd_barrier_complete(unsigned* bar, unsigned x, unsigned& nloc, unsigned& nx) {
    const unsigned G = gridDim.x * gridDim.y * gridDim.z;
    unsigned sum, cnt, mine, sp = 0u;
    for (;;) {
        sum = 0u; cnt = 0u; mine = 0u;
#pragma unroll
        for (unsigned j = 0; j < 16; ++j) { const unsigned c = xb_ld(&bar[XB_XCNT(j)]); sum += c; cnt += (c > 0u) ? 1u : 0u; mine = (j == x) ? c : mine; }
        if (sum == G) break;
        __builtin_amdgcn_s_sleep(1);
        if ((++sp & 255u) == 0u) { if (xb_ld(&bar[XB_TMO])) break; if (sp > XB_SPIN_CAP) { atomicAdd(&bar[XB_TMO], 1u); break; } }
    }
    nloc = mine > 0u ? mine : 1u; nx = cnt > 0u ? cnt : 1u;
}
__device__ __forceinline__ void xcd_barrier(const XcdBarrier& b, const int tid) {
    asm volatile("s_waitcnt vmcnt(0)" ::: "memory");
    __syncthreads();
    if (tid == 0) {
        unsigned* bar = b.bar;
        __builtin_amdgcn_s_waitcnt(0);
        unsigned nloc = b.st[0], nx = b.st[1];
        if (nloc == 0u) { xcd_barrier_complete(bar, b.x, nloc, nx); b.st[0] = nloc; b.st[1] = nx; }
        const unsigned old = xb_add(&bar[XB_XSUB(b.x)], 1u);
        const unsigned gen = old / nloc;
        if (old + 1u == (gen + 1u) * nloc) {
            __builtin_amdgcn_fence(__ATOMIC_RELEASE, "agent");
            asm volatile("s_waitcnt vmcnt(0)" ::: "memory");
            const unsigned og = xb_add(&bar[XB_TOP], 1u);
            const unsigned tg = og / nx;
            if (og + 1u == (tg + 1u) * nx) xb_add(&bar[XB_TOPGEN], 1u);
            else XB_SPIN(xb_ld(&bar[XB_TOPGEN]) == tg, bar);
            __builtin_amdgcn_fence(__ATOMIC_ACQUIRE, "agent");
            xb_add(&bar[XB_XGEN(b.x)], 1u);
            asm volatile("s_waitcnt vmcnt(0)" ::: "memory");
        } else {
            XB_SPIN(xb_ld(&bar[XB_XGEN(b.x)]) == gen, bar);
            __builtin_amdgcn_fence(__ATOMIC_ACQUIRE, "agent");
            asm volatile("s_waitcnt vmcnt(0)" ::: "memory");
        }
    }
    __syncthreads();
}

__device__ __forceinline__ void p0_transpose_item(const float* W, int K, int N, bf16* WT, LAS float* scr, int item, int lane) {
    const int nblk = N / 32, kb = item / nblk, nb = item % nblk, k0 = 64 * kb, n0 = 32 * nb;
    float t[32];
#pragma unroll
    for (int i = 0; i < 32; ++i) t[i] = W[(size_t)(k0 + 2 * i + (lane >> 5)) * N + n0 + (lane & 31)];
#pragma unroll
    for (int i = 0; i < 32; ++i) scr[(2 * i + (lane >> 5)) * 33 + (lane & 31)] = t[i];
    LDS_WAIT(); asm volatile("" ::: "memory");
    const int c = lane & 7;
#pragma unroll
    for (int j = 0; j < 4; ++j) { const int n = (lane >> 3) + 8 * j; const LAS float* s = scr + (8 * c) * 33 + n;
        v4u o; o.x = pk2(s[0 * 33], s[1 * 33]); o.y = pk2(s[2 * 33], s[3 * 33]); o.z = pk2(s[4 * 33], s[5 * 33]); o.w = pk2(s[6 * 33], s[7 * 33]);
        *(GAS v4u*)(WT + (size_t)(n0 + n) * K + k0 + 8 * c) = o; }
    LDS_WAIT(); asm volatile("" ::: "memory");
}
__device__ __forceinline__ void p0_convert(const float* src, bf16* dst, int nchunks, int gw, int NGW, int lane) {
    for (int c0 = gw; c0 < nchunks; c0 += 4 * NGW) {
        f32x4 a[4][2];
#pragma unroll
        for (int q = 0; q < 4; ++q) { const int c = c0 + q * NGW; if (c < nchunks) { const GAS f32x4* s = (const GAS f32x4*)(src + (size_t)c * 512 + lane * 8); a[q][0] = s[0]; a[q][1] = s[1]; } }
#pragma unroll
        for (int q = 0; q < 4; ++q) { const int c = c0 + q * NGW; if (c < nchunks) { v4u o; o.x = pk2(a[q][0].x, a[q][0].y); o.y = pk2(a[q][0].z, a[q][0].w); o.z = pk2(a[q][1].x, a[q][1].y); o.w = pk2(a[q][1].z, a[q][1].w);
            *(GAS v4u*)(dst + (size_t)c * 512 + lane * 8) = o; } }
    }
}

__device__ __forceinline__ float clamp448(float v) { return __builtin_amdgcn_fmed3f(v, -448.0f, 448.0f); }
__device__ __forceinline__ unsigned pk4_fp8(float a, float b, float c, float d) { int w = 0; w = __builtin_amdgcn_cvt_pk_fp8_f32(clamp448(a), clamp448(b), w, false); w = __builtin_amdgcn_cvt_pk_fp8_f32(clamp448(c), clamp448(d), w, true); return (unsigned)w; }
__device__ __forceinline__ unsigned pk4_i8c(float a, float b, float c, float d) {
    const int q0 = (int)__builtin_rintf(__builtin_amdgcn_fmed3f(a, -127.f, 127.f)), q1 = (int)__builtin_rintf(__builtin_amdgcn_fmed3f(b, -127.f, 127.f)), q2 = (int)__builtin_rintf(__builtin_amdgcn_fmed3f(c, -127.f, 127.f)), q3 = (int)__builtin_rintf(__builtin_amdgcn_fmed3f(d, -127.f, 127.f));
    return ((unsigned)q0 & 0xffu) | (((unsigned)q1 & 0xffu) << 8) | (((unsigned)q2 & 0xffu) << 16) | ((unsigned)q3 << 24);
}
template <int NR> __device__ __forceinline__ void rows_to_i8(const float* x, unsigned char* o8, float* sx, int m0, int stride, int lane, LAS unsigned* scr  ) {
    f32x4 v[NR][8];
#pragma unroll
    for (int k = 0; k < NR; ++k) { const GAS f32x4* xr = (const GAS f32x4*)(x + (size_t)(m0 + k * stride) * D) + lane;
#pragma unroll
        for (int j = 0; j < 8; ++j) v[k][j] = xr[64 * j]; }
#pragma unroll
    for (int k = 0; k < NR; ++k) { float am = 0.f;
#pragma unroll
        for (int j = 0; j < 8; ++j) am = fmaxf(am, fmaxf(fmaxf(fabsf(v[k][j].x), fabsf(v[k][j].y)), fmaxf(fabsf(v[k][j].z), fabsf(v[k][j].w))));
#pragma unroll
        for (int o = 1; o < 64; o <<= 1) am = fmaxf(am, shx(am, o, lane));
        const float inv = am > 0.f ? 127.0f / am : 0.f; const size_t ro = (size_t)(m0 + k * stride) * D;
#pragma unroll
        for (int j = 0; j < 8; ++j) scr[64 * j + lane] = pk4_i8c(v[k][j].x * inv, v[k][j].y * inv, v[k][j].z * inv, v[k][j].w * inv);
        { const v4u a4 = *(const LAS v4u*)(scr + 4 * lane), b4 = *(const LAS v4u*)(scr + 256 + 4 * lane); ((GAS v4u*)(o8 + ro))[lane] = a4; ((GAS v4u*)(o8 + ro))[64 + lane] = b4; }
        if (lane == 0) ((GAS float*)sx)[m0 + k * stride] = am * (1.0f / 127.0f); }
}
template <bool I8> __device__ __forceinline__ void p0_transpose_item8(const float* W, int K, int N, unsigned char* WT, float scale, LAS float* scr, int item, int lane) {
    const int nblk = N / 32, kb = item / nblk, nb = item % nblk, k0 = 64 * kb, n0 = 32 * nb;
    float t[32];
#pragma unroll
    for (int i = 0; i < 32; ++i) t[i] = W[(size_t)(k0 + 2 * i + (lane >> 5)) * N + n0 + (lane & 31)];
#pragma unroll
    for (int i = 0; i < 32; ++i) scr[(2 * i + (lane >> 5)) * 33 + (lane & 31)] = t[i] * scale;
    LDS_WAIT(); asm volatile("" ::: "memory");
    const int c = lane & 7;
#pragma unroll
    for (int j = 0; j < 4; ++j) { const int n = (lane >> 3) + 8 * j; const LAS float* s = scr + (8 * c) * 33 + n;
        v2u o; if (I8) { o.x = pk4_i8c(s[0 * 33], s[1 * 33], s[2 * 33], s[3 * 33]); o.y = pk4_i8c(s[4 * 33], s[5 * 33], s[6 * 33], s[7 * 33]); } else { o.x = pk4_fp8(s[0 * 33], s[1 * 33], s[2 * 33], s[3 * 33]); o.y = pk4_fp8(s[4 * 33], s[5 * 33], s[6 * 33], s[7 * 33]); }
        *(GAS v2u*)(WT + (size_t)(n0 + n) * K + k0 + 8 * c) = o; }
    LDS_WAIT(); asm volatile("" ::: "memory");
}
__device__ __forceinline__ void p0_convert8(const float* src, unsigned char* dst, float scale, int nchunks, int gw, int NGW, int lane) {
    for (int c0 = gw; c0 < nchunks; c0 += 8 * NGW) {
        f32x4 a[8][2];
#pragma unroll
        for (int q = 0; q < 8; ++q) { const int c = c0 + q * NGW; if (c < nchunks) { const GAS f32x4* s = (const GAS f32x4*)(src + (size_t)c * 512 + lane * 8); a[q][0] = s[0]; a[q][1] = s[1]; } }
#pragma unroll
        for (int q = 0; q < 8; ++q) { const int c = c0 + q * NGW; if (c < nchunks) { v2u o; o.x = pk4_fp8(a[q][0].x * scale, a[q][0].y * scale, a[q][0].z * scale, a[q][0].w * scale); o.y = pk4_fp8(a[q][1].x * scale, a[q][1].y * scale, a[q][1].z * scale, a[q][1].w * scale);
            *(GAS v2u*)(dst + (size_t)c * 512 + lane * 8) = o; } }
    }
}
__device__ __forceinline__ void p0_row_fp8(const float* src, unsigned char* dst, int e, float* scale, int lane) {
    f32x4 v[2][4]; float am = 0.f;
#pragma unroll
    for (int i = 0; i < 2; ++i)
#pragma unroll
        for (int q = 0; q < 4; ++q) { v[i][q] = *(const GAS f32x4*)(src + i * 1024 + lane * 16 + 4 * q);
            am = fmaxf(am, fmaxf(fmaxf(fabsf(v[i][q].x), fabsf(v[i][q].y)), fmaxf(fabsf(v[i][q].z), fabsf(v[i][q].w)))); }
#pragma unroll
    for (int o = 1; o < 64; o <<= 1) am = fmaxf(am, shx(am, o, lane));
    const float inv = am > 0.f ? 256.0f / am : 0.f;
#pragma unroll
    for (int i = 0; i < 2; ++i) { v4u w;
#pragma unroll
        for (int q = 0; q < 4; ++q) { int d = 0; d = __builtin_amdgcn_cvt_pk_fp8_f32(v[i][q].x * inv, v[i][q].y * inv, d, false); d = __builtin_amdgcn_cvt_pk_fp8_f32(v[i][q].z * inv, v[i][q].w * inv, d, true); w[q] = (unsigned)d; }
        *(GAS v4u*)(dst + (size_t)(i * 8 + (lane >> 3)) * (NEXP * 128) + (size_t)e * 128 + (lane & 7) * 16) = w; }
    if (lane == 0) *scale = am * (1.0f / 256.0f);
}

template <int NR> __device__ __forceinline__ void p0_row_fp4(const float* const (&src)[NR], unsigned char* const (&dst)[NR], const int (&e)[NR], float* const (&scale)[NR], LAS unsigned char* scr, int lane) {
    f32x4 v[NR][2][4];
#pragma unroll
    for (int k = 0; k < NR; ++k)
#pragma unroll
        for (int i = 0; i < 2; ++i)
#pragma unroll
            for (int q = 0; q < 4; ++q) v[k][i][q] = *(const GAS f32x4*)(src[k] + i * 1024 + lane * 16 + 4 * q);
#pragma unroll
    for (int k = 0; k < NR; ++k) { float am = 0.f;
#pragma unroll
        for (int i = 0; i < 2; ++i)
#pragma unroll
            for (int q = 0; q < 4; ++q) am = fmaxf(am, fmaxf(fmaxf(fabsf(v[k][i][q].x), fabsf(v[k][i][q].y)), fmaxf(fabsf(v[k][i][q].z), fabsf(v[k][i][q].w))));
#pragma unroll
        for (int o = 1; o < 64; o <<= 1) am = fmaxf(am, shx(am, o, lane));
        const float inv = am > 0.f ? 6.0f / am : 0.f;
#pragma unroll
        for (int i = 0; i < 2; ++i) { unsigned w0 = 0, w1 = 0;
            w0 = __builtin_amdgcn_cvt_scalef32_pk_fp4_f32(w0, v[k][i][0].x * inv, v[k][i][0].y * inv, 1.0f, 0); w0 = __builtin_amdgcn_cvt_scalef32_pk_fp4_f32(w0, v[k][i][0].z * inv, v[k][i][0].w * inv, 1.0f, 1);
            w0 = __builtin_amdgcn_cvt_scalef32_pk_fp4_f32(w0, v[k][i][1].x * inv, v[k][i][1].y * inv, 1.0f, 2); w0 = __builtin_amdgcn_cvt_scalef32_pk_fp4_f32(w0, v[k][i][1].z * inv, v[k][i][1].w * inv, 1.0f, 3);
            w1 = __builtin_amdgcn_cvt_scalef32_pk_fp4_f32(w1, v[k][i][2].x * inv, v[k][i][2].y * inv, 1.0f, 0); w1 = __builtin_amdgcn_cvt_scalef32_pk_fp4_f32(w1, v[k][i][2].z * inv, v[k][i][2].w * inv, 1.0f, 1);
            w1 = __builtin_amdgcn_cvt_scalef32_pk_fp4_f32(w1, v[k][i][3].x * inv, v[k][i][3].y * inv, 1.0f, 2); w1 = __builtin_amdgcn_cvt_scalef32_pk_fp4_f32(w1, v[k][i][3].z * inv, v[k][i][3].w * inv, 1.0f, 3);
            *(LAS v2u*)(scr + 2048 + (i * 64 + lane) * 8) = (v2u){w0, w1}; }
        { const v4u o4 = *(const LAS v4u*)(scr + 2048 + lane * 16);
          *(GAS v4u*)(dst[k] + (size_t)(lane >> 3) * (NEXP * 128) + (size_t)e[k] * 128 + (lane & 7) * 16) = o4; }
        if (lane == 0) *(GAS float*)scale[k] = am * (1.0f / 6.0f); }
}

template <int NR> __device__ __forceinline__ void p0_row_fp4t(const float* const (&src)[NR], unsigned char* const (&dst)[NR], const int (&e)[NR], float* const (&scale)[NR], LAS unsigned char* scr, int lane) {
    f32x4 v[NR][2][4];
#pragma unroll
    for (int k = 0; k < NR; ++k)
#pragma unroll
        for (int i = 0; i < 2; ++i)
#pragma unroll
            for (int q = 0; q < 4; ++q) v[k][i][q] = *(const GAS f32x4*)(src[k] + i * 1024 + lane * 16 + 4 * q);
#pragma unroll
    for (int k = 0; k < NR; ++k) { float am = 0.f;
#pragma unroll
        for (int i = 0; i < 2; ++i)
#pragma unroll
            for (int q = 0; q < 4; ++q) am = fmaxf(am, fmaxf(fmaxf(fabsf(v[k][i][q].x), fabsf(v[k][i][q].y)), fmaxf(fabsf(v[k][i][q].z), fabsf(v[k][i][q].w))));
#pragma unroll
        for (int o = 1; o < 64; o <<= 1) am = fmaxf(am, shx(am, o, lane));
        const float inv = am > 0.f ? 6.0f / am : 0.f;
#pragma unroll
        for (int i = 0; i < 2; ++i) { unsigned w0 = 0, w1 = 0;
            w0 = __builtin_amdgcn_cvt_scalef32_pk_fp4_f32(w0, v[k][i][0].x * inv, v[k][i][0].y * inv, 1.0f, 0); w0 = __builtin_amdgcn_cvt_scalef32_pk_fp4_f32(w0, v[k][i][0].z * inv, v[k][i][0].w * inv, 1.0f, 1);
            w0 = __builtin_amdgcn_cvt_scalef32_pk_fp4_f32(w0, v[k][i][1].x * inv, v[k][i][1].y * inv, 1.0f, 2); w0 = __builtin_amdgcn_cvt_scalef32_pk_fp4_f32(w0, v[k][i][1].z * inv, v[k][i][1].w * inv, 1.0f, 3);
            w1 = __builtin_amdgcn_cvt_scalef32_pk_fp4_f32(w1, v[k][i][2].x * inv, v[k][i][2].y * inv, 1.0f, 0); w1 = __builtin_amdgcn_cvt_scalef32_pk_fp4_f32(w1, v[k][i][2].z * inv, v[k][i][2].w * inv, 1.0f, 1);
            w1 = __builtin_amdgcn_cvt_scalef32_pk_fp4_f32(w1, v[k][i][3].x * inv, v[k][i][3].y * inv, 1.0f, 2); w1 = __builtin_amdgcn_cvt_scalef32_pk_fp4_f32(w1, v[k][i][3].z * inv, v[k][i][3].w * inv, 1.0f, 3);
            *(LAS v4u*)(scr + lane * 16) = (v4u){w0 & 0x0f0f0f0fu, (w0 >> 4) & 0x0f0f0f0fu, w1 & 0x0f0f0f0fu, (w1 >> 4) & 0x0f0f0f0fu};
            const int jj = lane & 15, oo = 4 * (jj & 3) + (jj >> 2), pos = (oo & 8) + ((oo & 1) << 2) + ((oo >> 1) & 3);
            const LAS unsigned char* col = scr + (lane & 48) * 16 + pos;
            unsigned o0 = 0, o1 = 0;
#pragma unroll
            for (int n = 0; n < 8; ++n) { o0 |= (unsigned)col[n * 16] << (4 * n); o1 |= (unsigned)col[(n + 8) * 16] << (4 * n); }
            *(LAS v2u*)(scr + 2048 + (i * 64 + lane) * 8) = (v2u){o0, o1};
            asm volatile("s_waitcnt lgkmcnt(0)" ::: "memory"); }
        { const v4u o4 = *(const LAS v4u*)(scr + 2048 + lane * 16);
          *(GAS v4u*)(dst[k] + (size_t)(lane >> 3) * (NEXP * 128) + (size_t)e[k] * 128 + (lane & 7) * 16) = o4; }
        if (lane == 0) *(GAS float*)scale[k] = am * (1.0f / 6.0f); }
}

#define LN8_UNPACK(q_) {bflo((q_)[0]), bfhi((q_)[0]), bflo((q_)[1]), bfhi((q_)[1]), bflo((q_)[2]), bfhi((q_)[2]), bflo((q_)[3]), bfhi((q_)[3])}
template <int NR> __device__ __forceinline__ void ln_rows(const bf16* y, const float* g, const float* b, bf16* ob, unsigned char* o8h, unsigned char* o8, float* sx, int m0, int stride, int lane, LAS unsigned* scr  ) {
    float v[NR][4][8];
#pragma unroll
    for (int k = 0; k < NR; ++k) { const GAS v4u* yr = (const GAS v4u*)(y + (size_t)(m0 + k * stride) * D) + lane; v4u w[4];
#pragma unroll
        for (int j = 0; j < 4; ++j) w[j] = yr[64 * j];
#pragma unroll
        for (int j = 0; j < 4; ++j) { const float f[8] = LN8_UNPACK(w[j]);
#pragma unroll
            for (int e = 0; e < 8; ++e) v[k][j][e] = f[e]; } }
    const GAS f32x4* g4 = (const GAS f32x4*)g + 2 * lane; const GAS f32x4* b4 = (const GAS f32x4*)b + 2 * lane;
#pragma unroll
    for (int k = 0; k < NR; ++k) { float s = 0.f;
#pragma unroll
        for (int j = 0; j < 4; ++j) s += ((v[k][j][0] + v[k][j][1]) + (v[k][j][2] + v[k][j][3])) + ((v[k][j][4] + v[k][j][5]) + (v[k][j][6] + v[k][j][7]));
        const float mean = wave_sum_l(s, lane) * (1.f / D); float s2 = 0.f;
#pragma unroll
        for (int j = 0; j < 4; ++j)
#pragma unroll
            for (int e = 0; e < 8; ++e) { v[k][j][e] -= mean; s2 += v[k][j][e] * v[k][j][e]; }
        const float rstd = 1.f / sqrtf(wave_sum_l(s2, lane) * (1.f / D) + LN_EPS);
        const size_t ro = (size_t)(m0 + k * stride) * D; float am = 0.f;
#pragma unroll
        for (int j = 0; j < 4; ++j) { const f32x4 ga = g4[128 * j], gb = g4[128 * j + 1], ba = b4[128 * j], bb = b4[128 * j + 1];
            const float gg[8] = {ga.x, ga.y, ga.z, ga.w, gb.x, gb.y, gb.z, gb.w}, be[8] = {ba.x, ba.y, ba.z, ba.w, bb.x, bb.y, bb.z, bb.w}; float o[8];
#pragma unroll
            for (int e = 0; e < 8; ++e) { o[e] = v[k][j][e] * rstd * gg[e] + be[e]; v[k][j][e] = o[e]; am = fmaxf(am, fabsf(o[e])); }
            ((GAS v4u*)(ob + ro) + lane)[64 * j] = (v4u){pk2(o[0], o[1]), pk2(o[2], o[3]), pk2(o[4], o[5]), pk2(o[6], o[7])};
            {
                unsigned hi = 0, lo = 0;
#define LN8_HI(e) hi = __builtin_amdgcn_cvt_scalef32_pk_fp4_f32(hi, o[2 * e] * X4_SCALE, o[2 * e + 1] * X4_SCALE, 1.0f, e)
#define LN8_LO(e) { const auto hv = __builtin_amdgcn_cvt_scalef32_pk_f32_fp4(hi, 1.0f, e); lo = __builtin_amdgcn_cvt_scalef32_pk_fp4_f32(lo, (o[2 * e] * X4_SCALE - hv[0]) * 4.0f, (o[2 * e + 1] * X4_SCALE - hv[1]) * 4.0f, 1.0f, e); }
                LN8_HI(0); LN8_HI(1); LN8_HI(2); LN8_HI(3); LN8_LO(0) LN8_LO(1) LN8_LO(2) LN8_LO(3)
                scr[64 * j + lane] = hi; scr[256 + 64 * j + lane] = lo; } }
        { const v4u h4 = *(const LAS v4u*)(scr + 4 * lane), l4 = *(const LAS v4u*)(scr + 256 + 4 * lane);
          ((GAS v4u*)(o8h + ro / 2))[lane] = h4; ((GAS v4u*)(o8h + (size_t)M_TOK * (D / 2) + ro / 2))[lane] = l4; }
        {
#pragma unroll
            for (int o2 = 1; o2 < 64; o2 <<= 1) am = fmaxf(am, shx(am, o2, lane));
            const float inv = am > 0.f ? 127.0f / am : 0.f;
#pragma unroll
            for (int j = 0; j < 4; ++j) *(LAS v2u*)(scr + 512 + 2 * (64 * j + lane)) = (v2u){pk4_i8c(v[k][j][0] * inv, v[k][j][1] * inv, v[k][j][2] * inv, v[k][j][3] * inv), pk4_i8c(v[k][j][4] * inv, v[k][j][5] * inv, v[k][j][6] * inv, v[k][j][7] * inv)};
            { const v4u a4 = *(const LAS v4u*)(scr + 512 + 4 * lane), b4q = *(const LAS v4u*)(scr + 768 + 4 * lane); ((GAS v4u*)(o8 + ro))[lane] = a4; ((GAS v4u*)(o8 + ro))[64 + lane] = b4q; }
            if (lane == 0) ((GAS float*)sx)[ro / D] = am * (1.0f / 127.0f); }
    }
}
template <int NR> __device__ __forceinline__ void rows_bf16_to_i8(const bf16* x, unsigned char* o8, float* sx, int m0, int stride, int lane) {
#pragma unroll
    for (int k = 0; k < NR; ++k) { const size_t ro = (size_t)(m0 + k * stride) * D; const GAS v2u* xr = (const GAS v2u*)(x + ro) + lane; f32x4 v[8]; float am = 0.f;
#pragma unroll
        for (int j = 0; j < 8; ++j) { const v2u w = xr[64 * j]; v[j] = (f32x4){bflo(w.x), bfhi(w.x), bflo(w.y), bfhi(w.y)};
            am = fmaxf(am, fmaxf(fmaxf(fabsf(v[j].x), fabsf(v[j].y)), fmaxf(fabsf(v[j].z), fabsf(v[j].w)))); }
#pragma unroll
        for (int o = 1; o < 64; o <<= 1) am = fmaxf(am, shx(am, o, lane));
        const float inv = am > 0.f ? 127.0f / am : 0.f;
#pragma unroll
        for (int j = 0; j < 8; ++j) ((GAS unsigned*)(o8 + ro) + lane)[64 * j] = pk4_i8c(v[j].x * inv, v[j].y * inv, v[j].z * inv, v[j].w * inv);
        if (lane == 0) ((GAS float*)sx)[m0 + k * stride] = am * (1.0f / 127.0f); }
}

__device__ __forceinline__ void ins16(float (&L)[16], float key) {
#pragma unroll
    for (int j = 15; j >= 1; --j) L[j] = __builtin_amdgcn_fmed3f(L[j - 1], L[j], key);
    L[0] = fmaxf(L[0], key);
}
#define FENCE16(L) do { _Pragma("unroll") for (int _j = 0; _j < 16; ++_j) asm("" : "+v"(L[_j])); } while (0)
__device__ __forceinline__ void topk_lane(const bf16* ST, int h, int t, int* eidx, float* gate) {
    const float NEG = -__builtin_inff();
    float L1[16], L2[16];
#pragma unroll
    for (int j = 0; j < 16; ++j) { L1[j] = NEG; L2[j] = NEG; }
    const GAS bf16* s1 = (const GAS bf16*)ST + (size_t)(h * 256) * M_TOK + t;
    const GAS bf16* s2 = s1 + (size_t)128 * M_TOK;
#pragma nounroll
    for (int n0 = 0; n0 < NKEYS; n0 += 32) {
        unsigned ca[32], cb[32];
#pragma unroll
        for (int q = 0; q < 32; ++q) { ca[q] = s1[(size_t)(n0 + q) * M_TOK]; cb[q] = s2[(size_t)(n0 + q) * M_TOK]; }
#pragma unroll
        for (int q = 0; q < 32; ++q) {
            const unsigned tag = (unsigned)(127 - n0 - q);
            const float ka = __builtin_bit_cast(float, (ca[q] << 16) | tag);
            const float kb = __builtin_bit_cast(float, (cb[q] << 16) | tag);
            ins16(L1, ka); ins16(L2, kb);
            FENCE16(L1); FENCE16(L2);
        }
    }
    unsigned long long p1lo = 0, p1hi = 0, p2lo = 0, p2hi = 0;
#pragma unroll
    for (int j = 0; j < 8; ++j) {
        p1lo |= (unsigned long long)(127u - (__builtin_bit_cast(unsigned, L1[j]) & 127u)) << (8 * j); p1hi |= (unsigned long long)(127u - (__builtin_bit_cast(unsigned, L1[j + 8]) & 127u)) << (8 * j);
        p2lo |= (unsigned long long)(127u - (__builtin_bit_cast(unsigned, L2[j]) & 127u)) << (8 * j); p2hi |= (unsigned long long)(127u - (__builtin_bit_cast(unsigned, L2[j + 8]) & 127u)) << (8 * j); }
    float T[16];
#pragma unroll
    for (int j = 0; j < 16; ++j) T[j] = NEG;
#pragma unroll
    for (int a = 0; a < 16; ++a)
#pragma unroll
        for (int b = 0; b < 16; ++b)
            if ((a + 1) * (b + 1) <= 16) { const float sm = L1[a] + L2[b];
                ins16(T, __builtin_bit_cast(float, (__builtin_bit_cast(unsigned, sm) & ~255u) | (unsigned)(255 - (a * 16 + b)))); FENCE16(T); }
    float e[16], sum = 0.f; int I[16];
#pragma unroll
    for (int j = 0; j < 16; ++j) { e[j] = __builtin_amdgcn_exp2f((T[j] - T[0]) * 1.4426950409f); sum += e[j];
        const unsigned code = 255u - (__builtin_bit_cast(unsigned, T[j]) & 255u); const unsigned a = code >> 4, b = code & 15u;
        const unsigned long long wa = (a & 8u) ? p1hi : p1lo, wb = (b & 8u) ? p2hi : p2lo;
        const unsigned ia = (unsigned)(wa >> ((a & 7u) * 8u)) & 127u, ib = (unsigned)(wb >> ((b & 7u) * 8u)) & 127u;
        I[j] = (int)(ia * NKEYS + ib); }
    const float inv = 1.0f / sum;
    GAS int* eo = (GAS int*)eidx + (size_t)t * NSEL + h * TOPK; GAS float* go = (GAS float*)gate + (size_t)t * NSEL + h * TOPK;
#pragma unroll
    for (int j = 0; j < 16; j += 4) { typedef int i32x4 __attribute__((ext_vector_type(4)));
        *(GAS i32x4*)(eo + j) = (i32x4){I[j], I[j + 1], I[j + 2], I[j + 3]}; *(GAS f32x4*)(go + j) = (f32x4){e[j] * inv, e[j + 1] * inv, e[j + 2] * inv, e[j + 3] * inv}; }
}

constexpr int CHUNK_STRIDE = NEXP * 128;
typedef float f32x2 __attribute__((ext_vector_type(2)));
typedef int i32x4 __attribute__((ext_vector_type(4)));
#define PIN8(a, b) asm volatile("" : "+v"(a[b]), "+v"(a[b + 1]), "+v"(a[b + 2]), "+v"(a[b + 3]), "+v"(a[b + 4]), "+v"(a[b + 5]), "+v"(a[b + 6]), "+v"(a[b + 7]) :: "memory")
__device__ __forceinline__ f32x2 shx2(f32x2 v, int m, int lane) { return (f32x2){shx(v.x, m, lane), shx(v.y, m, lane)}; }

#define GAT_FETCHV(dst, rs, voff, soff) dst = __builtin_bit_cast(v4u, __builtin_amdgcn_raw_buffer_load_b128(rs, (int)(voff), soff, 0))
template <int NR> __device__ __forceinline__ void ln_res_rows(const bf16* x, const bf16* o, const float* g, const float* b, float* of, bf16* ob, unsigned char* o8, float* sx, size_t ro0, size_t rstride, int lane, LAS unsigned* scr  ) {
    float v[NR][4][8];
#pragma unroll
    for (int k = 0; k < NR; ++k) { const GAS v4u* xr = (const GAS v4u*)(x + ro0 + k * rstride) + lane; const GAS v4u* orr = (const GAS v4u*)(o + ro0 + k * rstride) + lane; v4u xw[4], ow[4];
#pragma unroll
        for (int j = 0; j < 4; ++j) { xw[j] = xr[64 * j]; ow[j] = orr[64 * j]; }
#pragma unroll
        for (int j = 0; j < 4; ++j) { const float xf[8] = LN8_UNPACK(xw[j]), of8[8] = LN8_UNPACK(ow[j]);
#pragma unroll
            for (int e = 0; e < 8; ++e) v[k][j][e] = xf[e] * ALPHA + of8[e]; } }
    const GAS f32x4* g4 = (const GAS f32x4*)g + 2 * lane; const GAS f32x4* b4 = (const GAS f32x4*)b + 2 * lane;
#pragma unroll
    for (int k = 0; k < NR; ++k) { float s = 0.f;
#pragma unroll
        for (int j = 0; j < 4; ++j) s += ((v[k][j][0] + v[k][j][1]) + (v[k][j][2] + v[k][j][3])) + ((v[k][j][4] + v[k][j][5]) + (v[k][j][6] + v[k][j][7]));
        const float mean = wave_sum_l(s, lane) * (1.f / D); float s2 = 0.f;
#pragma unroll
        for (int j = 0; j < 4; ++j)
#pragma unroll
            for (int e = 0; e < 8; ++e) { v[k][j][e] -= mean; s2 += v[k][j][e] * v[k][j][e]; }
        const float rstd = 1.f / sqrtf(wave_sum_l(s2, lane) * (1.f / D) + LN_EPS);
        const size_t ro = ro0 + k * rstride;
        float am = 0.f;
#pragma unroll
        for (int j = 0; j < 4; ++j) { const f32x4 ga = g4[128 * j], gb = g4[128 * j + 1], ba = b4[128 * j], bb = b4[128 * j + 1];
            const float gg[8] = {ga.x, ga.y, ga.z, ga.w, gb.x, gb.y, gb.z, gb.w}, be[8] = {ba.x, ba.y, ba.z, ba.w, bb.x, bb.y, bb.z, bb.w}; float q[8];
#pragma unroll
            for (int e = 0; e < 8; ++e) { q[e] = v[k][j][e] * rstd * gg[e] + be[e]; v[k][j][e] = q[e]; am = fmaxf(am, fabsf(q[e])); }
            if (of) { ((GAS f32x4*)(of + ro) + 2 * lane)[128 * j] = (f32x4){q[0], q[1], q[2], q[3]}; ((GAS f32x4*)(of + ro) + 2 * lane)[128 * j + 1] = (f32x4){q[4], q[5], q[6], q[7]}; }
            if (ob) ((GAS v4u*)(ob + ro) + lane)[64 * j] = (v4u){pk2(q[0], q[1]), pk2(q[2], q[3]), pk2(q[4], q[5]), pk2(q[6], q[7])}; }
        if (o8) {
#pragma unroll
            for (int o2 = 1; o2 < 64; o2 <<= 1) am = fmaxf(am, shx(am, o2, lane));
            const float inv = am > 0.f ? 127.0f / am : 0.f;
#pragma unroll
            for (int j = 0; j < 4; ++j) *(LAS v2u*)(scr + 2 * (64 * j + lane)) = (v2u){pk4_i8c(v[k][j][0] * inv, v[k][j][1] * inv, v[k][j][2] * inv, v[k][j][3] * inv), pk4_i8c(v[k][j][4] * inv, v[k][j][5] * inv, v[k][j][6] * inv, v[k][j][7] * inv)};
            { const v4u a4 = *(const LAS v4u*)(scr + 4 * lane), b4q = *(const LAS v4u*)(scr + 256 + 4 * lane); ((GAS v4u*)(o8 + ro))[lane] = a4; ((GAS v4u*)(o8 + ro))[64 + lane] = b4q; }
            if (lane == 0) ((GAS float*)sx)[ro / D] = am * (1.0f / 127.0f); }
    }
}
#if defined(GAT_PMASK)
#define GAT_PM(R) (rep + 1 < (R) ? (unsigned)GAT_PMASK : 0x3fffu)
#else
#define GAT_PM(R) 0xffffffffu
#endif
#define GAT_FETCH4(rs, voff, soff) __builtin_amdgcn_raw_buffer_load_b128(rs, (int)(voff), soff, 0)
#define GAT_ACC(c, d) c = __builtin_fmaf(d.x, wq.x, __builtin_fmaf(d.y, wq.y, __builtin_fmaf(d.z, wq.z, __builtin_fmaf(d.w, wq.w, c))))
#define GAT_A8(a4) __builtin_shufflevector(a4, a4, 0, 1, 2, 3, -1, -1, -1, -1)
__device__ __forceinline__ void gat_u_mfma(float (&ccur)[8], float (&cprev)[8], f32x4 (&dp)[2], i32x4 (&A)[16], const i32x4 b1h, const i32x4 b2h, const i32x4 b1l, const i32x4 b2l, const LAS unsigned* enx, __amdgpu_buffer_rsrc_t rs, int soffn,
                                           const unsigned pofs, const f32x4 wq, const int s127, const int s125, const unsigned pm = 0xffffffffu) {
    v2u en0 = *(const LAS v2u*)(enx), en1 = *(const LAS v2u*)(enx + 16);
    f32x4 d0 = dp[0], d1 = dp[1];
#pragma unroll
    for (int g = 0; g < 8; ++g) {
        const v2u en2 = *(const LAS v2u*)(enx + ((g + 2) & 7) * 16);
        f32x4 d = __builtin_amdgcn_mfma_scale_f32_16x16x128_f8f6f4(GAT_A8(A[2 * g]), GAT_A8(b1h), (f32x4){0.f, 0.f, 0.f, 0.f}, 4, 4, 0, s127, 0, s127);
        d = __builtin_amdgcn_mfma_scale_f32_16x16x128_f8f6f4(GAT_A8(A[2 * g + 1]), GAT_A8(b2h), d, 4, 4, 0, s127, 0, s127);
        d = __builtin_amdgcn_mfma_scale_f32_16x16x128_f8f6f4(GAT_A8(A[2 * g]), GAT_A8(b1l), d, 4, 4, 0, s127, 0, s125);
        d = __builtin_amdgcn_mfma_scale_f32_16x16x128_f8f6f4(GAT_A8(A[2 * g + 1]), GAT_A8(b2l), d, 4, 4, 0, s127, 0, s125);
        A[2 * g] = __builtin_bit_cast(i32x4, GAT_FETCH4(rs, ((en0.x & pm) << 7) + pofs, soffn)); A[2 * g + 1] = __builtin_bit_cast(i32x4, GAT_FETCH4(rs, ((en0.y & pm) << 7) + pofs, soffn));
        if (g == 0) GAT_ACC(cprev[6], d0); else if (g == 1) GAT_ACC(cprev[7], d0); else GAT_ACC(ccur[g - 2], d0);
        d0 = d1; d1 = d; en0 = en1; en1 = en2;
        __builtin_amdgcn_sched_barrier(0);
    }
    dp[0] = d0; dp[1] = d1;
}
__device__ __forceinline__ float quad_sum(float v) {
    v += __builtin_bit_cast(float, __builtin_amdgcn_update_dpp(0, __builtin_bit_cast(int, v), 0xB1, 0xf, 0xf, false));
    v += __builtin_bit_cast(float, __builtin_amdgcn_update_dpp(0, __builtin_bit_cast(int, v), 0x4E, 0xf, 0xf, false));
    return v;
}
__device__ __forceinline__ f32x2 gat_v_step8(const float (&act)[16], float (&actn)[16], const LAS float* apn, v4u (&w)[16], const LAS unsigned* enx, __amdgpu_buffer_rsrc_t rs, int soffn, const unsigned jofs, int lane, const unsigned pm = 0xffffffffu) {
    f32x2 acc[8];
#pragma unroll
    for (int p = 0; p < 8; ++p) acc[p] = (f32x2){0.f, 0.f};
    v4u e0 = *(const LAS v4u*)(enx), e1 = e0;
#pragma unroll
    for (int i = 0; i < 16; ++i) { const f32x2 aa = {act[i], act[i]};
        if ((i & 3) == 0 && i < 12) e1 = *(const LAS v4u*)(enx + i + 4);
        if ((i & 3) == 1) { const f32x4 a4 = *(const LAS f32x4*)(apn + (i >> 2) * 4); actn[(i >> 2) * 4] = a4.x; actn[(i >> 2) * 4 + 1] = a4.y; actn[(i >> 2) * 4 + 2] = a4.z; actn[(i >> 2) * 4 + 3] = a4.w; }
#pragma unroll
        for (int c = 0; c < 4; ++c) { const f32x2 lo = __builtin_amdgcn_cvt_pk_f32_fp8((int)w[i][c], false), hi = __builtin_amdgcn_cvt_pk_f32_fp8((int)w[i][c], true);
            acc[2 * c] = __builtin_elementwise_fma(lo, aa, acc[2 * c]); acc[2 * c + 1] = __builtin_elementwise_fma(hi, aa, acc[2 * c + 1]); }
        asm volatile("" : "+v"(acc[0]), "+v"(acc[1]), "+v"(acc[2]), "+v"(acc[3]), "+v"(acc[4]), "+v"(acc[5]), "+v"(acc[6]), "+v"(acc[7]) :: "memory");
        GAT_FETCHV(w[i], rs, ((e0[i & 3] & pm) << 7) + jofs, soffn);
        if ((i & 3) == 3) e0 = e1;
        __builtin_amdgcn_sched_barrier(0);
    }
    const bool b3 = lane & 8, b4 = lane & 16, b5 = lane & 32;
    f32x2 ka[4], kb[2];
#pragma unroll
    for (int i = 0; i < 4; ++i) { const f32x2 keep = b3 ? acc[4 + i] : acc[i], send = b3 ? acc[i] : acc[4 + i]; ka[i] = keep + shx2(send, 8, lane); }
#pragma unroll
    for (int i = 0; i < 2; ++i) { const f32x2 keep = b4 ? ka[2 + i] : ka[i], send = b4 ? ka[i] : ka[2 + i]; kb[i] = keep + shx2(send, 16, lane); }
    const f32x2 keep = b5 ? kb[1] : kb[0], send = b5 ? kb[0] : kb[1];
    return keep + shx2(send, 32, lane);
}
__device__ __forceinline__ void peer_chunked(const unsigned char* utab, const unsigned char* vtab, const float* su, const float* sv, const int* eidx, const float* gate, const bf16* xres, const unsigned char* x8h,
                                             float* ybuf, const float* lng, const float* lnb, float* of, bf16* ob, unsigned char* o8, float* sx8, int gw, int NGW, LAS unsigned* vol, LAS unsigned* vids, const unsigned emask = 0x3fffu) {
    const __amdgpu_buffer_rsrc_t rsxh = __builtin_amdgcn_make_buffer_rsrc((void*)x8h, (short)0, M_TOK * (D / 2), 0x00020000), rsxl = __builtin_amdgcn_make_buffer_rsrc((void*)(x8h + (size_t)M_TOK * (D / 2)), (short)0, M_TOK * (D / 2), 0x00020000);
    const __amdgpu_buffer_rsrc_t rsy = __builtin_amdgcn_make_buffer_rsrc((void*)ybuf, (short)0, M_TOK * D * 2, 0x00020000);
    const __amdgpu_buffer_rsrc_t rsu = __builtin_amdgcn_make_buffer_rsrc((void*)utab, (short)0, NEXP * (D / 2), 0x00020000), rsv = __builtin_amdgcn_make_buffer_rsrc((void*)vtab, (short)0, NEXP * (D / 2), 0x00020000);
    LAS unsigned* et = vol; LAS float* actl = (LAS float*)(vol + 1024);
    {   int zz = 0; asm volatile("" : "+s"(zz));
        const int lane = __builtin_amdgcn_mbcnt_hi(-1, __builtin_amdgcn_mbcnt_lo(-1, zz));
#pragma unroll
        for (int q = 0; q < 8; ++q) { const v2u v = *(const GAS v2u*)(eidx + (size_t)(gw + q * NGW) * NSEL + 2 * lane); *(LAS v2u*)(et + q * 128 + 2 * lane) = (v2u){v.x & emask, v.y & emask}; }
        asm volatile("s_waitcnt lgkmcnt(0)" ::: "memory");
    }
    float osc[8];
#ifdef GAT_UREP
#pragma nounroll
    for (int rep = 0; rep < GAT_UREP; ++rep)
#endif
    {   int zz = 0; asm volatile("" : "+s"(zz));
        const int lu = __builtin_amdgcn_mbcnt_hi(-1, __builtin_amdgcn_mbcnt_lo(-1, zz));
        const int kbu = lu >> 4, q4 = lu & 3;
        const LAS unsigned* eu = et + 4 * ((lu >> 2) & 3) + 2 * (kbu >> 1);
        const unsigned pofs = (unsigned)(4 * (kbu & 1) + q4) * 16u;
        const bool bon = (kbu >> 1) == ((lu >> 3) & 1);
        const int m1 = (bon && ((lu >> 2) & 1) == 0) ? -1 : 0, m2 = (bon && ((lu >> 2) & 1) == 1) ? -1 : 0;
        int s127 = 127, s125 = 125; asm volatile("" : "+v"(s127), "+v"(s125));
        f32x4 wq = {q4 == 0 ? 1.f : 0.f, q4 == 1 ? 1.f : 0.f, q4 == 2 ? 1.f : 0.f, q4 == 3 ? 1.f : 0.f}; asm volatile("" : "+v"(wq));
        float cacc[8][8]; f32x4 dp[2] = {{0.f, 0.f, 0.f, 0.f}, {0.f, 0.f, 0.f, 0.f}};
#pragma unroll
        for (int q = 0; q < 8; ++q)
#pragma unroll
            for (int g = 0; g < 8; ++g) cacc[q][g] = 0.f;
        i32x4 A[16], xh0, xl0, xh1, xl1;
#define GAT_XLOAD8(dh, dl, q, cc) do { dh = __builtin_bit_cast(i32x4, __builtin_amdgcn_raw_buffer_load_b128(rsxh, (gw + (q) * NGW) * (D / 2) + (int)pofs, (cc) * 128, 0)); dl = __builtin_bit_cast(i32x4, __builtin_amdgcn_raw_buffer_load_b128(rsxl, (gw + (q) * NGW) * (D / 2) + (int)pofs, (cc) * 128, 0)); } while (0)
#define GAT_BUILD(b, r, m) const i32x4 b = {r[0] & m, r[1] & m, r[2] & m, r[3] & m}
#define GAT_USTEP(q, qn, cc, xhc, xlc, xhn, xln) { GAT_XLOAD8(xhn, xln, qn, cc); GAT_BUILD(b1h, xhc, m1); GAT_BUILD(b2h, xhc, m2); GAT_BUILD(b1l, xlc, m1); GAT_BUILD(b2l, xlc, m2); \
            gat_u_mfma(cacc[q], cacc[((q) + 7) & 7], dp, A, b1h, b2h, b1l, b2l, eu + (qn) * 128, rsu, (cc) * CHUNK_STRIDE, pofs, wq, s127, s125, GAT_PM(GAT_UREP)); }
        GAT_XLOAD8(xh0, xl0, 0, 0);
#pragma unroll
        for (int g = 0; g < 8; ++g) { const v2u en = *(const LAS v2u*)(eu + g * 16);
            A[2 * g] = __builtin_bit_cast(i32x4, GAT_FETCH4(rsu, (en.x << 7) + pofs, 0)); A[2 * g + 1] = __builtin_bit_cast(i32x4, GAT_FETCH4(rsu, (en.y << 7) + pofs, 0)); }
#pragma nounroll
        for (int c = 0; c < 8; ++c) {
            const int cn = c < 7 ? c + 1 : 7;
            GAT_USTEP(0, 1, c, xh0, xl0, xh1, xl1) GAT_USTEP(1, 2, c, xh1, xl1, xh0, xl0) GAT_USTEP(2, 3, c, xh0, xl0, xh1, xl1) GAT_USTEP(3, 4, c, xh1, xl1, xh0, xl0)
            GAT_USTEP(4, 5, c, xh0, xl0, xh1, xl1) GAT_USTEP(5, 6, c, xh1, xl1, xh0, xl0) GAT_USTEP(6, 7, c, xh0, xl0, xh1, xl1) GAT_USTEP(7, 0, cn, xh1, xl1, xh0, xl0)
        }
        GAT_ACC(cacc[7][6], dp[0]); GAT_ACC(cacc[7][7], dp[1]);
        const int ei = lu >> 2;
        LAS unsigned char* codes = (LAS unsigned char*)vol + 4096;
#pragma unroll
        for (int q = 0; q < 8; ++q) {
            float pe = 0.f, po = 0.f;
#pragma unroll
            for (int g = 0; g < 8; ++g) { const float s = quad_sum(cacc[q][g]);
                if (g & 1) po = (q4 == (g >> 1)) ? s : po; else pe = (q4 == (g >> 1)) ? s : pe; }
            const int pb = (2 * q4) * 16 + ei;
            const unsigned e0 = et[q * 128 + pb], e1 = et[q * 128 + pb + 16];
            const GAS float* gp = (const GAS float*)(gate + (size_t)(gw + q * NGW) * NSEL + pb);
            const float g0 = gp[0], g1 = gp[16];
            const float a0 = g0 * pg8::gelu_tanh(pe * (((const GAS float*)su)[e0] * (1.0f / X4_SCALE))) * ((const GAS float*)sv)[e0], a1 = g1 * pg8::gelu_tanh(po * (((const GAS float*)su)[e1] * (1.0f / X4_SCALE))) * ((const GAS float*)sv)[e1];
            float mx = fmaxf(fabsf(a0), fabsf(a1));
#pragma unroll
            for (int o = 1; o < 64; o <<= 1) mx = fmaxf(mx, shx(mx, o, lu));
            const float sc = mx > 0.f ? 6.0f / mx : 0.f;
            osc[q] = __builtin_bit_cast(float, __builtin_amdgcn_readfirstlane(__builtin_bit_cast(int, mx * (1.0f / 6.0f))));
            const float t0 = a0 * sc, t1 = a1 * sc;
            const unsigned ch = __builtin_amdgcn_cvt_scalef32_pk_fp4_f32(0u, t0, t1, 1.0f, 0); const auto vh = __builtin_amdgcn_cvt_scalef32_pk_f32_fp4(ch, 1.0f, 0);
            const float r0 = (t0 - vh[0]) * 4.0f, r1 = (t1 - vh[1]) * 4.0f;
            const unsigned cm = __builtin_amdgcn_cvt_scalef32_pk_fp4_f32(0u, r0, r1, 1.0f, 0); const auto vm = __builtin_amdgcn_cvt_scalef32_pk_f32_fp4(cm, 1.0f, 0);
            const unsigned cl = __builtin_amdgcn_cvt_scalef32_pk_fp4_f32(0u, (r0 - vm[0]) * 4.0f, (r1 - vm[1]) * 4.0f, 1.0f, 0);
            LAS unsigned char* cq = codes + q * 384 + pb;
            cq[0] = (unsigned char)(ch & 15u); cq[16] = (unsigned char)((ch >> 4) & 15u); cq[128] = (unsigned char)(cm & 15u); cq[144] = (unsigned char)((cm >> 4) & 15u);
            cq[256] = (unsigned char)(cl & 15u); cq[272] = (unsigned char)((cl >> 4) & 15u);
        }
        {   const int qq = lu >> 3, r8 = lu & 7; unsigned pk[8];
#pragma unroll
            for (int k = 0; k < 8; ++k) pk[k] = et[qq * 128 + 16 * k + r8] | (et[qq * 128 + 16 * k + 8 + r8] << 16);
            *(LAS v4u*)(vids + lu * 8) = (v4u){pk[0], pk[1], pk[2], pk[3]}; *(LAS v4u*)(vids + lu * 8 + 4) = (v4u){pk[4], pk[5], pk[6], pk[7]}; }
        {   const int mrow = lu & 15, kbv = lu >> 4;
            const LAS unsigned char* cb = (const LAS unsigned char*)vol + 4096 + (mrow < 3 ? mrow : 2) * 128 + kbv * 32;
#pragma unroll
            for (int q = 0; q < 8; ++q) { const v4u c0 = *(const LAS v4u*)(cb + q * 384), c1 = *(const LAS v4u*)(cb + q * 384 + 16); unsigned h[8];
#pragma unroll
                for (int k = 0; k < 8; ++k) { const unsigned w = k < 4 ? c0[k] : c1[k - 4]; const unsigned t = (w | (w >> 4)) & 0x00ff00ffu; h[k] = (t | (t >> 8)) & 0xffffu; }
                *(LAS v4u*)((LAS unsigned char*)vids + 2048 + q * 192 + (mrow < 3 ? mrow : 2) * 64 + kbv * 16) = (v4u){h[0] | (h[1] << 16), h[2] | (h[3] << 16), h[4] | (h[5] << 16), h[6] | (h[7] << 16)}; }
        }
        __builtin_amdgcn_sched_barrier(0);
    }
#ifdef GAT_VREP
#pragma nounroll
    for (int rep = 0; rep < GAT_VREP; ++rep)
#endif
    {   int zz = 0; asm volatile("" : "+s"(zz));
        const int lv = __builtin_amdgcn_mbcnt_hi(-1, __builtin_amdgcn_mbcnt_lo(-1, zz));
        const int r8 = lv >> 3, kbv = lv >> 4, mrow = lv & 15;
        const unsigned pofsE = 16u * (unsigned)((lv & 7) ^ (r8 >> 1)), pofsO = pofsE ^ 64u;
        const unsigned ringa = (unsigned)(size_t)(LAS unsigned char*)vol;
        const unsigned idsa = (unsigned)(size_t)(LAS unsigned char*)vids + (unsigned)r8 * 32u;
        const unsigned apx = (((ringa + (unsigned)mrow * 128u) | (16u * (unsigned)(mrow >> 1))) ^ (16u * (unsigned)(kbv >> 1))) + 8u * (unsigned)(kbv & 1);
        const int term = mrow & 3;
        const unsigned keep = (term < 3 && (mrow >> 2) == kbv) ? 0xffffffffu : 0u;
        const unsigned acta = (unsigned)(size_t)(LAS unsigned char*)vids + 2048u + (unsigned)(term < 3 ? term : 2) * 64u;
        int sA = 127 - 2 * (term < 2 ? term : 2), s127 = 127; asm volatile("" : "+v"(sA), "+v"(s127));
        asm volatile("s_waitcnt lgkmcnt(0)" ::: "memory");
        __builtin_amdgcn_sched_barrier(0);
        v4u idn0, idn1;
#define GATV_IDS(d0, d1, q) asm volatile("ds_read_b128 %0, %2\n\tds_read_b128 %1, %2 offset:16\n\ts_waitcnt lgkmcnt(0)" : "=&v"(d0), "=&v"(d1) : "v"(idsa + (unsigned)(q) * 256u) : "memory")
#define GATV_ACT(d, q) do { asm volatile("ds_read_b128 %0, %4\n\tds_read_b128 %1, %4 offset:16\n\tds_read_b128 %2, %4 offset:32\n\tds_read_b128 %3, %4 offset:48\n\ts_waitcnt lgkmcnt(0)" : "=&v"(d[0]), "=&v"(d[1]), "=&v"(d[2]), "=&v"(d[3]) : "v"(acta + (unsigned)(q) * 192u) : "memory"); \
            _Pragma("unroll") for (int u_ = 0; u_ < 4; ++u_) d[u_] = (v4u){d[u_].x & keep, d[u_].y & keep, d[u_].z & keep, d[u_].w & keep}; } while (0)
#define GATV_ID(d0, d1, k) ((((k) < 8 ? d0[(k) >> 1] : d1[((k) - 8) >> 1]) >> (16 * ((k) & 1))) & 0xffffu)
#define GATV_DMA(u, d0, d1, soff) do { _Pragma("unroll") for (int w_ = 0; w_ < 4; ++w_) \
            __builtin_amdgcn_raw_ptr_buffer_load_lds(rsv, (LAS void*)((LAS unsigned char*)vol + (u) * 4096 + w_ * 1024), 16, (int)(((GATV_ID(d0, d1, (u) * 4 + w_) & GAT_PM(GAT_VREP)) << 7) + ((w_ & 1) ? pofsO : pofsE)), soff, 0, 0); } while (0)
#define GATV_TR(dst, areg, off) asm volatile("ds_read_b64_tr_b4 %0, %1 offset:%2" : "=v"(dst) : "v"(areg), "i"(off))
#define GATV_RD(r, u, g) do { unsigned a0_ = apx ^ (32u * (g)); asm volatile("" : "+v"(a0_));        \
            GATV_TR(r[0], a0_, (u) * 4096); GATV_TR(r[1], a0_, (u) * 4096 + 2048); } while (0)
#define GATV_WAIT(r, n) asm volatile("s_waitcnt lgkmcnt(" #n ")" : "+v"(r[0]), "+v"(r[1]) :: "memory")
#define GATV_MM(r, u, g, au) do { const i32x4 b_ = {(int)r[0].x, (int)r[0].y, (int)r[1].x, (int)r[1].y}; \
            acc[g] = __builtin_amdgcn_mfma_scale_f32_16x16x128_f8f6f4(GAT_A8(au), GAT_A8(b_), (u) == 0 ? (f32x4){0.f, 0.f, 0.f, 0.f} : acc[g], 4, 4, 0, sA, 0, s127); } while (0)
#define GATV_UNIT(u, aq, d0, d1, soffn) { asm volatile("s_waitcnt vmcnt(12)" ::: "memory"); \
            GATV_RD(ra, u, 0); GATV_RD(rb, u, 1); GATV_RD(rc, u, 2); GATV_RD(rd, u, 3); const i32x4 au_ = {(int)aq[u].x, (int)aq[u].y, (int)aq[u].z, (int)aq[u].w}; \
            GATV_WAIT(ra, 6); GATV_MM(ra, u, 0, au_); GATV_WAIT(rb, 4); GATV_MM(rb, u, 1, au_); GATV_WAIT(rc, 2); GATV_MM(rc, u, 2, au_); GATV_WAIT(rd, 0); GATV_MM(rd, u, 3, au_); \
            __builtin_amdgcn_sched_barrier(0); GATV_DMA(u, d0, d1, soffn); __builtin_amdgcn_sched_barrier(0); }
#define GATV_STEP(q, qn, cc, ccn, in0, in1) { GATV_IDS(in0, in1, qn); v4u aq_[4]; GATV_ACT(aq_, q); \
            GATV_UNIT(0, aq_, in0, in1, (ccn) * CHUNK_STRIDE) GATV_UNIT(1, aq_, in0, in1, (ccn) * CHUNK_STRIDE) GATV_UNIT(2, aq_, in0, in1, (ccn) * CHUNK_STRIDE) GATV_UNIT(3, aq_, in0, in1, (ccn) * CHUNK_STRIDE) \
            { float o_[4]; _Pragma("unroll") for (int g_ = 0; g_ < 4; ++g_) o_[g_] = ((acc[g_].x + acc[g_].y) + acc[g_].z) * osc[q]; \
              __builtin_amdgcn_raw_buffer_store_b64((v2u){pg8::cvt_pk_bf16(o_[0], o_[1]), pg8::cvt_pk_bf16(o_[2], o_[3])}, rsy, sto, (gw + (q) * NGW) * (D * 2) + (cc) * 512, 0); } \
            __builtin_amdgcn_sched_barrier(0); }
        f32x4 acc[4]; v2u ra[2], rb[2], rc[2], rd[2];
        const int sto = (lv & 15) * 32 + kbv * 8;
        GATV_IDS(idn0, idn1, 0);
        GATV_DMA(0, idn0, idn1, 0); GATV_DMA(1, idn0, idn1, 0); GATV_DMA(2, idn0, idn1, 0); GATV_DMA(3, idn0, idn1, 0);
#pragma nounroll
        for (int c = 0; c < 8; ++c) {
            const int cn = c < 7 ? c + 1 : 7;
            GATV_STEP(0, 1, c, c, idn0, idn1) GATV_STEP(1, 2, c, c, idn0, idn1) GATV_STEP(2, 3, c, c, idn0, idn1) GATV_STEP(3, 4, c, c, idn0, idn1)
            GATV_STEP(4, 5, c, c, idn0, idn1) GATV_STEP(5, 6, c, c, idn0, idn1) GATV_STEP(6, 7, c, c, idn0, idn1) GATV_STEP(7, 0, c, cn, idn0, idn1)
        }
    }
    asm volatile("s_waitcnt vmcnt(0)" ::: "memory");
    __builtin_amdgcn_fence(__ATOMIC_ACQUIRE, "agent");
#pragma nounroll
    for (int k = 0; k < 2; ++k) { int zz = 0; asm volatile("" : "+s"(zz));
        const int ll = __builtin_amdgcn_mbcnt_hi(-1, __builtin_amdgcn_mbcnt_lo(-1, zz));
        ln_res_rows<4>(xres, (const bf16*)ybuf, lng, lnb, of, ob, o8, sx8, (size_t)(gw + 4 * k * NGW) * D, (size_t)NGW * D, ll, vol); }
}

template <int W> __device__ __forceinline__ void pool_item(const GAS v4u* hp, GAS v4u* op, int pos0) {
    constexpr int NR = 7 + W;
    v4u r[NR];
    const bool head = pos0 == 0;
#pragma unroll
    for (int k = 0; k < NR; ++k) { const int rel = k - (W - 1);
        const bool ok = rel >= 0 || (!head && (pos0 + rel >= 0));
        r[k] = ok ? hp[(long)rel * (D / 8)] : (v4u){0u, 0u, 0u, 0u}; }
    float run[8];
#pragma unroll
    for (int e = 0; e < 8; ++e) run[e] = 0.f;
#pragma unroll
    for (int k = 0; k < W - 1; ++k) { run[0] += bflo(r[k].x); run[1] += bfhi(r[k].x); run[2] += bflo(r[k].y); run[3] += bfhi(r[k].y); run[4] += bflo(r[k].z); run[5] += bfhi(r[k].z); run[6] += bflo(r[k].w); run[7] += bfhi(r[k].w); }
#pragma unroll
    for (int i = 0; i < 8; ++i) { const v4u c = r[W - 1 + i];
        const float cv[8] = {bflo(c.x), bfhi(c.x), bflo(c.y), bfhi(c.y), bflo(c.z), bfhi(c.z), bflo(c.w), bfhi(c.w)};
#pragma unroll
        for (int e = 0; e < 8; ++e) run[e] += cv[e];
        const int pos = pos0 + i; const int cnt = pos + 1 < W ? pos + 1 : W; const float ic = 1.0f / (float)cnt;
        v4u o; o.x = pk2(run[0] * ic - cv[0], run[1] * ic - cv[1]); o.y = pk2(run[2] * ic - cv[2], run[3] * ic - cv[3]); o.z = pk2(run[4] * ic - cv[4], run[5] * ic - cv[5]); o.w = pk2(run[6] * ic - cv[6], run[7] * ic - cv[7]);
        op[(long)i * (D / 8)] = o;
        const v4u d = r[i];
        run[0] -= bflo(d.x); run[1] -= bfhi(d.x); run[2] -= bflo(d.y); run[3] -= bfhi(d.y); run[4] -= bflo(d.z); run[5] -= bfhi(d.z); run[6] -= bflo(d.w); run[7] -= bfhi(d.w); }
}

#ifndef PHMASK
#define PHMASK 0xFFFFFFFFu
#endif
#define PHON(k) ((PHMASK >> (k)) & 1u)
#define x_in KARG(const float*, 0)
#define a_w_in KARG(const float*, 8)
#define a_b_in KARG(const float*, 16)
#define a_v_g KARG(const float*, 24)
#define a_v_b KARG(const float*, 32)
#define a_w_s KARG(const float*, 40)
#define a_b_s KARG(const float*, 48)
#define a_w_out KARG(const float*, 56)
#define b_w_in KARG(const float*, 64)
#define b_w_grp KARG(const float*, 72)
#define b_b_grp KARG(const float*, 80)
#define b_scale KARG(const float*, 88)
#define b_w_out KARG(const float*, 96)
#define ln_mix_g KARG(const float*, 104)
#define ln_mix_b KARG(const float*, 112)
#define ln_ffn_g KARG(const float*, 120)
#define ln_ffn_b KARG(const float*, 128)
#define peer_wq KARG(const float*, 136)
#define peer_sk KARG(const float*, 144)
#define peer_u KARG(const float*, 152)
#define peer_v KARG(const float*, 160)
#define W1I ((unsigned char*)(ws + WS_W1T))
#define XI0 ((unsigned char*)(ws + WS_XF))
#define SX0 ((float*)(ws + WS_SX0))
#define W2F ((unsigned char*)(ws + WS_W2T))
#define GF ((unsigned char*)(ws + WS_X1))
#define BINI ((unsigned char*)(ws + WS_BINT))
#define BOUTF ((unsigned char*)(ws + WS_BOUTT))
#define MIXED8 ((unsigned char*)(ws + WS_MIXED))
#define WQB ((bf16*)(ws + WS_WQT))
#define WQS ((bf16*)(ws + WS_WQS))
#define WQSI ((unsigned char*)(ws + WS_WQT))
#define SW ((float*)(ws + WS_SV + 131072))
#define BGT ((bf16*)(ws + WS_BGT))
#define BD ((bf16*)(ws + WS_BD))
#define BDSK ((bf16*)(ws + WS_BDSK))
#define XB ((bf16*)(ws + WS_XB))
#define UT ((unsigned char*)(ws + WS_UT))
#define SU ((float*)(ws + WS_SU))
#define SV ((float*)(ws + WS_SV))
#define VTAB ((unsigned char*)(ws + WS_VTAB))
#define UG ((bf16*)(ws + WS_UG))
#define ST ((float*)(ws + WS_ST))
#define POOL ((bf16*)(ws + WS_POOL))
#define MIXED ((bf16*)(ws + WS_MIXED))
#define VT ((bf16*)(ws + WS_VT))
#define Q ((bf16*)(ws + WS_Q))
#define X8H ((unsigned char*)(ws + WS_Q))
#define H ((bf16*)(ws + WS_H))
#define Y ((float*)(ws + WS_Y))
#define X1 ((float*)(ws + WS_X1))
#define EIDX ((int*)(ws + WS_EIDX))
#define GATE ((float*)(ws + WS_GATE))
struct Args { const float* in[21]; float* out; unsigned char* ws; int ph_lo, ph_hi; };
__global__ void __launch_bounds__(NTHREADS, 2) mega_fwd(Args args) {
    extern __shared__ __attribute__((aligned(16))) unsigned char lds_raw[];
    LAS unsigned char* lds = (LAS unsigned char*)lds_raw;
    volatile LAS unsigned* MISC = (volatile LAS unsigned*)(lds + MISC_OFF);
    typedef const char __attribute__((address_space(4)))* kap_t;
#define KARG(T, off) (*(T const __attribute__((address_space(4)))*)(ka + (off)))
#define PH_BEGIN kap_t ka = (kap_t)__builtin_amdgcn_kernarg_segment_ptr(); asm volatile("" : "+s"(ka)); unsigned char* ws = KARG(unsigned char*, 176); asm volatile("" : "+s"(ws));
#define OUT_PTR KARG(float*, 168)
#define IDX_BEGIN int bx = blockIdx.x, G = gridDim.x, wave = wave0, zero = 0; asm volatile("" : "+s"(bx), "+s"(G), "+s"(wave), "+s"(zero)); \
        const int lane = __builtin_amdgcn_mbcnt_hi(-1, __builtin_amdgcn_mbcnt_lo(-1, zero)), tid = wave * 64 + lane; \
        const int vcu = (G % 8 == 0) ? (bx % 8) * (G / 8) + bx / 8 : bx; const int gw = vcu * NWAVES + wave, NGW = G * NWAVES; (void)tid; (void)gw; (void)NGW; (void)vcu; (void)lane;
    for (int u = threadIdx.x; u < (LDS_BYTES - LDSCTL_OFF) / 4; u += NTHREADS) ((LAS unsigned*)(lds + LDSCTL_OFF))[u] = 0u;
    __syncthreads();
    int lo, hi; unsigned xcc; const int wave0 = __builtin_amdgcn_readfirstlane(threadIdx.x >> 6);
    { PH_BEGIN; lo = KARG(int, 184); hi = KARG(int, 188);
      xcc = xb_xcc_id();
      if (!MK_PER_PHASE && threadIdx.x == 0) (void)xb_add((unsigned*)(ws + WS_CTL) + CW_BAR + XB_XCNT(xcc), 1u); }
#pragma nounroll
    for (int ph = lo; ph < hi; ++ph) {
        const int ly = ph >= 13 ? 1 : 0;
        const int pk = ph >= 17 ? 14 : (ph >= 13 ? ph - 8 : ph);
#ifdef RPT_MASK
        for (int rep = 0; rep < (((RPT_MASK >> ph) & 1u) ? 2 : 1); ++rep)
#endif
        switch (pk) {
        case 0: if (PHON(0)) { PH_BEGIN; IDX_BEGIN;
            LAS float* scr = (LAS float*)(lds + RING_OFF + wave * 16384);
            constexpr int I_W1 = (D / 64) * (FFA / 32), I_W2 = (HA / 64) * (D / 32), I_SQ = (D / 64) * (D / 32), I_G = (512 / 64) * (512 / 32);
            constexpr int NITEMS = I_W1 + I_W2 + 2 * I_SQ + 4 * I_G;
            for (int it = gw; it < NITEMS; it += NGW) {
                int r = it;
                if (r < I_W1) { p0_transpose_item8<true>(a_w_in, D, FFA, W1I, W1_SCALE, scr, r, lane); continue; } r -= I_W1;
                if (r < I_W2) { p0_transpose_item8<false>(a_w_out, HA, D, W2F, W2_SCALE, scr, r, lane); continue; } r -= I_W2;
                if (r < I_SQ) { p0_transpose_item8<true>(b_w_in, D, D, BINI, W1_SCALE, scr, r, lane); continue; } r -= I_SQ;
                if (r < I_SQ) { p0_transpose_item8<false>(b_w_out, D, D, BOUTF, W2_SCALE, scr, r, lane); continue; } r -= I_SQ;
                { const int g = r / I_G; p0_transpose_item(b_w_grp + (size_t)g * 512 * 512, 512, 512, BGT + (size_t)g * 512 * 512, scr, r % I_G, lane); }
            }
            for (int m = gw; m < M_TOK; m += 4 * NGW) rows_to_i8<4>(x_in, XI0, SX0, m, NGW, lane, (LAS unsigned*)scr);
            p0_convert(peer_wq, WQB, 2 * D * D / 512, gw, NGW, lane);
            for (int r = gw; r < 2 * NEXP; r += 2 * NGW) { const int r1 = r + NGW, la = r >= NEXP ? 1 : 0, lb = r1 >= NEXP ? 1 : 0;
                const float* const s2[2] = {peer_u + (size_t)r * D, peer_u + (size_t)r1 * D}; unsigned char* const d2[2] = {UT + (size_t)la * NEXP * (D / 2), UT + (size_t)lb * NEXP * (D / 2)};
                const int e2[2] = {r - la * NEXP, r1 - lb * NEXP}; float* const c2[2] = {SU + r, SU + r1};
                p0_row_fp4<2>(s2, d2, e2, c2, (LAS unsigned char*)scr, lane); }
            for (int r = gw; r < 2 * NEXP; r += 2 * NGW) { const int r1 = r + NGW, la = r >= NEXP ? 1 : 0, lb = r1 >= NEXP ? 1 : 0;
                const float* const s2[2] = {peer_v + (size_t)r * D, peer_v + (size_t)r1 * D}; unsigned char* const d2[2] = {VTAB + (size_t)la * NEXP * (D / 2), VTAB + (size_t)lb * NEXP * (D / 2)};
                const int e2[2] = {r - la * NEXP, r1 - lb * NEXP}; float* const c2[2] = {SV + r, SV + r1};
                p0_row_fp4t<2>(s2, d2, e2, c2, (LAS unsigned char*)scr, lane); }
            for (int i0 = gw * 64 + lane; i0 < NGA * 65536; i0 += 8 * NGW * 64) { float wv[8];
#pragma unroll
                for (int k = 0; k < 8; ++k) { int i = i0 + k * NGW * 64; i = i < NGA * 65536 ? i : NGA * 65536 - 1; const int h = i >> 16, t = (i >> 8) & 127, s = i & 127;
                    wv[k] = ((const GAS float*)a_w_s)[(h * 128 + t) * 128 + s]; }
                asm volatile("" : "+v"(wv[0]), "+v"(wv[1]), "+v"(wv[2]), "+v"(wv[3]), "+v"(wv[4]), "+v"(wv[5]), "+v"(wv[6]), "+v"(wv[7]));
#pragma unroll
                for (int k = 0; k < 8; ++k) { const int i = i0 + k * NGW * 64; const int tp = (i >> 8) & 255, sp = i & 255;
                    const float v = ((tp >> 7) == (sp >> 7) && (sp & 127) <= (tp & 127)) ? wv[k] : 0.f; if (i < NGA * 65536) ((GAS bf16*)BD)[i] = (bf16)f2bf(v); } }
            for (int i = gw * 64 + lane; i < 2 * 65536; i += NGW * 64) { const int l2 = i >> 16, r = (i >> 8) & 255, c = i & 255;
                const float kv = ((const GAS float*)peer_sk)[((l2 * 2 + (r >> 7)) * 128 + (r & 127)) * 128 + (c & 127)];
                const float v = ((r >> 7) == (c >> 7)) ? kv : 0.f; ((GAS bf16*)BDSK)[i] = (bf16)f2bf(v); }
        } break;
        case 1: if (PHON(1)) { PH_BEGIN; IDX_BEGIN;
            { pg8::AddrScores g{BDSK, WQB, 256, D, 256}; pg8::StaticOrder S; S.init(2 * D, D, G, bx); pg8::EpiBf16<0> E{WQS, D, nullptr, nullptr, nullptr};
              pg8::gemm_phase<pg8::EpiBf16<0>, pg8::AddrScores, pg8::StaticOrder, true, true>(lds + RING_OFF, g, S, E, tid); }
#ifdef G1_STAGGER
            { const int xs_ = (int)(xcc & 7u); for (int s_ = 0; s_ < xs_ * G1_STAGGER; ++s_) __builtin_amdgcn_s_sleep(75); }
#endif
            { pg8::AddrPlain8 g{XI0, W1I, D, D, D}; pg8::StaticOrder S; S.init(M_TOK, HA, G, bx); pg8::EpiGeluFp8 E{(unsigned char*)UG, HA, a_b_in, SX0, 1.0f / W1_SCALE, U_SCALE};
              pg8::gemm_phase<pg8::EpiGeluFp8, pg8::AddrPlain8, pg8::StaticOrder, true, true, 2>(lds + RING_OFF, g, S, E, tid); }
            { pg8::AddrPlain8 g{W1I + (size_t)HA * D, XI0, D, D, D}; pg8::StaticOrder S; S.init(HA, M_TOK, G, bx); pg8::EpiBf16<1, true> E{VT, M_TOK, nullptr, a_b_in + HA, nullptr, 1.0f / W1_SCALE, nullptr, SX0};
              pg8::gemm_phase<pg8::EpiBf16<1, true>, pg8::AddrPlain8, pg8::StaticOrder, true, true, 2>(lds + RING_OFF, g, S, E, tid); }
        } break;
        case 2: if (PHON(2)) { PH_BEGIN; IDX_BEGIN;
            for (int r = gw; r < 2 * D; r += 2 * NGW) rows_bf16_to_i8<2>(WQS, WQSI, SW, r, NGW, lane);
            LAS float* red = (LAS float*)(lds + RING_OFF);
            LAS float* stat = red + 64 * 64 * 2;
            const int rg = tid >> 3, j8 = tid & 7;
            for (int tb = vcu; tb < M_TOK / 64; tb += G) {
                const int t0 = tb * 64;
                float s[8], q[8];
#pragma unroll
                for (int e = 0; e < 8; ++e) { s[e] = 0.f; q[e] = 0.f; }
#pragma unroll 16
                for (int i = 0; i < 64; ++i) { const v4u w = *(const GAS v4u*)(VT + (size_t)(rg + 64 * i) * M_TOK + t0 + 8 * j8);
                    const float f[8] = {bflo(w.x), bfhi(w.x), bflo(w.y), bfhi(w.y), bflo(w.z), bfhi(w.z), bflo(w.w), bfhi(w.w)};
#pragma unroll
                    for (int e = 0; e < 8; ++e) { s[e] += f[e]; q[e] += f[e] * f[e]; } }
#pragma unroll
                for (int e = 0; e < 8; ++e) { red[(rg * 64 + 8 * j8 + e) * 2] = s[e]; red[(rg * 64 + 8 * j8 + e) * 2 + 1] = q[e]; }
                __syncthreads();
                if (tid < 128) { const int tok = tid & 63, wh = tid >> 6; float a = 0.f;
                    for (int r = 0; r < 64; ++r) a += red[(r * 64 + tok) * 2 + wh];
                    stat[tok * 2 + wh] = a; }
                __syncthreads();
                float mu[8], rs[8]; float inv_ha = 1.f / HA; asm volatile("" : "+v"(inv_ha));
#pragma unroll
                for (int e = 0; e < 8; ++e) { const float m = stat[(8 * j8 + e) * 2] * inv_ha; const float var = stat[(8 * j8 + e) * 2 + 1] * inv_ha - m * m; mu[e] = m; rs[e] = 1.f / sqrtf(fmaxf(var, 0.f) + LN_EPS); }
#pragma unroll 8
                for (int i = 0; i < 64; ++i) { const int c = rg + 64 * i; GAS v4u* p = (GAS v4u*)(VT + (size_t)c * M_TOK + t0 + 8 * j8); const v4u w = *p; const float gg = a_v_g[c], bb = a_v_b[c];
                    const float f[8] = {bflo(w.x), bfhi(w.x), bflo(w.y), bfhi(w.y), bflo(w.z), bfhi(w.z), bflo(w.w), bfhi(w.w)}; float o[8];
#pragma unroll
                    for (int e = 0; e < 8; ++e) o[e] = (f[e] - mu[e]) * rs[e] * gg + bb;
                    v4u ow; ow.x = pk2(o[0], o[1]); ow.y = pk2(o[2], o[3]); ow.z = pk2(o[4], o[5]); ow.w = pk2(o[6], o[7]); *p = ow; }
                __syncthreads();
            }
        } break;
        case 3: if (PHON(3)) { PH_BEGIN; IDX_BEGIN;
            pg8::AddrSpatial g{BD, VT, 256, M_TOK, 256}; pg8::StaticOrder S; S.init(M_TOK, HA, G, bx); pg8::EpiGate8 E{(const unsigned char*)UG, GF, HA, a_b_s, G_SCALE / U_SCALE};
            pg8::gemm_phase<pg8::EpiGate8, pg8::AddrSpatial, pg8::StaticOrder, true, true>(lds + RING_OFF, g, S, E, tid);
        } break;
        case 4: if (PHON(4)) { PH_BEGIN; IDX_BEGIN;
            pg8::AddrPlain8 g{GF, W2F, HA, HA, HA}; pg8::StaticOrder S; S.init(M_TOK, D, G, bx); pg8::EpiRes<false> E{(bf16*)Y, x_in, D, ALPHA, 1.0f / (G_SCALE * W2_SCALE)};
            pg8::gemm_phase<pg8::EpiRes<false>, pg8::AddrPlain8, pg8::StaticOrder, true, true, 1>(lds + RING_OFF, g, S, E, tid);
        } break;
        case 5: if (PHON(5)) { PH_BEGIN; IDX_BEGIN;
            for (int m = gw; m < M_TOK; m += 4 * NGW) ln_rows<4>((const bf16*)Y, ln_mix_g + ly * D, ln_mix_b + ly * D, XB, X8H, XI0, SX0, m, NGW, lane, (LAS unsigned*)(lds + RING_OFF + wave * 16384));
        } break;
        case 6: if (PHON(6)) { PH_BEGIN; IDX_BEGIN;
            pg8::AddrPlain8 g{WQSI + (size_t)ly * D * D, XI0, D, D, D}; pg8::StaticOrder S; S.init(D, M_TOK, G, bx); pg8::EpiBf16<0, true> E{(bf16*)ST, M_TOK, nullptr, nullptr, nullptr, 1.0f, SW + ly * D, SX0};
            pg8::gemm_phase<pg8::EpiBf16<0, true>, pg8::AddrPlain8, pg8::StaticOrder, true, true, 2>(lds + RING_OFF, g, S, E, tid);
        } break;
        case 7: if (PHON(7)) { PH_BEGIN; IDX_BEGIN;
            for (int it = gw; it < (M_TOK / 64) * HEADS; it += NGW) { const int h = it & 7, t = (it >> 3) * 64 + lane; topk_lane((const bf16*)ST, h, t, EIDX, GATE); }
        } break;
        case 8: if (PHON(8)) { PH_BEGIN; IDX_BEGIN;
            const unsigned char* ut = UT + (size_t)ly * NEXP * (D / 2); const unsigned char* vt = VTAB + (size_t)ly * NEXP * (D / 2);
            peer_chunked(ut, vt, SU + ly * NEXP, SV + ly * NEXP, EIDX, GATE, XB, X8H, Y, ln_ffn_g + ly * D, ln_ffn_b + ly * D, ly == 0 ? nullptr : OUT_PTR, ly == 0 ? XB : nullptr, ly == 0 ? XI0 : nullptr, SX0, gw, NGW, (LAS unsigned*)(lds + RING_OFF + wave * 16384), (LAS unsigned*)(lds + IDS16_OFF + wave * IDS16_WAVE));
        } break;
        case 9: if (PHON(9)) { PH_BEGIN; IDX_BEGIN;
            pg8::AddrPlain8 g{XI0, BINI, D, D, D}; pg8::StaticOrder S; S.init(M_TOK, D, G, bx); pg8::EpiBf16<0, true> E{H, D, nullptr, nullptr, nullptr, 1.0f / W1_SCALE, SX0, nullptr};
            pg8::gemm_phase<pg8::EpiBf16<0, true>, pg8::AddrPlain8, pg8::StaticOrder, true, true, 2>(lds + RING_OFF, g, S, E, tid);
        } break;
        case 10: if (PHON(10)) { PH_BEGIN; IDX_BEGIN;
            for (int it = gw; it < (M_TOK / 8) * 4; it += NGW) { const int t0 = (it >> 2) * 8, qd = it & 3, pos0 = t0 & (SEQ - 1);
                const GAS v4u* hp = (const GAS v4u*)(H + (size_t)t0 * D + qd * 512) + lane;
                if (qd == 0) pool_item<2>(hp, (GAS v4u*)(POOL + (size_t)t0 * D + qd * 512) + lane, pos0);
                else if (qd == 1) pool_item<4>(hp, (GAS v4u*)(POOL + (size_t)t0 * D + qd * 512) + lane, pos0);
                else if (qd == 2) pool_item<8>(hp, (GAS v4u*)(POOL + (size_t)t0 * D + qd * 512) + lane, pos0);
                else pool_item<16>(hp, (GAS v4u*)(POOL + (size_t)t0 * D + qd * 512) + lane, pos0); }
        } break;
        case 11: if (PHON(11)) { PH_BEGIN; IDX_BEGIN;
            pg8::AddrGrouped g{POOL, BGT, D, 512, 512}; pg8::StaticOrder S; S.init(M_TOK, D, G, bx); pg8::EpiFp8 E{MIXED8, D, b_b_grp, b_scale, M_SCALE};
            pg8::gemm_phase<pg8::EpiFp8, pg8::AddrGrouped, pg8::StaticOrder, true, true>(lds + RING_OFF, g, S, E, tid);
        } break;
#ifdef PROBE_L2
        case 14: { PH_BEGIN; IDX_BEGIN;
            peer_chunked(UT, VTAB, SU, SV, EIDX, GATE, XB, X8H, Y, ln_ffn_g, ln_ffn_b, nullptr, nullptr, nullptr, nullptr, gw, NGW, (LAS unsigned*)(lds + RING_OFF + wave * 16384), (LAS unsigned*)(lds + IDS16_OFF + wave * IDS16_WAVE), PROBE_L2);
        } break;
#endif
        default: if (PHON(12)) { PH_BEGIN; IDX_BEGIN;
            pg8::AddrPlain8 g{MIXED8, BOUTF, D, D, D}; pg8::StaticOrder S; S.init(M_TOK, D, G, bx); pg8::EpiRes<true> E{(bf16*)Y, XB, D, ALPHA, 1.0f / (M_SCALE * W2_SCALE)};
            pg8::gemm_phase<pg8::EpiRes<true>, pg8::AddrPlain8, pg8::StaticOrder, true, true, 1>(lds + RING_OFF, g, S, E, tid);
        } break;
        }
        if (ph + 1 < hi) { PH_BEGIN; unsigned xl = xcc; int w2 = wave0, z2 = 0; asm volatile("" : "+s"(xl), "+s"(w2), "+s"(z2));
            const int tidb = w2 * 64 + __builtin_amdgcn_mbcnt_hi(-1, __builtin_amdgcn_mbcnt_lo(-1, z2));
            XcdBarrier bar; bar.bar = (unsigned*)(ws + WS_CTL) + CW_BAR; bar.x = xl; bar.st = MISC + 8; xcd_barrier(bar, tidb); }
    }
}

extern "C" void kernel_launch(void* const* d_in, const int* in_sizes, int n_in, void* d_out, int out_size, void* d_ws, size_t ws_size, hipStream_t stream) {
    static int grid = 0;
    if (grid == 0) {
        if (n_in != 21 || out_size != M_TOK * D || ws_size < WS_END) { fprintf(stderr, "kernel_launch: unexpected problem (n_in %d, out %d, ws %zu)\n", n_in, out_size, ws_size); grid = -1; return; }
        int dev = 0, cus = 0, per_cu = 0;
        if (hipGetDevice(&dev) != hipSuccess || hipDeviceGetAttribute(&cus, hipDeviceAttributeMultiprocessorCount, dev) != hipSuccess) { grid = -1; return; }
        if (hipFuncSetAttribute((const void*)mega_fwd, hipFuncAttributeMaxDynamicSharedMemorySize, LDS_BYTES) != hipSuccess) { fprintf(stderr, "kernel_launch: hipFuncSetAttribute failed\n"); grid = -1; return; }
        if (hipOccupancyMaxActiveBlocksPerMultiprocessor(&per_cu, (const void*)mega_fwd, NTHREADS, LDS_BYTES) != hipSuccess || per_cu < 1) { fprintf(stderr, "kernel_launch: occupancy query says %d blocks per CU\n", per_cu); (void)hipGetLastError(); }
        grid = cus;
    }
    if (grid < 0) return;
    if (hipMemsetAsync((char*)d_ws + WS_CTL, 0, CTL_ZERO_BYTES, stream) != hipSuccess) return;
    Args a{};
    for (int i = 0; i < 21; ++i) a.in[i] = (const float*)d_in[i];
    a.out = (float*)d_out; a.ws = (unsigned char*)d_ws;
#if MK_PER_PHASE
    for (int p = 0; p < N_PHASES; ++p) { a.ph_lo = p; a.ph_hi = p + 1; hipLaunchKernelGGL(mega_fwd, dim3(grid), dim3(NTHREADS), LDS_BYTES, stream, a); }
#else
    a.ph_lo = 0; a.ph_hi = N_PHASES;
#ifdef PROBE_L2
    a.ph_hi = N_PHASES + 1;
#endif
    hipLaunchKernelGGL(mega_fwd, dim3(grid), dim3(NTHREADS), LDS_BYTES, stream, a);
#endif
}
```

```cpp
#include <hip/hip_runtime.h>
#include <cstdio>
#include <cstdint>

#ifndef MK_PER_PHASE
#define MK_PER_PHASE 0
#endif

namespace pg8 {
#define PG8_LAS __attribute__((address_space(3)))
#define PG8_GAS __attribute__((address_space(1)))
typedef unsigned short bf16_t;
typedef short bf16x8 __attribute__((ext_vector_type(8)));
typedef float f32x4 __attribute__((ext_vector_type(4)));
typedef float f32x2 __attribute__((ext_vector_type(2)));
typedef unsigned u32x4 __attribute__((ext_vector_type(4)));
constexpr int BM = 256, BK = 64, HALF = 128, HTB = HALF * BK * 2  , STAGE_BYTES = 8 * HTB, NXCD = 8, WGM = 8;

__host__ __device__ __forceinline__ int lds_byte(int r, int c) { const int st = (r >> 4) * 2 + (c >> 5), rr = r & 15, cc = c & 31, ob = rr * 64 + cc * 2; return st * 1024 + (ob ^ (((ob >> 9) & 1) << 5)); }
__host__ __device__ __forceinline__ void stage_rc(int b, int& R, int& C) { const int st = b / 1024, sb = b % 1024, swz = sb ^ (((sb >> 9) & 1) << 5); R = (st >> 1) * 16 + swz / 64; C = (st & 1) * 32 + (swz % 64) / 2; }
__host__ __device__ __forceinline__ int perm32(int rho) { const int n = rho >> 4, i = rho & 15; return 8 * (i >> 2) + 4 * n + (i & 3); }

typedef int i32x8 __attribute__((ext_vector_type(8)));
typedef int i32x4v __attribute__((ext_vector_type(4)));
__device__ __forceinline__ i32x8 pk32(bf16x8 a, bf16x8 b) { return __builtin_shufflevector(__builtin_bit_cast(i32x4v, a), __builtin_bit_cast(i32x4v, b), 0, 1, 2, 3, 4, 5, 6, 7); }
struct Unit { int pm, pn; };

struct StaticOrder {
    int nM, nN, nwg, G, c;
    __host__ __device__ void init(int M, int N, int G_, int c_) { nM = M / BM; nN = N / BM; nwg = nM * nN; G = G_; c = c_; }
    __host__ __device__ bool next(int i, Unit& u) const {
        const long L = (long)i * G + c; if (L >= nwg) return false;
        int wgid = (int)L; { const int q = nwg / NXCD, r = nwg % NXCD, xcd = wgid % NXCD, off = wgid / NXCD; wgid = (xcd < r ? xcd * (q + 1) : r * (q + 1) + (xcd - r) * q) + off; }
        const int nig = WGM * nN, gid = wgid / nig, fm = gid * WGM, gsz = (nM - fm) < WGM ? (nM - fm) : WGM;
        u.pm = fm + ((wgid % nig) % gsz); u.pn = (wgid % nig) / gsz; return true;
    }
    __device__ __forceinline__ void a_ready(const Unit&) const {}
    __device__ __forceinline__ void done(const Unit&) const {}
};

struct AddrPlain { const bf16_t* A; const bf16_t* Bt; int lda, ldb, K;
    __device__ __forceinline__ const char* a(const Unit& u) const { return (const char*)(A + (size_t)u.pm * BM * lda); }
    __device__ __forceinline__ const char* b(const Unit& u) const { return (const char*)(Bt + (size_t)u.pn * BM * ldb); } };
struct AddrPlain8 { const unsigned char* A; const unsigned char* Bt; int lda, ldb, K;
    __device__ __forceinline__ const char* a(const Unit& u) const { return (const char*)(A + (size_t)u.pm * BM * lda); }
    __device__ __forceinline__ const char* b(const Unit& u) const { return (const char*)(Bt + (size_t)u.pn * BM * ldb); } };
struct AddrSpatial { const bf16_t* BD; const bf16_t* VNT; int lda, ldb, K;
    __device__ __forceinline__ const char* a(const Unit& u) const { return (const char*)(BD + (size_t)u.pn * 65536); }
    __device__ __forceinline__ const char* b(const Unit& u) const { return (const char*)(VNT + (size_t)u.pn * 256 * 16384 + (size_t)u.pm * 256); } };
struct AddrScores { const bf16_t* BDsk; const bf16_t* Q; int lda, ldb, K;
    __device__ __forceinline__ const char* a(const Unit& u) const { return (const char*)(BDsk + (size_t)(u.pm >> 3) * 65536); }
    __device__ __forceinline__ const char* b(const Unit& u) const { return (const char*)(Q + (size_t)(u.pm >> 3) * 2048 * 2048 + (size_t)u.pn * 256 * 2048 + (size_t)(u.pm & 7) * 256); } };
struct AddrGrouped { const bf16_t* P; const bf16_t* BgT; int lda, ldb, K;
    __device__ __forceinline__ const char* a(const Unit& u) const { return (const char*)(P + (size_t)u.pm * 256 * 2048 + (size_t)(u.pn >> 1) * 512); }
    __device__ __forceinline__ const char* b(const Unit& u) const { return (const char*)(BgT + (size_t)(u.pn >> 1) * 512 * 512 + (size_t)(u.pn & 1) * 256 * 512); } };

__device__ __forceinline__ unsigned cvt_pk_bf16(float lo, float hi) { unsigned r; asm volatile("v_cvt_pk_bf16_f32 %0, %1, %2" : "=v"(r) : "v"(lo), "v"(hi)); return r; }
__device__ __forceinline__ float gelu_tanh(float v) {
    const float y2 = v * (1.5957691216f + 0.0713548163f * v * v);
    const float e = __builtin_amdgcn_exp2f(-1.4426950409f * y2);
    return v * __builtin_amdgcn_rcpf(1.0f + e);
}
__device__ __forceinline__ f32x4 gelu4(f32x4 v) { return (f32x4){gelu_tanh(v[0]), gelu_tanh(v[1]), gelu_tanh(v[2]), gelu_tanh(v[3])}; }
__device__ __forceinline__ u32x4 pack8(f32x4 v0, f32x4 v1) { u32x4 w; w.x = cvt_pk_bf16(v0[0], v0[1]); w.y = cvt_pk_bf16(v0[2], v0[3]); w.z = cvt_pk_bf16(v1[0], v1[1]); w.w = cvt_pk_bf16(v1[2], v1[3]); return w; }

typedef unsigned u32x2p __attribute__((ext_vector_type(2)));
__device__ __forceinline__ u32x4 pair16(u32x2p x, u32x2p y) {
    const auto s0 = __builtin_amdgcn_permlane16_swap(x.x, y.x, false, false), s1 = __builtin_amdgcn_permlane16_swap(x.y, y.y, false, false);
    return (u32x4){s0[0], s1[0], s0[1], s1[1]};
}
__device__ __forceinline__ void unpair16(u32x4 l, u32x2p& x, u32x2p& y) {
    const auto s0 = __builtin_amdgcn_permlane16_swap(l.x, l.z, false, false), s1 = __builtin_amdgcn_permlane16_swap(l.y, l.w, false, false);
    x = (u32x2p){s0[0], s1[0]}; y = (u32x2p){s0[1], s1[1]};
}
__device__ __forceinline__ u32x2p pk8_fp8(f32x4 v0, f32x4 v1) {
    int w0 = 0, w1 = 0;
    w0 = __builtin_amdgcn_cvt_pk_fp8_f32(__builtin_amdgcn_fmed3f(v0[0], -448.f, 448.f), __builtin_amdgcn_fmed3f(v0[1], -448.f, 448.f), w0, false);
    w0 = __builtin_amdgcn_cvt_pk_fp8_f32(__builtin_amdgcn_fmed3f(v0[2], -448.f, 448.f), __builtin_amdgcn_fmed3f(v0[3], -448.f, 448.f), w0, true);
    w1 = __builtin_amdgcn_cvt_pk_fp8_f32(__builtin_amdgcn_fmed3f(v1[0], -448.f, 448.f), __builtin_amdgcn_fmed3f(v1[1], -448.f, 448.f), w1, false);
    w1 = __builtin_amdgcn_cvt_pk_fp8_f32(__builtin_amdgcn_fmed3f(v1[2], -448.f, 448.f), __builtin_amdgcn_fmed3f(v1[3], -448.f, 448.f), w1, true);
    return (u32x2p){(unsigned)w0, (unsigned)w1};
}
__device__ __forceinline__ float bf_lo(unsigned w) { return __builtin_bit_cast(float, w << 16); }
__device__ __forceinline__ float bf_hi(unsigned w) { return __builtin_bit_cast(float, w & 0xffff0000u); }

template <int ACT, bool IACC = false> struct EpiBf16 {
    static constexpr bool PERM = true, AFTER_DRAIN = false;
    bf16_t* O; int ldc; const float* cbias; const float* rbias; const float* cscale; float ascale = 1.0f;
    const float* rs = nullptr; const float* cs = nullptr;
    __device__ __forceinline__ void operator()(const f32x4 (&acc)[2][2][4][2], const Unit& u, int wr, int wc, int fr, int fq) const {
        const int row0 = u.pm * BM + wr * 64 + fr, col0 = u.pn * BM + wc * 32 + 8 * fq;
        f32x4 bv[2][2], sv[2][2], cv[2][2]; float rsc[2][4], rb[2][4];
#pragma unroll
        for (int bj = 0; bj < 2; ++bj)
#pragma unroll
            for (int n = 0; n < 2; ++n) { bv[bj][n] = cbias ? *(const PG8_GAS f32x4*)(cbias + col0 + bj * HALF + 4 * n) : (f32x4){0.f, 0.f, 0.f, 0.f};
                                          sv[bj][n] = cscale ? *(const PG8_GAS f32x4*)(cscale + col0 + bj * HALF + 4 * n) : (f32x4){1.f, 1.f, 1.f, 1.f};
                                          cv[bj][n] = cs ? *(const PG8_GAS f32x4*)(cs + col0 + bj * HALF + 4 * n) : (f32x4){1.f, 1.f, 1.f, 1.f}; }
#pragma unroll
        for (int ai = 0; ai < 2; ++ai)
#pragma unroll
            for (int m = 0; m < 4; ++m) { const int r = row0 + ai * HALF + m * 16; rsc[ai][m] = (rs ? ((const PG8_GAS float*)rs)[r] : 1.0f) * ascale; rb[ai][m] = rbias ? ((const PG8_GAS float*)rbias)[r] : 0.f; }
#pragma unroll
        for (int ai = 0; ai < 2; ++ai)
#pragma unroll
            for (int m = 0; m < 4; ++m) { const int r = row0 + ai * HALF + m * 16; PG8_GAS bf16_t* rowp = (PG8_GAS bf16_t*)O + (size_t)r * ldc + col0;
#pragma unroll
                for (int bj = 0; bj < 2; ++bj) { f32x4 a0 = acc[ai][bj][m][0], a1 = acc[ai][bj][m][1];
                    if (IACC) { a0 = __builtin_convertvector(__builtin_bit_cast(i32x4v, a0), f32x4); a1 = __builtin_convertvector(__builtin_bit_cast(i32x4v, a1), f32x4); }
                    f32x4 v0 = a0 * (cv[bj][0] * rsc[ai][m]) + bv[bj][0] + rb[ai][m], v1 = a1 * (cv[bj][1] * rsc[ai][m]) + bv[bj][1] + rb[ai][m];
                    if (ACT == 1) { v0 = gelu4(v0); v1 = gelu4(v1); }
                    v0 = v0 * sv[bj][0]; v1 = v1 * sv[bj][1];
                    *(PG8_GAS u32x4*)(rowp + bj * HALF) = pack8(v0, v1); } }
    }
};
struct EpiF32 {
    static constexpr bool PERM = false, AFTER_DRAIN = false;
    float* C; int ldc;
    __device__ __forceinline__ void operator()(const f32x4 (&acc)[2][2][4][2], const Unit& u, int wr, int wc, int fr, int fq) const {
        const int row0 = u.pm * BM + wr * 64 + fr, col0 = u.pn * BM + wc * 32 + 4 * fq;
#pragma unroll
        for (int ai = 0; ai < 2; ++ai)
#pragma unroll
            for (int m = 0; m < 4; ++m) { float* rowp = C + (size_t)(row0 + ai * HALF + m * 16) * ldc + col0;
#pragma unroll
                for (int bj = 0; bj < 2; ++bj)
#pragma unroll
                    for (int n = 0; n < 2; ++n) *(f32x4*)(rowp + bj * HALF + n * 16) = acc[ai][bj][m][n]; }
    }
};
template <bool RBF> struct EpiRes {
    static constexpr bool PERM = true, AFTER_DRAIN = false;
    bf16_t* Y; const void* R; int ldc; float alpha; float ascale = 1.0f;
    __device__ __forceinline__ void operator()(const f32x4 (&acc)[2][2][4][2], const Unit& u, int wr, int wc, int fr, int fq) const {
        const int row0 = u.pm * BM + wr * 64 + fr, col0 = u.pn * BM + wc * 32 + 8 * fq;
#pragma unroll
        for (int ai = 0; ai < 2; ++ai) {
            f32x4 rv[4][2][2];
#pragma unroll
            for (int m = 0; m < 4; ++m) { const size_t off = (size_t)(row0 + ai * HALF + m * 16) * ldc + col0;
#pragma unroll
                for (int bj = 0; bj < 2; ++bj) {
                    if constexpr (RBF) { const u32x4 w = *(const PG8_GAS u32x4*)((const bf16_t*)R + off + bj * HALF);
                        rv[m][bj][0] = (f32x4){__builtin_bit_cast(float, w.x << 16), __builtin_bit_cast(float, w.x & 0xffff0000u), __builtin_bit_cast(float, w.y << 16), __builtin_bit_cast(float, w.y & 0xffff0000u)};
                        rv[m][bj][1] = (f32x4){__builtin_bit_cast(float, w.z << 16), __builtin_bit_cast(float, w.z & 0xffff0000u), __builtin_bit_cast(float, w.w << 16), __builtin_bit_cast(float, w.w & 0xffff0000u)}; }
                    else { rv[m][bj][0] = *(const PG8_GAS f32x4*)((const float*)R + off + bj * HALF); rv[m][bj][1] = *(const PG8_GAS f32x4*)((const float*)R + off + bj * HALF + 4); } } }
#pragma unroll
            for (int m = 0; m < 4; ++m) { const size_t off = (size_t)(row0 + ai * HALF + m * 16) * ldc + col0;
#pragma unroll
                for (int bj = 0; bj < 2; ++bj) *(PG8_GAS u32x4*)(Y + off + bj * HALF) = pack8(rv[m][bj][0] * alpha + acc[ai][bj][m][0] * ascale, rv[m][bj][1] * alpha + acc[ai][bj][m][1] * ascale); } }
    }
};
struct EpiGate {
    static constexpr bool PERM = true, AFTER_DRAIN = false;
    bf16_t* UG; int ldc; const float* bs;
    __device__ __forceinline__ void operator()(const f32x4 (&acc)[2][2][4][2], const Unit& u, int wr, int wc, int fr, int fq) const {
        const int row0 = u.pm * BM + wr * 64 + fr, col0 = u.pn * BM + wc * 32 + 8 * fq;
#pragma unroll
        for (int ai = 0; ai < 2; ++ai)
#pragma unroll
            for (int m = 0; m < 4; ++m) { const int r = row0 + ai * HALF + m * 16; bf16_t* rowp = UG + (size_t)r * ldc + col0; const float rb = bs[u.pn * 128 + (r & 127)];
#pragma unroll
                for (int bj = 0; bj < 2; ++bj) { const u32x4 uu = *(const u32x4*)(rowp + bj * HALF);
                    f32x4 v0 = acc[ai][bj][m][0] + rb, v1 = acc[ai][bj][m][1] + rb;
                    v0 = v0 * (f32x4){bf_lo(uu.x), bf_hi(uu.x), bf_lo(uu.y), bf_hi(uu.y)}; v1 = v1 * (f32x4){bf_lo(uu.z), bf_hi(uu.z), bf_lo(uu.w), bf_hi(uu.w)};
                    *(u32x4*)(rowp + bj * HALF) = pack8(v0, v1); } }
    }
};

struct EpiFp8 {
    static constexpr bool PERM = true, AFTER_DRAIN = false;
    unsigned char* O; int ldc; const float* cbias; const float* cscale; float oscale;
    __device__ __forceinline__ void operator()(const f32x4 (&acc)[2][2][4][2], const Unit& u, int wr, int wc, int fr, int fq) const {
        const int row0 = u.pm * BM + wr * 64 + fr, col0 = u.pn * BM + wc * 32 + 8 * fq, odd = fq & 1;
        f32x4 bv[2][2], sv[2][2];
#pragma unroll
        for (int bj = 0; bj < 2; ++bj)
#pragma unroll
            for (int n = 0; n < 2; ++n) { bv[bj][n] = *(const PG8_GAS f32x4*)(cbias + col0 + bj * HALF + 4 * n); sv[bj][n] = *(const PG8_GAS f32x4*)(cscale + col0 + bj * HALF + 4 * n) * oscale; }
#pragma unroll
        for (int ai = 0; ai < 2; ++ai)
#pragma unroll
            for (int mp = 0; mp < 2; ++mp) { const int r = row0 + ai * HALF + mp * 32 + 16 * odd;
#pragma unroll
                for (int bj = 0; bj < 2; ++bj) {
                    const u32x2p x = pk8_fp8((acc[ai][bj][2 * mp][0] + bv[bj][0]) * sv[bj][0], (acc[ai][bj][2 * mp][1] + bv[bj][1]) * sv[bj][1]);
                    const u32x2p y = pk8_fp8((acc[ai][bj][2 * mp + 1][0] + bv[bj][0]) * sv[bj][0], (acc[ai][bj][2 * mp + 1][1] + bv[bj][1]) * sv[bj][1]);
                    *(PG8_GAS u32x4*)(O + (size_t)r * ldc + col0 - 8 * odd + bj * HALF) = pair16(x, y); } }
    }
};
struct EpiGeluFp8 {
    static constexpr bool PERM = true, AFTER_DRAIN = false;
    unsigned char* O; int ldc; const float* cbias; const float* rs; float ascale; float oscale;
    __device__ __forceinline__ void operator()(const f32x4 (&acc)[2][2][4][2], const Unit& u, int wr, int wc, int fr, int fq) const {
        const int row0 = u.pm * BM + wr * 64 + fr, col0 = u.pn * BM + wc * 32 + 8 * fq, odd = fq & 1;
        f32x4 bv[2][2]; float rsc[2][4];
#pragma unroll
        for (int bj = 0; bj < 2; ++bj)
#pragma unroll
            for (int n = 0; n < 2; ++n) bv[bj][n] = *(const PG8_GAS f32x4*)(cbias + col0 + bj * HALF + 4 * n);
#pragma unroll
        for (int ai = 0; ai < 2; ++ai)
#pragma unroll
            for (int m = 0; m < 4; ++m) rsc[ai][m] = ((const PG8_GAS float*)rs)[row0 + ai * HALF + m * 16] * ascale;
#pragma unroll
        for (int ai = 0; ai < 2; ++ai)
#pragma unroll
            for (int mp = 0; mp < 2; ++mp) { const int r = row0 + ai * HALF + mp * 32 + 16 * odd;
#pragma unroll
                for (int bj = 0; bj < 2; ++bj) { u32x2p xy[2];
#pragma unroll
                    for (int h = 0; h < 2; ++h) { const int m = 2 * mp + h;
                        f32x4 v0 = __builtin_convertvector(__builtin_bit_cast(i32x4v, acc[ai][bj][m][0]), f32x4) * rsc[ai][m] + bv[bj][0], v1 = __builtin_convertvector(__builtin_bit_cast(i32x4v, acc[ai][bj][m][1]), f32x4) * rsc[ai][m] + bv[bj][1];
                        xy[h] = pk8_fp8(gelu4(v0) * oscale, gelu4(v1) * oscale); }
                    *(PG8_GAS u32x4*)(O + (size_t)r * ldc + col0 - 8 * odd + bj * HALF) = pair16(xy[0], xy[1]); } }
    }
};
struct EpiGate8 {
    static constexpr bool PERM = true, AFTER_DRAIN = false;
    const unsigned char* U; unsigned char* GF; int ldc; const float* bs; float gscale;
    __device__ __forceinline__ void operator()(const f32x4 (&acc)[2][2][4][2], const Unit& u, int wr, int wc, int fr, int fq) const {
        const int row0 = u.pm * BM + wr * 64 + fr, col0 = u.pn * BM + wc * 32 + 8 * fq, odd = fq & 1;
        u32x4 ul[2][2][2]; float rb[2][4];
#pragma unroll
        for (int ai = 0; ai < 2; ++ai) {
#pragma unroll
            for (int m = 0; m < 4; ++m) rb[ai][m] = ((const PG8_GAS float*)bs)[u.pn * 128 + ((row0 + ai * HALF + m * 16) & 127)];
#pragma unroll
            for (int mp = 0; mp < 2; ++mp)
#pragma unroll
                for (int bj = 0; bj < 2; ++bj) ul[ai][mp][bj] = *(const PG8_GAS u32x4*)(U + (size_t)(row0 + ai * HALF + mp * 32 + 16 * odd) * ldc + col0 - 8 * odd + bj * HALF); }
#pragma unroll
        for (int ai = 0; ai < 2; ++ai)
#pragma unroll
            for (int mp = 0; mp < 2; ++mp) { const int r = row0 + ai * HALF + mp * 32 + 16 * odd;
#pragma unroll
                for (int bj = 0; bj < 2; ++bj) { u32x2p ux[2], gx[2]; unpair16(ul[ai][mp][bj], ux[0], ux[1]);
#pragma unroll
                    for (int h = 0; h < 2; ++h) { const int m = 2 * mp + h;
                        f32x4 v0 = acc[ai][bj][m][0] + rb[ai][m], v1 = acc[ai][bj][m][1] + rb[ai][m];
                        const auto u01 = __builtin_amdgcn_cvt_pk_f32_fp8((int)ux[h].x, false), u23 = __builtin_amdgcn_cvt_pk_f32_fp8((int)ux[h].x, true), u45 = __builtin_amdgcn_cvt_pk_f32_fp8((int)ux[h].y, false), u67 = __builtin_amdgcn_cvt_pk_f32_fp8((int)ux[h].y, true);
                        gx[h] = pk8_fp8(v0 * (f32x4){u01[0], u01[1], u23[0], u23[1]} * gscale, v1 * (f32x4){u45[0], u45[1], u67[0], u67[1]} * gscale); }
                    *(PG8_GAS u32x4*)(GF + (size_t)r * ldc + col0 - 8 * odd + bj * HALF) = pair16(gx[0], gx[1]); } }
    }
};

template <class Epi, class Addr, class Sched, bool ALIGN_EPI = false, bool SP2 = false, int MODE = 0  >
__device__ __forceinline__ void gemm_phase(PG8_LAS unsigned char* lds, const Addr& g, const Sched& S, const Epi& E, const int tid  ) {
    const int wid = __builtin_amdgcn_readfirstlane(tid >> 6), lane = tid & 63, wr = wid >> 2, wc = wid & 3, fr = lane & 15, fq = lane >> 4;
    constexpr bool FP8 = MODE == 1, I8 = MODE == 2; constexpr int ES = MODE ? 1 : 2;
    const int K = g.K, nt = K / (BK * 2 / ES);
    unsigned voffA[2], voffB[2];
#pragma unroll
    for (int i = 0; i < 2; ++i) { int R, C; stage_rc(tid * 16 + i * 8192, R, C); const int Rb = Epi::PERM ? ((R & ~31) + perm32(R & 31)) : R;
        voffA[i] = (unsigned)(R * g.lda * ES + C * 2); voffB[i] = (unsigned)(Rb * g.ldb * ES + C * 2); }
    const size_t kstep = (size_t)(BK * 2);
    const size_t hsA = (size_t)HALF * g.lda * ES, hsB = (size_t)HALF * g.ldb * ES;
    const unsigned ldsw = (unsigned)wid * 1024u;
    const int aoff = lds_byte(wr * 64 + fr, fq * 8), boff = lds_byte(wc * 32 + fr, fq * 8);
#define PG8_SA(b, h) (((b) * 2 + (h)) * HTB)
#define PG8_SB(b, h) ((4 + (b) * 2 + (h)) * HTB)
#define PG8_STAGE(bufoff, gbase, voff) do { _Pragma("unroll") for (int _i = 0; _i < 2; ++_i) \
        __builtin_amdgcn_global_load_lds((const unsigned*)((const char*)(gbase) + (voff)[_i]), (PG8_LAS unsigned*)(lds + (bufoff) + ldsw + _i * 8192), 16, 0, 0); } while (0)
#define PG8_LDA(dst, b, h) do { _Pragma("unroll") for (int m = 0; m < 4; ++m) { if constexpr (FP8) { dst##8[m] = pk32(*(const PG8_LAS bf16x8*)(lds + PG8_SA(b, h) + aoff + m * 2048), *(const PG8_LAS bf16x8*)(lds + PG8_SA(b, h) + aoff + m * 2048 + 1024)); } \
        else { _Pragma("unroll") for (int k = 0; k < 2; ++k) dst[m][k] = *(const PG8_LAS bf16x8*)(lds + PG8_SA(b, h) + aoff + m * 2048 + k * 1024); } } } while (0)
#define PG8_LDB(dst, b, h) do { _Pragma("unroll") for (int n = 0; n < 2; ++n) { if constexpr (FP8) { dst##8[n] = pk32(*(const PG8_LAS bf16x8*)(lds + PG8_SB(b, h) + boff + n * 2048), *(const PG8_LAS bf16x8*)(lds + PG8_SB(b, h) + boff + n * 2048 + 1024)); } \
        else { _Pragma("unroll") for (int k = 0; k < 2; ++k) dst[n][k] = *(const PG8_LAS bf16x8*)(lds + PG8_SB(b, h) + boff + n * 2048 + k * 1024); } } } while (0)
#define PG8_MMA(ai, bj, At, Bt) do { __builtin_amdgcn_s_setprio(1); _Pragma("unroll") for (int m = 0; m < 4; ++m) _Pragma("unroll") for (int n = 0; n < 2; ++n) { \
        if constexpr (FP8) { asm volatile("v_mfma_scale_f32_16x16x128_f8f6f4 %0, %1, %2, %0, %3, %3 op_sel_hi:[0,0,0]" : "+v"(acc[ai][bj][m][n]) : "v"(Bt##8[n]), "v"(At##8[m]), "v"(sc127)); } \
        else if constexpr (I8) { _Pragma("unroll") for (int k = 0; k < 2; ++k) acc[ai][bj][m][n] = __builtin_bit_cast(f32x4, __builtin_amdgcn_mfma_i32_16x16x64_i8(__builtin_bit_cast(i32x4v, Bt[n][k]), __builtin_bit_cast(i32x4v, At[m][k]), __builtin_bit_cast(i32x4v, acc[ai][bj][m][n]), 0, 0, 0)); } \
        else { _Pragma("unroll") for (int k = 0; k < 2; ++k) acc[ai][bj][m][n] = __builtin_amdgcn_mfma_f32_16x16x32_bf16(Bt[n][k], At[m][k], acc[ai][bj][m][n], 0, 0, 0); } } __builtin_amdgcn_s_setprio(0); } while (0)
#define PG8_WAIT_V(n) asm volatile("s_waitcnt vmcnt(" #n ")" ::: "memory")
#define PG8_WAIT_L(n) asm volatile("s_waitcnt lgkmcnt(" #n ")" ::: "memory")
#define PG8_BAR __builtin_amdgcn_s_barrier()
#define PG8_SCHED __builtin_amdgcn_sched_barrier(0)
    Unit cur, nxt; int ui = 0;
    if (!S.next(0, cur)) return;
    f32x4 acc[2][2][4][2];
#pragma unroll
    for (int a = 0; a < 2; ++a)
#pragma unroll
        for (int b = 0; b < 2; ++b)
#pragma unroll
            for (int m = 0; m < 4; ++m)
#pragma unroll
                for (int n = 0; n < 2; ++n) acc[a][b][m][n] = (f32x4){0.f, 0.f, 0.f, 0.f};
    bf16x8 At[4][2], B0[2][2], B1[2][2]; i32x8 At8[4], B08[2], B18[2]; int sc127 = 127; if constexpr (FP8) asm volatile("" : "+v"(sc127));
    const char* cA = g.a(cur); const char* cB = g.b(cur);
    S.a_ready(cur);
    if constexpr (SP2) {
        PG8_STAGE(PG8_SB(0, 0), cB, voffB); PG8_STAGE(PG8_SB(0, 1), cB + hsB, voffB); PG8_STAGE(PG8_SA(0, 0), cA, voffA); PG8_STAGE(PG8_SA(0, 1), cA + hsA, voffA);
        if (wr == 1) PG8_BAR;
        PG8_WAIT_V(2); PG8_BAR;
        PG8_STAGE(PG8_SB(1, 0), cB + kstep, voffB); PG8_STAGE(PG8_SA(1, 0), cA + kstep, voffA); PG8_STAGE(PG8_SB(1, 1), cB + hsB + kstep, voffB);
        PG8_WAIT_V(6); PG8_BAR;
    } else {
        PG8_STAGE(PG8_SB(0, 0), cB, voffB); PG8_STAGE(PG8_SA(0, 0), cA, voffA); PG8_STAGE(PG8_SB(0, 1), cB + hsB, voffB); PG8_STAGE(PG8_SA(0, 1), cA + hsA, voffA);
        if (wr == 1) PG8_BAR;
        PG8_WAIT_V(4); PG8_BAR;
        PG8_STAGE(PG8_SB(1, 0), cB + kstep, voffB); PG8_STAGE(PG8_SA(1, 0), cA + kstep, voffA); PG8_STAGE(PG8_SB(1, 1), cB + hsB + kstep, voffB);
        PG8_WAIT_V(6); PG8_BAR;
    }
    for (;;) {
        const bool has_next = S.next(ui + 1, nxt);
        const char* nA = has_next ? g.a(nxt) : cA; const char* nB = has_next ? g.b(nxt) : cB;
        for (int t = 0; t < nt; t += 2) {
            const bool last = (t == nt - 2);
            const char* a1 = cA + (size_t)(t + 1) * kstep;
            const char* a2 = last ? nA : cA + (size_t)(t + 2) * kstep; const char* b2 = last ? nB : cB + (size_t)(t + 2) * kstep;
            const char* a3 = a2 + kstep; const char* b3 = b2 + kstep;
            if (last && has_next) S.a_ready(nxt);
            if constexpr (SP2) {
            PG8_LDB(B0, 0, 0); PG8_LDB(B1, 0, 1); PG8_SCHED; PG8_LDA(At, 0, 0); PG8_STAGE(PG8_SA(1, 1), a1 + hsA, voffA);
            PG8_WAIT_V(8); PG8_WAIT_L(0); PG8_BAR; PG8_MMA(0, 0, At, B0); PG8_MMA(0, 1, At, B1); PG8_BAR; PG8_SCHED;
            PG8_LDA(At, 0, 1); PG8_STAGE(PG8_SB(0, 0), b2, voffB); PG8_STAGE(PG8_SB(0, 1), b2 + hsB, voffB); PG8_STAGE(PG8_SA(0, 0), a2, voffA);
            PG8_WAIT_V(8); PG8_WAIT_L(0); PG8_BAR; PG8_MMA(1, 0, At, B0); PG8_MMA(1, 1, At, B1); PG8_BAR; PG8_SCHED;
            PG8_LDB(B0, 1, 0); PG8_LDB(B1, 1, 1); PG8_SCHED; PG8_LDA(At, 1, 0); PG8_STAGE(PG8_SA(0, 1), a2 + hsA, voffA);
            PG8_WAIT_V(8); PG8_WAIT_L(0); PG8_BAR; PG8_MMA(0, 0, At, B0); PG8_MMA(0, 1, At, B1); PG8_BAR; PG8_SCHED;
            PG8_LDA(At, 1, 1); PG8_STAGE(PG8_SB(1, 0), b3, voffB); PG8_STAGE(PG8_SB(1, 1), b3 + hsB, voffB); PG8_STAGE(PG8_SA(1, 0), a3, voffA);
            PG8_WAIT_V(8); PG8_WAIT_L(0); PG8_BAR; PG8_MMA(1, 0, At, B0); PG8_MMA(1, 1, At, B1); PG8_BAR; PG8_SCHED;
            } else {
            PG8_LDB(B0, 0, 0); PG8_SCHED; PG8_LDA(At, 0, 0); PG8_STAGE(PG8_SA(1, 1), a1 + hsA, voffA);
            PG8_WAIT_L(8); PG8_BAR; PG8_WAIT_L(0); PG8_MMA(0, 0, At, B0); PG8_BAR; PG8_SCHED;
            PG8_LDB(B1, 0, 1); PG8_STAGE(PG8_SB(0, 0), b2, voffB);
            PG8_BAR; PG8_WAIT_L(0); PG8_MMA(0, 1, At, B1); PG8_BAR;
            PG8_LDA(At, 0, 1); PG8_STAGE(PG8_SA(0, 0), a2, voffA);
            PG8_BAR; PG8_WAIT_L(0); PG8_MMA(1, 0, At, B0); PG8_BAR; PG8_SCHED;
            PG8_STAGE(PG8_SB(0, 1), b2 + hsB, voffB);
            PG8_WAIT_V(6); PG8_BAR; PG8_MMA(1, 1, At, B1); PG8_BAR;
            PG8_LDB(B0, 1, 0); PG8_SCHED; PG8_LDA(At, 1, 0); PG8_STAGE(PG8_SA(0, 1), a2 + hsA, voffA);
            PG8_WAIT_L(8); PG8_BAR; PG8_WAIT_L(0); PG8_MMA(0, 0, At, B0); PG8_BAR; PG8_SCHED;
            PG8_LDB(B1, 1, 1); PG8_STAGE(PG8_SB(1, 0), b3, voffB);
            PG8_BAR; PG8_WAIT_L(0); PG8_MMA(0, 1, At, B1); PG8_BAR;
            PG8_LDA(At, 1, 1); PG8_STAGE(PG8_SA(1, 0), a3, voffA);
            PG8_BAR; PG8_WAIT_L(0); PG8_MMA(1, 0, At, B0); PG8_BAR; PG8_SCHED;
            PG8_STAGE(PG8_SB(1, 1), b3 + hsB, voffB);
            PG8_WAIT_V(6); PG8_BAR; PG8_MMA(1, 1, At, B1); PG8_BAR;
            }
        }
        if constexpr (ALIGN_EPI) { if (wr == 0) PG8_BAR; }
        if constexpr (FP8) asm volatile("s_nop 15\n\ts_nop 15" ::: "memory");
#ifdef PG8_EPI2
        if constexpr (!Epi::AFTER_DRAIN && PG8_EPI2(Epi)) { E(acc, cur, wr, wc, fr, fq); asm volatile("" ::: "memory"); }
#endif
        if constexpr (!Epi::AFTER_DRAIN) { E(acc, cur, wr, wc, fr, fq); S.done(cur); }
        if (!has_next) break;
#pragma unroll
        for (int a = 0; a < 2; ++a)
#pragma unroll
            for (int b = 0; b < 2; ++b)
#pragma unroll
                for (int m = 0; m < 4; ++m)
#pragma unroll
                    for (int n = 0; n < 2; ++n) acc[a][b][m][n] = (f32x4){0.f, 0.f, 0.f, 0.f};
        cur = nxt; cA = nA; cB = nB; ++ui;
        if constexpr (ALIGN_EPI) { if (wr == 1) PG8_BAR; }
    }
    PG8_WAIT_V(0);
    if constexpr (!ALIGN_EPI) { if (wr == 0) PG8_BAR; }
    PG8_BAR;
    if constexpr (Epi::AFTER_DRAIN) { E.fused(acc, cur, wr, wc, fr, fq, lds, wid, lane); S.done(cur); }
#undef PG8_SA
#undef PG8_SB
#undef PG8_STAGE
#undef PG8_LDA
#undef PG8_LDB
#undef PG8_MMA
#undef PG8_WAIT_V
#undef PG8_WAIT_L
#undef PG8_BAR
#undef PG8_SCHED
}
}

constexpr int NWAVES = 8, NTHREADS = NWAVES * 64;
constexpr int M_TOK = 16384, SEQ = 4096, D = 2048, FFA = 8192, HA = 4096, NGA = 16, CHUNK = 128;
constexpr int NKEYS = 128, NEXP = 16384, HEADS = 8, TOPK = 16, NSEL = HEADS * TOPK;
constexpr float ALPHA = 1.41421356237f, LN_EPS = 1e-5f;
constexpr float X4_SCALE = 1.25f;
constexpr float M_SCALE = 32.0f;
constexpr float U_SCALE = 16.0f;
constexpr float G_SCALE = 16.0f, W2_SCALE = 2048.0f;
constexpr float W1_SCALE = 1024.0f;
constexpr int N_PHASES = 17;

constexpr size_t MiB = 1u << 20;
constexpr size_t WS_CTL = 0, CTL_ZERO_BYTES = 1 * MiB;
constexpr size_t WS_W1T = 2 * MiB, WS_W2T = 34 * MiB, WS_BINT = 50 * MiB, WS_BOUTT = 58 * MiB, WS_WQT = 66 * MiB  , WS_BGT = 82 * MiB, WS_BD = 84 * MiB, WS_BDSK = 86 * MiB  ;
constexpr size_t WS_SU = 87 * MiB, WS_SV = 87 * MiB + 131072;
constexpr size_t WS_XB = 88 * MiB;
constexpr size_t WS_UT = 152 * MiB, WS_VTAB = 280 * MiB;
constexpr size_t WS_UG = 408 * MiB;
constexpr size_t WS_ST = 408 * MiB, WS_POOL = 408 * MiB, WS_MIXED = 472 * MiB;
constexpr size_t WS_VT = 536 * MiB;
constexpr size_t WS_Q = 536 * MiB, WS_H = 600 * MiB;
constexpr size_t WS_Y = 664 * MiB;
constexpr size_t WS_X1 = 792 * MiB;
constexpr size_t WS_EIDX = 920 * MiB, WS_GATE = 928 * MiB;
constexpr size_t WS_WQS = 936 * MiB;
constexpr size_t WS_XF = 952 * MiB;
constexpr size_t WS_SX0 = 984 * MiB;
constexpr size_t WS_END = 985 * MiB;
constexpr int CW_BAR = 4096;

constexpr int RING_OFF = 0, RING_BYTES = 131072;
constexpr int LDSCTL_OFF = RING_BYTES, MISC_OFF = LDSCTL_OFF + 320;
constexpr int IDS16_OFF = LDSCTL_OFF + 1024;
constexpr int IDS16_WAVE = 3584;
constexpr int LDS_BYTES = IDS16_OFF + 8 * IDS16_WAVE;
static_assert(MISC_OFF + 128 <= LDS_BYTES, "LDS map");

#define GAS __attribute__((address_space(1)))
#define LAS __attribute__((address_space(3)))
typedef unsigned short bf16;
typedef unsigned v4u __attribute__((ext_vector_type(4)));
typedef unsigned v2u __attribute__((ext_vector_type(2)));
typedef float f32x4 __attribute__((ext_vector_type(4)));
typedef __bf16 bf16x2_t __attribute__((ext_vector_type(2)));
typedef GAS unsigned gu32;
#define RLX_AGENT __ATOMIC_RELAXED, __HIP_MEMORY_SCOPE_AGENT
#define LDS_WAIT() asm volatile("s_waitcnt lgkmcnt(0)" ::: "memory")
#define VM_WAIT() asm volatile("s_waitcnt vmcnt(0)" ::: "memory")
__device__ __forceinline__ unsigned f2bf(float f) { unsigned u = __builtin_bit_cast(unsigned, f); return (u + 0x7fffu + ((u >> 16) & 1u)) >> 16; }
__device__ __forceinline__ unsigned pk2(float lo, float hi) { return f2bf(lo) | (f2bf(hi) << 16); }
__device__ __forceinline__ float bflo(unsigned w) { return __builtin_bit_cast(float, w << 16); }
__device__ __forceinline__ float bfhi(unsigned w) { return __builtin_bit_cast(float, w & 0xffff0000u); }
__device__ __forceinline__ float dot2_bf16(unsigned w, unsigned x, float acc) { return __builtin_amdgcn_fdot2_f32_bf16(__builtin_bit_cast(bf16x2_t, w), __builtin_bit_cast(bf16x2_t, x), acc, false); }
__device__ __forceinline__ float shx(float v, int m, int lane) { return __builtin_bit_cast(float, __builtin_amdgcn_ds_bpermute((lane ^ m) << 2, __builtin_bit_cast(int, v))); }
__device__ __forceinline__ float wave_sum_l(float v, int lane) {
#pragma unroll
    for (int o = 1; o < 64; o <<= 1) v += shx(v, o, lane);
    return v;
}

#define XB_TMO      128
#define XB_XCNT(j)  (256  + 64 * (j))
#define XB_XSUB(j)  (1280 + 64 * (j))
#define XB_XGEN(j)  (2304 + 64 * (j))
#define XB_TOP      3328
#define XB_TOPGEN   3392
#define XCD_BAR_WORDS 3456
#define XB_SPIN_CAP (1u << 20)

__device__ __forceinline__ unsigned xb_ld(unsigned* p)              { return __hip_atomic_load(p, __ATOMIC_RELAXED, __HIP_MEMORY_SCOPE_AGENT); }
__device__ __forceinline__ unsigned xb_add(unsigned* p, unsigned v) { return __hip_atomic_fetch_add(p, v, __ATOMIC_RELAXED, __HIP_MEMORY_SCOPE_AGENT); }
__device__ __forceinline__ unsigned xb_xcc_id() { return (unsigned)__builtin_amdgcn_s_getreg((3 << 11) | 20) & 0xFu; }
#define XB_SPIN(cond, bar) do { unsigned _sp = 0; while (cond) { __builtin_amdgcn_s_sleep(1); \
    if ((++_sp & 255u) == 0u) { if (xb_ld(&(bar)[XB_TMO])) break; if (_sp > XB_SPIN_CAP) { atomicAdd(&(bar)[XB_TMO], 1u); break; } } } } while (0)

struct XcdBarrier { unsigned* bar; unsigned x; volatile LAS unsigned* st; };

__device__ __forceinline__ XcdBarrier xcd_barrier_post(unsigned* bar, volatile LAS unsigned* st) {
    XcdBarrier b; b.bar = bar; b.x = xb_xcc_id(); b.st = st;
    if (threadIdx.x == 0) (void)xb_add(&bar[XB_XCNT(b.x)], 1u);
    return b;
}
__device__ __forceinline__ void xcd_barrier_complete(unsigned* bar, unsigned x, unsigned& nloc, unsigned& nx) {
    const unsigned G = gridDim.x * gridDim.y * gridDim.z;
    unsigned sum, cnt, mine, sp = 0u;
    for (;;) {
        sum = 0u; cnt = 0u; mine = 0u;
#pragma unroll
        for (unsigned j = 0; j < 16; ++j) { const unsigned c = xb_ld(&bar[XB_XCNT(j)]); sum += c; cnt += (c > 0u) ? 1u : 0u; mine = (j == x) ? c : mine; }
        if (sum == G) break;
        __builtin_amdgcn_s_sleep(1);
        if ((++sp & 255u) == 0u) { if (xb_ld(&bar[XB_TMO])) break; if (sp > XB_SPIN_CAP) { atomicAdd(&bar[XB_TMO], 1u); break; } }
    }
    nloc = mine > 0u ? mine : 1u; nx = cnt > 0u ? cnt : 1u;
}
__device__ __forceinline__ void xcd_barrier(const XcdBarrier& b, const int tid) {
    asm volatile("s_waitcnt vmcnt(0)" ::: "memory");
    __syncthreads();
    if (tid == 0) {
        unsigned* bar = b.bar;
        __builtin_amdgcn_s_waitcnt(0);
        unsigned nloc = b.st[0], nx = b.st[1];
        if (nloc == 0u) { xcd_barrier_complete(bar, b.x, nloc, nx); b.st[0] = nloc; b.st[1] = nx; }
        const unsigned old = xb_add(&bar[XB_XSUB(b.x)], 1u);
        const unsigned gen = old / nloc;
        if (old + 1u == (gen + 1u) * nloc) {
            __builtin_amdgcn_fence(__ATOMIC_RELEASE, "agent");
            asm volatile("s_waitcnt vmcnt(0)" ::: "memory");
            const unsigned og = xb_add(&bar[XB_TOP], 1u);
            const unsigned tg = og / nx;
            if (og + 1u == (tg + 1u) * nx) xb_add(&bar[XB_TOPGEN], 1u);
            else XB_SPIN(xb_ld(&bar[XB_TOPGEN]) == tg, bar);
            __builtin_amdgcn_fence(__ATOMIC_ACQUIRE, "agent");
            xb_add(&bar[XB_XGEN(b.x)], 1u);
            asm volatile("s_waitcnt vmcnt(0)" ::: "memory");
        } else {
            XB_SPIN(xb_ld(&bar[XB_XGEN(b.x)]) == gen, bar);
            __builtin_amdgcn_fence(__ATOMIC_ACQUIRE, "agent");
            asm volatile("s_waitcnt vmcnt(0)" ::: "memory");
        }
    }
    __syncthreads();
}

__device__ __forceinline__ void p0_transpose_item(const float* W, int K, int N, bf16* WT, LAS float* scr, int item, int lane) {
    const int nblk = N / 32, kb = item / nblk, nb = item % nblk, k0 = 64 * kb, n0 = 32 * nb;
    float t[32];
#pragma unroll
    for (int i = 0; i < 32; ++i) t[i] = W[(size_t)(k0 + 2 * i + (lane >> 5)) * N + n0 + (lane & 31)];
#pragma unroll
    for (int i = 0; i < 32; ++i) scr[(2 * i + (lane >> 5)) * 33 + (lane & 31)] = t[i];
    LDS_WAIT(); asm volatile("" ::: "memory");
    const int c = lane & 7;
#pragma unroll
    for (int j = 0; j < 4; ++j) { const int n = (lane >> 3) + 8 * j; const LAS float* s = scr + (8 * c) * 33 + n;
        v4u o; o.x = pk2(s[0 * 33], s[1 * 33]); o.y = pk2(s[2 * 33], s[3 * 33]); o.z = pk2(s[4 * 33], s[5 * 33]); o.w = pk2(s[6 * 33], s[7 * 33]);
        *(GAS v4u*)(WT + (size_t)(n0 + n) * K + k0 + 8 * c) = o; }
    LDS_WAIT(); asm volatile("" ::: "memory");
}
__device__ __forceinline__ void p0_convert(const float* src, bf16* dst, int nchunks, int gw, int NGW, int lane) {
    for (int c0 = gw; c0 < nchunks; c0 += 4 * NGW) {
        f32x4 a[4][2];
#pragma unroll
        for (int q = 0; q < 4; ++q) { const int c = c0 + q * NGW; if (c < nchunks) { const GAS f32x4* s = (const GAS f32x4*)(src + (size_t)c * 512 + lane * 8); a[q][0] = s[0]; a[q][1] = s[1]; } }
#pragma unroll
        for (int q = 0; q < 4; ++q) { const int c = c0 + q * NGW; if (c < nchunks) { v4u o; o.x = pk2(a[q][0].x, a[q][0].y); o.y = pk2(a[q][0].z, a[q][0].w); o.z = pk2(a[q][1].x, a[q][1].y); o.w = pk2(a[q][1].z, a[q][1].w);
            *(GAS v4u*)(dst + (size_t)c * 512 + lane * 8) = o; } }
    }
}

__device__ __forceinline__ float clamp448(float v) { return __builtin_amdgcn_fmed3f(v, -448.0f, 448.0f); }
__device__ __forceinline__ unsigned pk4_fp8(float a, float b, float c, float d) { int w = 0; w = __builtin_amdgcn_cvt_pk_fp8_f32(clamp448(a), clamp448(b), w, false); w = __builtin_amdgcn_cvt_pk_fp8_f32(clamp448(c), clamp448(d), w, true); return (unsigned)w; }
__device__ __forceinline__ unsigned pk4_i8c(float a, float b, float c, float d) {
    const int q0 = (int)__builtin_rintf(__builtin_amdgcn_fmed3f(a, -127.f, 127.f)), q1 = (int)__builtin_rintf(__builtin_amdgcn_fmed3f(b, -127.f, 127.f)), q2 = (int)__builtin_rintf(__builtin_amdgcn_fmed3f(c, -127.f, 127.f)), q3 = (int)__builtin_rintf(__builtin_amdgcn_fmed3f(d, -127.f, 127.f));
    return ((unsigned)q0 & 0xffu) | (((unsigned)q1 & 0xffu) << 8) | (((unsigned)q2 & 0xffu) << 16) | ((unsigned)q3 << 24);
}
template <int NR> __device__ __forceinline__ void rows_to_i8(const float* x, unsigned char* o8, float* sx, int m0, int stride, int lane) {
    f32x4 v[NR][8];
#pragma unroll
    for (int k = 0; k < NR; ++k) { const GAS f32x4* xr = (const GAS f32x4*)(x + (size_t)(m0 + k * stride) * D) + lane;
#pragma unroll
        for (int j = 0; j < 8; ++j) v[k][j] = xr[64 * j]; }
#pragma unroll
    for (int k = 0; k < NR; ++k) { float am = 0.f;
#pragma unroll
        for (int j = 0; j < 8; ++j) am = fmaxf(am, fmaxf(fmaxf(fabsf(v[k][j].x), fabsf(v[k][j].y)), fmaxf(fabsf(v[k][j].z), fabsf(v[k][j].w))));
#pragma unroll
        for (int o = 1; o < 64; o <<= 1) am = fmaxf(am, shx(am, o, lane));
        const float inv = am > 0.f ? 127.0f / am : 0.f; const size_t ro = (size_t)(m0 + k * stride) * D;
#pragma unroll
        for (int j = 0; j < 8; ++j) ((GAS unsigned*)(o8 + ro) + lane)[64 * j] = pk4_i8c(v[k][j].x * inv, v[k][j].y * inv, v[k][j].z * inv, v[k][j].w * inv);
        if (lane == 0) ((GAS float*)sx)[m0 + k * stride] = am * (1.0f / 127.0f); }
}
template <bool I8> __device__ __forceinline__ void p0_transpose_item8(const float* W, int K, int N, unsigned char* WT, float scale, LAS float* scr, int item, int lane) {
    const int nblk = N / 32, kb = item / nblk, nb = item % nblk, k0 = 64 * kb, n0 = 32 * nb;
    float t[32];
#pragma unroll
    for (int i = 0; i < 32; ++i) t[i] = W[(size_t)(k0 + 2 * i + (lane >> 5)) * N + n0 + (lane & 31)];
#pragma unroll
    for (int i = 0; i < 32; ++i) scr[(2 * i + (lane >> 5)) * 33 + (lane & 31)] = t[i] * scale;
    LDS_WAIT(); asm volatile("" ::: "memory");
    const int c = lane & 7;
#pragma unroll
    for (int j = 0; j < 4; ++j) { const int n = (lane >> 3) + 8 * j; const LAS float* s = scr + (8 * c) * 33 + n;
        v2u o; if (I8) { o.x = pk4_i8c(s[0 * 33], s[1 * 33], s[2 * 33], s[3 * 33]); o.y = pk4_i8c(s[4 * 33], s[5 * 33], s[6 * 33], s[7 * 33]); } else { o.x = pk4_fp8(s[0 * 33], s[1 * 33], s[2 * 33], s[3 * 33]); o.y = pk4_fp8(s[4 * 33], s[5 * 33], s[6 * 33], s[7 * 33]); }
        *(GAS v2u*)(WT + (size_t)(n0 + n) * K + k0 + 8 * c) = o; }
    LDS_WAIT(); asm volatile("" ::: "memory");
}
__device__ __forceinline__ void p0_convert8(const float* src, unsigned char* dst, float scale, int nchunks, int gw, int NGW, int lane) {
    for (int c0 = gw; c0 < nchunks; c0 += 8 * NGW) {
        f32x4 a[8][2];
#pragma unroll
        for (int q = 0; q < 8; ++q) { const int c = c0 + q * NGW; if (c < nchunks) { const GAS f32x4* s = (const GAS f32x4*)(src + (size_t)c * 512 + lane * 8); a[q][0] = s[0]; a[q][1] = s[1]; } }
#pragma unroll
        for (int q = 0; q < 8; ++q) { const int c = c0 + q * NGW; if (c < nchunks) { v2u o; o.x = pk4_fp8(a[q][0].x * scale, a[q][0].y * scale, a[q][0].z * scale, a[q][0].w * scale); o.y = pk4_fp8(a[q][1].x * scale, a[q][1].y * scale, a[q][1].z * scale, a[q][1].w * scale);
            *(GAS v2u*)(dst + (size_t)c * 512 + lane * 8) = o; } }
    }
}
__device__ __forceinline__ void p0_row_fp8(const float* src, unsigned char* dst, int e, float* scale, int lane) {
    f32x4 v[2][4]; float am = 0.f;
#pragma unroll
    for (int i = 0; i < 2; ++i)
#pragma unroll
        for (int q = 0; q < 4; ++q) { v[i][q] = *(const GAS f32x4*)(src + i * 1024 + lane * 16 + 4 * q);
            am = fmaxf(am, fmaxf(fmaxf(fabsf(v[i][q].x), fabsf(v[i][q].y)), fmaxf(fabsf(v[i][q].z), fabsf(v[i][q].w)))); }
#pragma unroll
    for (int o = 1; o < 64; o <<= 1) am = fmaxf(am, shx(am, o, lane));
    const float inv = am > 0.f ? 256.0f / am : 0.f;
#pragma unroll
    for (int i = 0; i < 2; ++i) { v4u w;
#pragma unroll
        for (int q = 0; q < 4; ++q) { int d = 0; d = __builtin_amdgcn_cvt_pk_fp8_f32(v[i][q].x * inv, v[i][q].y * inv, d, false); d = __builtin_amdgcn_cvt_pk_fp8_f32(v[i][q].z * inv, v[i][q].w * inv, d, true); w[q] = (unsigned)d; }
        *(GAS v4u*)(dst + (size_t)(i * 8 + (lane >> 3)) * (NEXP * 128) + (size_t)e * 128 + (lane & 7) * 16) = w; }
    if (lane == 0) *scale = am * (1.0f / 256.0f);
}

template <int NR> __device__ __forceinline__ void p0_row_fp4(const float* const (&src)[NR], unsigned char* const (&dst)[NR], const int (&e)[NR], float* const (&scale)[NR], int lane) {
    f32x4 v[NR][2][4];
#pragma unroll
    for (int k = 0; k < NR; ++k)
#pragma unroll
        for (int i = 0; i < 2; ++i)
#pragma unroll
            for (int q = 0; q < 4; ++q) v[k][i][q] = *(const GAS f32x4*)(src[k] + i * 1024 + lane * 16 + 4 * q);
#pragma unroll
    for (int k = 0; k < NR; ++k) { float am = 0.f;
#pragma unroll
        for (int i = 0; i < 2; ++i)
#pragma unroll
            for (int q = 0; q < 4; ++q) am = fmaxf(am, fmaxf(fmaxf(fabsf(v[k][i][q].x), fabsf(v[k][i][q].y)), fmaxf(fabsf(v[k][i][q].z), fabsf(v[k][i][q].w))));
#pragma unroll
        for (int o = 1; o < 64; o <<= 1) am = fmaxf(am, shx(am, o, lane));
        const float inv = am > 0.f ? 6.0f / am : 0.f;
#pragma unroll
        for (int i = 0; i < 2; ++i) { unsigned w0 = 0, w1 = 0;
            w0 = __builtin_amdgcn_cvt_scalef32_pk_fp4_f32(w0, v[k][i][0].x * inv, v[k][i][0].y * inv, 1.0f, 0); w0 = __builtin_amdgcn_cvt_scalef32_pk_fp4_f32(w0, v[k][i][0].z * inv, v[k][i][0].w * inv, 1.0f, 1);
            w0 = __builtin_amdgcn_cvt_scalef32_pk_fp4_f32(w0, v[k][i][1].x * inv, v[k][i][1].y * inv, 1.0f, 2); w0 = __builtin_amdgcn_cvt_scalef32_pk_fp4_f32(w0, v[k][i][1].z * inv, v[k][i][1].w * inv, 1.0f, 3);
            w1 = __builtin_amdgcn_cvt_scalef32_pk_fp4_f32(w1, v[k][i][2].x * inv, v[k][i][2].y * inv, 1.0f, 0); w1 = __builtin_amdgcn_cvt_scalef32_pk_fp4_f32(w1, v[k][i][2].z * inv, v[k][i][2].w * inv, 1.0f, 1);
            w1 = __builtin_amdgcn_cvt_scalef32_pk_fp4_f32(w1, v[k][i][3].x * inv, v[k][i][3].y * inv, 1.0f, 2); w1 = __builtin_amdgcn_cvt_scalef32_pk_fp4_f32(w1, v[k][i][3].z * inv, v[k][i][3].w * inv, 1.0f, 3);
            *(GAS v2u*)(dst[k] + (size_t)(i * 4 + (lane >> 4)) * (NEXP * 128) + (size_t)e[k] * 128 + (lane & 15) * 8) = (v2u){w0, w1}; }
        if (lane == 0) *(GAS float*)scale[k] = am * (1.0f / 6.0f); }
}

template <int NR> __device__ __forceinline__ void p0_row_fp4t(const float* const (&src)[NR], unsigned char* const (&dst)[NR], const int (&e)[NR], float* const (&scale)[NR], LAS unsigned char* scr, int lane) {
    f32x4 v[NR][2][4];
#pragma unroll
    for (int k = 0; k < NR; ++k)
#pragma unroll
        for (int i = 0; i < 2; ++i)
#pragma unroll
            for (int q = 0; q < 4; ++q) v[k][i][q] = *(const GAS f32x4*)(src[k] + i * 1024 + lane * 16 + 4 * q);
#pragma unroll
    for (int k = 0; k < NR; ++k) { float am = 0.f;
#pragma unroll
        for (int i = 0; i < 2; ++i)
#pragma unroll
            for (int q = 0; q < 4; ++q) am = fmaxf(am, fmaxf(fmaxf(fabsf(v[k][i][q].x), fabsf(v[k][i][q].y)), fmaxf(fabsf(v[k][i][q].z), fabsf(v[k][i][q].w))));
#pragma unroll
        for (int o = 1; o < 64; o <<= 1) am = fmaxf(am, shx(am, o, lane));
        const float inv = am > 0.f ? 6.0f / am : 0.f;
#pragma unroll
        for (int i = 0; i < 2; ++i) { unsigned w0 = 0, w1 = 0;
            w0 = __builtin_amdgcn_cvt_scalef32_pk_fp4_f32(w0, v[k][i][0].x * inv, v[k][i][0].y * inv, 1.0f, 0); w0 = __builtin_amdgcn_cvt_scalef32_pk_fp4_f32(w0, v[k][i][0].z * inv, v[k][i][0].w * inv, 1.0f, 1);
            w0 = __builtin_amdgcn_cvt_scalef32_pk_fp4_f32(w0, v[k][i][1].x * inv, v[k][i][1].y * inv, 1.0f, 2); w0 = __builtin_amdgcn_cvt_scalef32_pk_fp4_f32(w0, v[k][i][1].z * inv, v[k][i][1].w * inv, 1.0f, 3);
            w1 = __builtin_amdgcn_cvt_scalef32_pk_fp4_f32(w1, v[k][i][2].x * inv, v[k][i][2].y * inv, 1.0f, 0); w1 = __builtin_amdgcn_cvt_scalef32_pk_fp4_f32(w1, v[k][i][2].z * inv, v[k][i][2].w * inv, 1.0f, 1);
            w1 = __builtin_amdgcn_cvt_scalef32_pk_fp4_f32(w1, v[k][i][3].x * inv, v[k][i][3].y * inv, 1.0f, 2); w1 = __builtin_amdgcn_cvt_scalef32_pk_fp4_f32(w1, v[k][i][3].z * inv, v[k][i][3].w * inv, 1.0f, 3);
            *(LAS v4u*)(scr + lane * 16) = (v4u){w0 & 0x0f0f0f0fu, (w0 >> 4) & 0x0f0f0f0fu, w1 & 0x0f0f0f0fu, (w1 >> 4) & 0x0f0f0f0fu};
            const int jj = lane & 15, oo = 4 * (jj & 3) + (jj >> 2), pos = (oo & 8) + ((oo & 1) << 2) + ((oo >> 1) & 3);
            const LAS unsigned char* col = scr + (lane & 48) * 16 + pos;
            unsigned o0 = 0, o1 = 0;
#pragma unroll
            for (int n = 0; n < 8; ++n) { o0 |= (unsigned)col[n * 16] << (4 * n); o1 |= (unsigned)col[(n + 8) * 16] << (4 * n); }
            *(GAS v2u*)(dst[k] + (size_t)(i * 4 + (lane >> 4)) * (NEXP * 128) + (size_t)e[k] * 128 + jj * 8) = (v2u){o0, o1};
            asm volatile("s_waitcnt lgkmcnt(0)" ::: "memory"); }
        if (lane == 0) *(GAS float*)scale[k] = am * (1.0f / 6.0f); }
}

#define LN8_UNPACK(q_) {bflo((q_)[0]), bfhi((q_)[0]), bflo((q_)[1]), bfhi((q_)[1]), bflo((q_)[2]), bfhi((q_)[2]), bflo((q_)[3]), bfhi((q_)[3])}
template <int NR> __device__ __forceinline__ void ln_rows(const bf16* y, const float* g, const float* b, bf16* ob, unsigned char* o8h, unsigned char* o8, float* sx, int m0, int stride, int lane) {
    float v[NR][4][8];
#pragma unroll
    for (int k = 0; k < NR; ++k) { const GAS v4u* yr = (const GAS v4u*)(y + (size_t)(m0 + k * stride) * D) + lane; v4u w[4];
#pragma unroll
        for (int j = 0; j < 4; ++j) w[j] = yr[64 * j];
#pragma unroll
        for (int j = 0; j < 4; ++j) { const float f[8] = LN8_UNPACK(w[j]);
#pragma unroll
            for (int e = 0; e < 8; ++e) v[k][j][e] = f[e]; } }
    const GAS f32x4* g4 = (const GAS f32x4*)g + 2 * lane; const GAS f32x4* b4 = (const GAS f32x4*)b + 2 * lane;
#pragma unroll
    for (int k = 0; k < NR; ++k) { float s = 0.f;
#pragma unroll
        for (int j = 0; j < 4; ++j) s += ((v[k][j][0] + v[k][j][1]) + (v[k][j][2] + v[k][j][3])) + ((v[k][j][4] + v[k][j][5]) + (v[k][j][6] + v[k][j][7]));
        const float mean = wave_sum_l(s, lane) * (1.f / D); float s2 = 0.f;
#pragma unroll
        for (int j = 0; j < 4; ++j)
#pragma unroll
            for (int e = 0; e < 8; ++e) { v[k][j][e] -= mean; s2 += v[k][j][e] * v[k][j][e]; }
        const float rstd = 1.f / sqrtf(wave_sum_l(s2, lane) * (1.f / D) + LN_EPS);
        const size_t ro = (size_t)(m0 + k * stride) * D; float am = 0.f;
#pragma unroll
        for (int j = 0; j < 4; ++j) { const f32x4 ga = g4[128 * j], gb = g4[128 * j + 1], ba = b4[128 * j], bb = b4[128 * j + 1];
            const float gg[8] = {ga.x, ga.y, ga.z, ga.w, gb.x, gb.y, gb.z, gb.w}, be[8] = {ba.x, ba.y, ba.z, ba.w, bb.x, bb.y, bb.z, bb.w}; float o[8];
#pragma unroll
            for (int e = 0; e < 8; ++e) { o[e] = v[k][j][e] * rstd * gg[e] + be[e]; v[k][j][e] = o[e]; am = fmaxf(am, fabsf(o[e])); }
            ((GAS v4u*)(ob + ro) + lane)[64 * j] = (v4u){pk2(o[0], o[1]), pk2(o[2], o[3]), pk2(o[4], o[5]), pk2(o[6], o[7])};
            {
                unsigned hi = 0, lo = 0;
#define LN8_HI(e) hi = __builtin_amdgcn_cvt_scalef32_pk_fp4_f32(hi, o[2 * e] * X4_SCALE, o[2 * e + 1] * X4_SCALE, 1.0f, e)
#define LN8_LO(e) { const auto hv = __builtin_amdgcn_cvt_scalef32_pk_f32_fp4(hi, 1.0f, e); lo = __builtin_amdgcn_cvt_scalef32_pk_fp4_f32(lo, (o[2 * e] * X4_SCALE - hv[0]) * 4.0f, (o[2 * e + 1] * X4_SCALE - hv[1]) * 4.0f, 1.0f, e); }
                LN8_HI(0); LN8_HI(1); LN8_HI(2); LN8_HI(3); LN8_LO(0) LN8_LO(1) LN8_LO(2) LN8_LO(3)
                ((GAS unsigned*)(o8h + ro / 2) + lane)[64 * j] = hi; ((GAS unsigned*)(o8h + (size_t)M_TOK * (D / 2) + ro / 2) + lane)[64 * j] = lo; } }
        {
#pragma unroll
            for (int o2 = 1; o2 < 64; o2 <<= 1) am = fmaxf(am, shx(am, o2, lane));
            const float inv = am > 0.f ? 127.0f / am : 0.f;
#pragma unroll
            for (int j = 0; j < 4; ++j) ((GAS v2u*)(o8 + ro) + lane)[64 * j] = (v2u){pk4_i8c(v[k][j][0] * inv, v[k][j][1] * inv, v[k][j][2] * inv, v[k][j][3] * inv), pk4_i8c(v[k][j][4] * inv, v[k][j][5] * inv, v[k][j][6] * inv, v[k][j][7] * inv)};
            if (lane == 0) ((GAS float*)sx)[ro / D] = am * (1.0f / 127.0f); }
    }
}
template <int NR> __device__ __forceinline__ void rows_bf16_to_i8(const bf16* x, unsigned char* o8, float* sx, int m0, int stride, int lane) {
#pragma unroll
    for (int k = 0; k < NR; ++k) { const size_t ro = (size_t)(m0 + k * stride) * D; const GAS v2u* xr = (const GAS v2u*)(x + ro) + lane; f32x4 v[8]; float am = 0.f;
#pragma unroll
        for (int j = 0; j < 8; ++j) { const v2u w = xr[64 * j]; v[j] = (f32x4){bflo(w.x), bfhi(w.x), bflo(w.y), bfhi(w.y)};
            am = fmaxf(am, fmaxf(fmaxf(fabsf(v[j].x), fabsf(v[j].y)), fmaxf(fabsf(v[j].z), fabsf(v[j].w)))); }
#pragma unroll
        for (int o = 1; o < 64; o <<= 1) am = fmaxf(am, shx(am, o, lane));
        const float inv = am > 0.f ? 127.0f / am : 0.f;
#pragma unroll
        for (int j = 0; j < 8; ++j) ((GAS unsigned*)(o8 + ro) + lane)[64 * j] = pk4_i8c(v[j].x * inv, v[j].y * inv, v[j].z * inv, v[j].w * inv);
        if (lane == 0) ((GAS float*)sx)[m0 + k * stride] = am * (1.0f / 127.0f); }
}

__device__ __forceinline__ void ins16(float (&L)[16], float key) {
#pragma unroll
    for (int j = 15; j >= 1; --j) L[j] = __builtin_amdgcn_fmed3f(L[j - 1], L[j], key);
    L[0] = fmaxf(L[0], key);
}
#define FENCE16(L) do { _Pragma("unroll") for (int _j = 0; _j < 16; ++_j) asm("" : "+v"(L[_j])); } while (0)
__device__ __forceinline__ void topk_lane(const bf16* ST, int h, int t, int* eidx, float* gate) {
    const float NEG = -__builtin_inff();
    float L1[16], L2[16];
#pragma unroll
    for (int j = 0; j < 16; ++j) { L1[j] = NEG; L2[j] = NEG; }
    const GAS bf16* s1 = (const GAS bf16*)ST + (size_t)(h * 256) * M_TOK + t;
    const GAS bf16* s2 = s1 + (size_t)128 * M_TOK;
#pragma nounroll
    for (int n0 = 0; n0 < NKEYS; n0 += 32) {
        unsigned ca[32], cb[32];
#pragma unroll
        for (int q = 0; q < 32; ++q) { ca[q] = s1[(size_t)(n0 + q) * M_TOK]; cb[q] = s2[(size_t)(n0 + q) * M_TOK]; }
#pragma unroll
        for (int q = 0; q < 32; ++q) {
            const unsigned tag = (unsigned)(127 - n0 - q);
            const float ka = __builtin_bit_cast(float, (ca[q] << 16) | tag);
            const float kb = __builtin_bit_cast(float, (cb[q] << 16) | tag);
            ins16(L1, ka); ins16(L2, kb);
            FENCE16(L1); FENCE16(L2);
        }
    }
    unsigned long long p1lo = 0, p1hi = 0, p2lo = 0, p2hi = 0;
#pragma unroll
    for (int j = 0; j < 8; ++j) {
        p1lo |= (unsigned long long)(127u - (__builtin_bit_cast(unsigned, L1[j]) & 127u)) << (8 * j); p1hi |= (unsigned long long)(127u - (__builtin_bit_cast(unsigned, L1[j + 8]) & 127u)) << (8 * j);
        p2lo |= (unsigned long long)(127u - (__builtin_bit_cast(unsigned, L2[j]) & 127u)) << (8 * j); p2hi |= (unsigned long long)(127u - (__builtin_bit_cast(unsigned, L2[j + 8]) & 127u)) << (8 * j); }
    float T[16];
#pragma unroll
    for (int j = 0; j < 16; ++j) T[j] = NEG;
#pragma unroll
    for (int a = 0; a < 16; ++a)
#pragma unroll
        for (int b = 0; b < 16; ++b)
            if ((a + 1) * (b + 1) <= 16) { const float sm = L1[a] + L2[b];
                ins16(T, __builtin_bit_cast(float, (__builtin_bit_cast(unsigned, sm) & ~255u) | (unsigned)(255 - (a * 16 + b)))); FENCE16(T); }
    float e[16], sum = 0.f; int I[16];
#pragma unroll
    for (int j = 0; j < 16; ++j) { e[j] = __builtin_amdgcn_exp2f((T[j] - T[0]) * 1.4426950409f); sum += e[j];
        const unsigned code = 255u - (__builtin_bit_cast(unsigned, T[j]) & 255u); const unsigned a = code >> 4, b = code & 15u;
        const unsigned long long wa = (a & 8u) ? p1hi : p1lo, wb = (b & 8u) ? p2hi : p2lo;
        const unsigned ia = (unsigned)(wa >> ((a & 7u) * 8u)) & 127u, ib = (unsigned)(wb >> ((b & 7u) * 8u)) & 127u;
        I[j] = (int)(ia * NKEYS + ib); }
    const float inv = 1.0f / sum;
    GAS int* eo = (GAS int*)eidx + (size_t)t * NSEL + h * TOPK; GAS float* go = (GAS float*)gate + (size_t)t * NSEL + h * TOPK;
#pragma unroll
    for (int j = 0; j < 16; j += 4) { typedef int i32x4 __attribute__((ext_vector_type(4)));
        *(GAS i32x4*)(eo + j) = (i32x4){I[j], I[j + 1], I[j + 2], I[j + 3]}; *(GAS f32x4*)(go + j) = (f32x4){e[j] * inv, e[j + 1] * inv, e[j + 2] * inv, e[j + 3] * inv}; }
}

constexpr int CHUNK_STRIDE = NEXP * 128;
typedef float f32x2 __attribute__((ext_vector_type(2)));
typedef int i32x4 __attribute__((ext_vector_type(4)));
#define PIN8(a, b) asm volatile("" : "+v"(a[b]), "+v"(a[b + 1]), "+v"(a[b + 2]), "+v"(a[b + 3]), "+v"(a[b + 4]), "+v"(a[b + 5]), "+v"(a[b + 6]), "+v"(a[b + 7]) :: "memory")
__device__ __forceinline__ f32x2 shx2(f32x2 v, int m, int lane) { return (f32x2){shx(v.x, m, lane), shx(v.y, m, lane)}; }

#define GAT_FETCHV(dst, rs, voff, soff) dst = __builtin_bit_cast(v4u, __builtin_amdgcn_raw_buffer_load_b128(rs, (int)(voff), soff, 0))
template <int NR> __device__ __forceinline__ void ln_res_rows(const bf16* x, const bf16* o, const float* g, const float* b, float* of, bf16* ob, unsigned char* o8, float* sx, size_t ro0, size_t rstride, int lane) {
    float v[NR][4][8];
#pragma unroll
    for (int k = 0; k < NR; ++k) { const GAS v4u* xr = (const GAS v4u*)(x + ro0 + k * rstride) + lane; const GAS v4u* orr = (const GAS v4u*)(o + ro0 + k * rstride) + lane; v4u xw[4], ow[4];
#pragma unroll
        for (int j = 0; j < 4; ++j) { xw[j] = xr[64 * j]; ow[j] = orr[64 * j]; }
#pragma unroll
        for (int j = 0; j < 4; ++j) { const float xf[8] = LN8_UNPACK(xw[j]), of8[8] = LN8_UNPACK(ow[j]);
#pragma unroll
            for (int e = 0; e < 8; ++e) v[k][j][e] = xf[e] * ALPHA + of8[e]; } }
    const GAS f32x4* g4 = (const GAS f32x4*)g + 2 * lane; const GAS f32x4* b4 = (const GAS f32x4*)b + 2 * lane;
#pragma unroll
    for (int k = 0; k < NR; ++k) { float s = 0.f;
#pragma unroll
        for (int j = 0; j < 4; ++j) s += ((v[k][j][0] + v[k][j][1]) + (v[k][j][2] + v[k][j][3])) + ((v[k][j][4] + v[k][j][5]) + (v[k][j][6] + v[k][j][7]));
        const float mean = wave_sum_l(s, lane) * (1.f / D); float s2 = 0.f;
#pragma unroll
        for (int j = 0; j < 4; ++j)
#pragma unroll
            for (int e = 0; e < 8; ++e) { v[k][j][e] -= mean; s2 += v[k][j][e] * v[k][j][e]; }
        const float rstd = 1.f / sqrtf(wave_sum_l(s2, lane) * (1.f / D) + LN_EPS);
        const size_t ro = ro0 + k * rstride;
        float am = 0.f;
#pragma unroll
        for (int j = 0; j < 4; ++j) { const f32x4 ga = g4[128 * j], gb = g4[128 * j + 1], ba = b4[128 * j], bb = b4[128 * j + 1];
            const float gg[8] = {ga.x, ga.y, ga.z, ga.w, gb.x, gb.y, gb.z, gb.w}, be[8] = {ba.x, ba.y, ba.z, ba.w, bb.x, bb.y, bb.z, bb.w}; float q[8];
#pragma unroll
            for (int e = 0; e < 8; ++e) { q[e] = v[k][j][e] * rstd * gg[e] + be[e]; v[k][j][e] = q[e]; am = fmaxf(am, fabsf(q[e])); }
            if (of) { ((GAS f32x4*)(of + ro) + 2 * lane)[128 * j] = (f32x4){q[0], q[1], q[2], q[3]}; ((GAS f32x4*)(of + ro) + 2 * lane)[128 * j + 1] = (f32x4){q[4], q[5], q[6], q[7]}; }
            if (ob) ((GAS v4u*)(ob + ro) + lane)[64 * j] = (v4u){pk2(q[0], q[1]), pk2(q[2], q[3]), pk2(q[4], q[5]), pk2(q[6], q[7])}; }
        if (o8) {
#pragma unroll
            for (int o2 = 1; o2 < 64; o2 <<= 1) am = fmaxf(am, shx(am, o2, lane));
            const float inv = am > 0.f ? 127.0f / am : 0.f;
#pragma unroll
            for (int j = 0; j < 4; ++j) ((GAS v2u*)(o8 + ro) + lane)[64 * j] = (v2u){pk4_i8c(v[k][j][0] * inv, v[k][j][1] * inv, v[k][j][2] * inv, v[k][j][3] * inv), pk4_i8c(v[k][j][4] * inv, v[k][j][5] * inv, v[k][j][6] * inv, v[k][j][7] * inv)};
            if (lane == 0) ((GAS float*)sx)[ro / D] = am * (1.0f / 127.0f); }
    }
}
#if defined(GAT_PMASK)
#define GAT_PM(R) (rep + 1 < (R) ? (unsigned)GAT_PMASK : 0x3fffu)
#else
#define GAT_PM(R) 0xffffffffu
#endif
#define GAT_FETCH4(rs, voff, soff) __builtin_amdgcn_raw_buffer_load_b128(rs, (int)(voff), soff, 0)
#define GAT_ACC(c, d) c = __builtin_fmaf(d.x, wq.x, __builtin_fmaf(d.y, wq.y, __builtin_fmaf(d.z, wq.z, __builtin_fmaf(d.w, wq.w, c))))
#define GAT_A8(a4) __builtin_shufflevector(a4, a4, 0, 1, 2, 3, -1, -1, -1, -1)
__device__ __forceinline__ void gat_u_mfma(float (&ccur)[8], float (&cprev)[8], f32x4 (&dp)[2], i32x4 (&A)[16], const i32x4 b1h, const i32x4 b2h, const i32x4 b1l, const i32x4 b2l, const LAS unsigned* enx, __amdgpu_buffer_rsrc_t rs, int soffn,
                                           const unsigned pofs, const f32x4 wq, const int s127, const int s125, const unsigned pm = 0xffffffffu) {
    unsigned en0 = enx[0], en1 = enx[8];
    f32x4 d0 = dp[0], d1 = dp[1];
#pragma unroll
    for (int g = 0; g < 8; ++g) {
        const unsigned en2 = enx[((g + 2) & 7) * 8];
        f32x4 d = __builtin_amdgcn_mfma_scale_f32_16x16x128_f8f6f4(GAT_A8(A[2 * g]), GAT_A8(b1h), (f32x4){0.f, 0.f, 0.f, 0.f}, 4, 4, 0, s127, 0, s127);
        d = __builtin_amdgcn_mfma_scale_f32_16x16x128_f8f6f4(GAT_A8(A[2 * g + 1]), GAT_A8(b2h), d, 4, 4, 0, s127, 0, s127);
        d = __builtin_amdgcn_mfma_scale_f32_16x16x128_f8f6f4(GAT_A8(A[2 * g]), GAT_A8(b1l), d, 4, 4, 0, s127, 0, s125);
        d = __builtin_amdgcn_mfma_scale_f32_16x16x128_f8f6f4(GAT_A8(A[2 * g + 1]), GAT_A8(b2l), d, 4, 4, 0, s127, 0, s125);
        A[2 * g] = __builtin_bit_cast(i32x4, GAT_FETCH4(rs, ((en0 & 0xffffu & pm) << 7) + pofs, soffn)); A[2 * g + 1] = __builtin_bit_cast(i32x4, GAT_FETCH4(rs, (((en0 >> 16) & pm) << 7) + pofs, soffn));
        if (g == 0) GAT_ACC(cprev[6], d0); else if (g == 1) GAT_ACC(cprev[7], d0); else GAT_ACC(ccur[g - 2], d0);
        d0 = d1; d1 = d; en0 = en1; en1 = en2;
        __builtin_amdgcn_sched_barrier(0);
    }
    dp[0] = d0; dp[1] = d1;
}
__device__ __forceinline__ float quad_sum(float v) {
    v += __builtin_bit_cast(float, __builtin_amdgcn_update_dpp(0, __builtin_bit_cast(int, v), 0xB1, 0xf, 0xf, false));
    v += __builtin_bit_cast(float, __builtin_amdgcn_update_dpp(0, __builtin_bit_cast(int, v), 0x4E, 0xf, 0xf, false));
    return v;
}
__device__ __forceinline__ f32x2 gat_v_step8(const float (&act)[16], float (&actn)[16], const LAS float* apn, v4u (&w)[16], const LAS unsigned* enx, __amdgpu_buffer_rsrc_t rs, int soffn, const unsigned jofs, int lane, const unsigned pm = 0xffffffffu) {
    f32x2 acc[8];
#pragma unroll
    for (int p = 0; p < 8; ++p) acc[p] = (f32x2){0.f, 0.f};
    v4u e0 = *(const LAS v4u*)(enx), e1 = e0;
#pragma unroll
    for (int i = 0; i < 16; ++i) { const f32x2 aa = {act[i], act[i]};
        if ((i & 3) == 0 && i < 12) e1 = *(const LAS v4u*)(enx + i + 4);
        if ((i & 3) == 1) { const f32x4 a4 = *(const LAS f32x4*)(apn + (i >> 2) * 4); actn[(i >> 2) * 4] = a4.x; actn[(i >> 2) * 4 + 1] = a4.y; actn[(i >> 2) * 4 + 2] = a4.z; actn[(i >> 2) * 4 + 3] = a4.w; }
#pragma unroll
        for (int c = 0; c < 4; ++c) { const f32x2 lo = __builtin_amdgcn_cvt_pk_f32_fp8((int)w[i][c], false), hi = __builtin_amdgcn_cvt_pk_f32_fp8((int)w[i][c], true);
            acc[2 * c] = __builtin_elementwise_fma(lo, aa, acc[2 * c]); acc[2 * c + 1] = __builtin_elementwise_fma(hi, aa, acc[2 * c + 1]); }
        asm volatile("" : "+v"(acc[0]), "+v"(acc[1]), "+v"(acc[2]), "+v"(acc[3]), "+v"(acc[4]), "+v"(acc[5]), "+v"(acc[6]), "+v"(acc[7]) :: "memory");
        GAT_FETCHV(w[i], rs, ((e0[i & 3] & pm) << 7) + jofs, soffn);
        if ((i & 3) == 3) e0 = e1;
        __builtin_amdgcn_sched_barrier(0);
    }
    const bool b3 = lane & 8, b4 = lane & 16, b5 = lane & 32;
    f32x2 ka[4], kb[2];
#pragma unroll
    for (int i = 0; i < 4; ++i) { const f32x2 keep = b3 ? acc[4 + i] : acc[i], send = b3 ? acc[i] : acc[4 + i]; ka[i] = keep + shx2(send, 8, lane); }
#pragma unroll
    for (int i = 0; i < 2; ++i) { const f32x2 keep = b4 ? ka[2 + i] : ka[i], send = b4 ? ka[i] : ka[2 + i]; kb[i] = keep + shx2(send, 16, lane); }
    const f32x2 keep = b5 ? kb[1] : kb[0], send = b5 ? kb[0] : kb[1];
    return keep + shx2(send, 32, lane);
}
__device__ __forceinline__ void peer_chunked(const unsigned char* utab, const unsigned char* vtab, const float* su, const float* sv, const int* eidx, const float* gate, const bf16* xres, const unsigned char* x8h,
                                             float* ybuf, const float* lng, const float* lnb, float* of, bf16* ob, unsigned char* o8, float* sx8, int gw, int NGW, LAS unsigned* vol, LAS unsigned* vids, const unsigned emask = 0x3fffu) {
    const __amdgpu_buffer_rsrc_t rsxh = __builtin_amdgcn_make_buffer_rsrc((void*)x8h, (short)0, M_TOK * (D / 2), 0x00020000), rsxl = __builtin_amdgcn_make_buffer_rsrc((void*)(x8h + (size_t)M_TOK * (D / 2)), (short)0, M_TOK * (D / 2), 0x00020000);
    const __amdgpu_buffer_rsrc_t rsy = __builtin_amdgcn_make_buffer_rsrc((void*)ybuf, (short)0, M_TOK * D * 2, 0x00020000);
    const __amdgpu_buffer_rsrc_t rsu = __builtin_amdgcn_make_buffer_rsrc((void*)utab, (short)0, NEXP * (D / 2), 0x00020000), rsv = __builtin_amdgcn_make_buffer_rsrc((void*)vtab, (short)0, NEXP * (D / 2), 0x00020000);
    LAS unsigned* et = vids;
    {   int zz = 0; asm volatile("" : "+s"(zz));
        const int lane = __builtin_amdgcn_mbcnt_hi(-1, __builtin_amdgcn_mbcnt_lo(-1, zz));
#pragma unroll
        for (int q = 0; q < 8; ++q) { const v2u v = *(const GAS v2u*)(eidx + (size_t)(gw + q * NGW) * NSEL + 2 * lane); et[q * 64 + lane] = (v.x & emask) | ((v.y & emask) << 16); }
        asm volatile("s_waitcnt lgkmcnt(0)" ::: "memory");
    }
    float osc[8];
#ifdef GAT_UREP
#pragma nounroll
    for (int rep = 0; rep < GAT_UREP; ++rep)
#endif
    {   int zz = 0; asm volatile("" : "+s"(zz));
        const int lu = __builtin_amdgcn_mbcnt_hi(-1, __builtin_amdgcn_mbcnt_lo(-1, zz));
        const int kbu = lu >> 4, q4 = lu & 3;
        const LAS unsigned* eu = et + 2 * ((lu >> 2) & 3) + (kbu >> 1);
        {   LAS v4u* xs = (LAS v4u*)vol;
#pragma unroll
            for (int q = 0; q < 8; ++q) { const v4u h4 = *(const GAS v4u*)(x8h + (size_t)(gw + q * NGW) * (D / 2) + lu * 16), l4 = *(const GAS v4u*)(x8h + (size_t)M_TOK * (D / 2) + (size_t)(gw + q * NGW) * (D / 2) + lu * 16);
                xs[q * 128 + lu] = h4; xs[q * 128 + 64 + lu] = l4; }
            asm volatile("s_waitcnt lgkmcnt(0)" ::: "memory"); }
        const unsigned pofs = (unsigned)(4 * (kbu & 1) + q4) * 16u;
        const bool bon = (kbu >> 1) == ((lu >> 3) & 1);
        const int m1 = (bon && ((lu >> 2) & 1) == 0) ? -1 : 0, m2 = (bon && ((lu >> 2) & 1) == 1) ? -1 : 0;
        int s127 = 127, s125 = 125; asm volatile("" : "+v"(s127), "+v"(s125));
        f32x4 wq = {q4 == 0 ? 1.f : 0.f, q4 == 1 ? 1.f : 0.f, q4 == 2 ? 1.f : 0.f, q4 == 3 ? 1.f : 0.f}; asm volatile("" : "+v"(wq));
        float cacc[8][8]; f32x4 dp[2] = {{0.f, 0.f, 0.f, 0.f}, {0.f, 0.f, 0.f, 0.f}};
#pragma unroll
        for (int q = 0; q < 8; ++q)
#pragma unroll
            for (int g = 0; g < 8; ++g) cacc[q][g] = 0.f;
        i32x4 A[16], xh0, xl0, xh1, xl1;
#define GAT_XLOAD8(dh, dl, q, cc) do { const LAS i32x4* xp_ = (const LAS i32x4*)((const LAS unsigned char*)vol + (q) * 2048 + (cc) * 128 + pofs); dh = xp_[0]; dl = xp_[64]; } while (0)
#define GAT_BUILD(b, r, m) const i32x4 b = {r[0] & m, r[1] & m, r[2] & m, r[3] & m}
#define GAT_USTEP(q, qn, cc, xhc, xlc, xhn, xln) { GAT_XLOAD8(xhn, xln, qn, cc); GAT_BUILD(b1h, xhc, m1); GAT_BUILD(b2h, xhc, m2); GAT_BUILD(b1l, xlc, m1); GAT_BUILD(b2l, xlc, m2); \
            gat_u_mfma(cacc[q], cacc[((q) + 7) & 7], dp, A, b1h, b2h, b1l, b2l, eu + (qn) * 64, rsu, (cc) * CHUNK_STRIDE, pofs, wq, s127, s125, GAT_PM(GAT_UREP)); }
        GAT_XLOAD8(xh0, xl0, 0, 0);
#pragma unroll
        for (int g = 0; g < 8; ++g) { const unsigned en = eu[g * 8];
            A[2 * g] = __builtin_bit_cast(i32x4, GAT_FETCH4(rsu, ((en & 0xffffu) << 7) + pofs, 0)); A[2 * g + 1] = __builtin_bit_cast(i32x4, GAT_FETCH4(rsu, ((en >> 16) << 7) + pofs, 0)); }
#pragma nounroll
        for (int c = 0; c < 8; ++c) {
            const int cn = c < 7 ? c + 1 : 7;
            GAT_USTEP(0, 1, c, xh0, xl0, xh1, xl1) GAT_USTEP(1, 2, c, xh1, xl1, xh0, xl0) GAT_USTEP(2, 3, c, xh0, xl0, xh1, xl1) GAT_USTEP(3, 4, c, xh1, xl1, xh0, xl0)
            GAT_USTEP(4, 5, c, xh0, xl0, xh1, xl1) GAT_USTEP(5, 6, c, xh1, xl1, xh0, xl0) GAT_USTEP(6, 7, c, xh0, xl0, xh1, xl1) GAT_USTEP(7, 0, cn, xh1, xl1, xh0, xl0)
        }
        GAT_ACC(cacc[7][6], dp[0]); GAT_ACC(cacc[7][7], dp[1]);
        const int ei = lu >> 2;
        LAS unsigned char* codes = (LAS unsigned char*)vol + 4096;
#pragma unroll
        for (int q = 0; q < 8; ++q) {
            float pe = 0.f, po = 0.f;
#pragma unroll
            for (int g = 0; g < 8; ++g) { const float s = quad_sum(cacc[q][g]);
                if (g & 1) po = (q4 == (g >> 1)) ? s : po; else pe = (q4 == (g >> 1)) ? s : pe; }
            const int pb = (2 * q4) * 16 + ei;
            const unsigned e0 = ((const LAS unsigned short*)et)[q * 128 + pb], e1 = ((const LAS unsigned short*)et)[q * 128 + pb + 16];
            const GAS float* gp = (const GAS float*)(gate + (size_t)(gw + q * NGW) * NSEL + pb);
            const float g0 = gp[0], g1 = gp[16];
            const float a0 = g0 * pg8::gelu_tanh(pe * (((const GAS float*)su)[e0] * (1.0f / X4_SCALE))) * ((const GAS float*)sv)[e0], a1 = g1 * pg8::gelu_tanh(po * (((const GAS float*)su)[e1] * (1.0f / X4_SCALE))) * ((const GAS float*)sv)[e1];
            float mx = fmaxf(fabsf(a0), fabsf(a1));
#pragma unroll
            for (int o = 1; o < 64; o <<= 1) mx = fmaxf(mx, shx(mx, o, lu));
            const float sc = mx > 0.f ? 6.0f / mx : 0.f;
            osc[q] = __builtin_bit_cast(float, __builtin_amdgcn_readfirstlane(__builtin_bit_cast(int, mx * (1.0f / 6.0f))));
            const float t0 = a0 * sc, t1 = a1 * sc;
            const unsigned ch = __builtin_amdgcn_cvt_scalef32_pk_fp4_f32(0u, t0, t1, 1.0f, 0); const auto vh = __builtin_amdgcn_cvt_scalef32_pk_f32_fp4(ch, 1.0f, 0);
            const float r0 = (t0 - vh[0]) * 4.0f, r1 = (t1 - vh[1]) * 4.0f;
            const unsigned cm = __builtin_amdgcn_cvt_scalef32_pk_fp4_f32(0u, r0, r1, 1.0f, 0); const auto vm = __builtin_amdgcn_cvt_scalef32_pk_f32_fp4(cm, 1.0f, 0);
            const unsigned cl = __builtin_amdgcn_cvt_scalef32_pk_fp4_f32(0u, (r0 - vm[0]) * 4.0f, (r1 - vm[1]) * 4.0f, 1.0f, 0);
            LAS unsigned char* cq = codes + q * 384 + pb;
            cq[0] = (unsigned char)(ch & 15u); cq[16] = (unsigned char)((ch >> 4) & 15u); cq[128] = (unsigned char)(cm & 15u); cq[144] = (unsigned char)((cm >> 4) & 15u);
            cq[256] = (unsigned char)(cl & 15u); cq[272] = (unsigned char)((cl >> 4) & 15u);
        }
        {   const int qq = lu >> 3, r8 = lu & 7; unsigned pk[8];
#pragma unroll
            for (int k = 0; k < 8; ++k) pk[k] = (unsigned)((const LAS unsigned short*)et)[qq * 128 + 16 * k + r8] | ((unsigned)((const LAS unsigned short*)et)[qq * 128 + 16 * k + 8 + r8] << 16);
            asm volatile("s_waitcnt lgkmcnt(0)" : "+v"(pk[0]), "+v"(pk[1]), "+v"(pk[2]), "+v"(pk[3]), "+v"(pk[4]), "+v"(pk[5]), "+v"(pk[6]), "+v"(pk[7]) :: "memory");
            *(LAS v4u*)(vids + lu * 8) = (v4u){pk[0], pk[1], pk[2], pk[3]}; *(LAS v4u*)(vids + lu * 8 + 4) = (v4u){pk[4], pk[5], pk[6], pk[7]}; }
        {   const int mrow = lu & 15, kbv = lu >> 4;
            const LAS unsigned char* cb = (const LAS unsigned char*)vol + 4096 + (mrow < 3 ? mrow : 2) * 128 + kbv * 32;
#pragma unroll
            for (int q = 0; q < 8; ++q) { const v4u c0 = *(const LAS v4u*)(cb + q * 384), c1 = *(const LAS v4u*)(cb + q * 384 + 16); unsigned h[8];
#pragma unroll
                for (int k = 0; k < 8; ++k) { const unsigned w = k < 4 ? c0[k] : c1[k - 4]; const unsigned t = (w | (w >> 4)) & 0x00ff00ffu; h[k] = (t | (t >> 8)) & 0xffffu; }
                *(LAS v4u*)((LAS unsigned char*)vids + 2048 + q * 192 + (mrow < 3 ? mrow : 2) * 64 + kbv * 16) = (v4u){h[0] | (h[1] << 16), h[2] | (h[3] << 16), h[4] | (h[5] << 16), h[6] | (h[7] << 16)}; }
        }
        __builtin_amdgcn_sched_barrier(0);
    }
#ifdef GAT_VREP
#pragma nounroll
    for (int rep = 0; rep < GAT_VREP; ++rep)
#endif
    {   int zz = 0; asm volatile("" : "+s"(zz));
        const int lv = __builtin_amdgcn_mbcnt_hi(-1, __builtin_amdgcn_mbcnt_lo(-1, zz));
        const int r8 = lv >> 3, kbv = lv >> 4, mrow = lv & 15;
        const unsigned pofsE = 16u * (unsigned)((lv & 7) ^ (r8 >> 1)), pofsO = pofsE ^ 64u;
        const unsigned ringa = (unsigned)(size_t)(LAS unsigned char*)vol;
        const unsigned idsa = (unsigned)(size_t)(LAS unsigned char*)vids + (unsigned)r8 * 32u;
        const unsigned apx = (((ringa + (unsigned)mrow * 128u) | (16u * (unsigned)(mrow >> 1))) ^ (16u * (unsigned)(kbv >> 1))) + 8u * (unsigned)(kbv & 1);
        const int term = mrow & 3;
        const unsigned keep = (term < 3 && (mrow >> 2) == kbv) ? 0xffffffffu : 0u;
        const unsigned acta = (unsigned)(size_t)(LAS unsigned char*)vids + 2048u + (unsigned)(term < 3 ? term : 2) * 64u;
        int sA = 127 - 2 * (term < 2 ? term : 2), s127 = 127; asm volatile("" : "+v"(sA), "+v"(s127));
        asm volatile("s_waitcnt lgkmcnt(0)" ::: "memory");
        __builtin_amdgcn_sched_barrier(0);
        v4u idn0, idn1;
#define GATV_IDS(d0, d1, q) asm volatile("ds_read_b128 %0, %2\n\tds_read_b128 %1, %2 offset:16\n\ts_waitcnt lgkmcnt(0)" : "=&v"(d0), "=&v"(d1) : "v"(idsa + (unsigned)(q) * 256u) : "memory")
#define GATV_ACT(d, q) do { asm volatile("ds_read_b128 %0, %4\n\tds_read_b128 %1, %4 offset:16\n\tds_read_b128 %2, %4 offset:32\n\tds_read_b128 %3, %4 offset:48\n\ts_waitcnt lgkmcnt(0)" : "=&v"(d[0]), "=&v"(d[1]), "=&v"(d[2]), "=&v"(d[3]) : "v"(acta + (unsigned)(q) * 192u) : "memory"); \
            _Pragma("unroll") for (int u_ = 0; u_ < 4; ++u_) d[u_] = (v4u){d[u_].x & keep, d[u_].y & keep, d[u_].z & keep, d[u_].w & keep}; } while (0)
#define GATV_ID(d0, d1, k) ((((k) < 8 ? d0[(k) >> 1] : d1[((k) - 8) >> 1]) >> (16 * ((k) & 1))) & 0xffffu)
#define GATV_DMA(u, d0, d1, soff) do { _Pragma("unroll") for (int w_ = 0; w_ < 4; ++w_) \
            __builtin_amdgcn_raw_ptr_buffer_load_lds(rsv, (LAS void*)((LAS unsigned char*)vol + (u) * 4096 + w_ * 1024), 16, (int)(((GATV_ID(d0, d1, (u) * 4 + w_) & GAT_PM(GAT_VREP)) << 7) + ((w_ & 1) ? pofsO : pofsE)), soff, 0, 0); } while (0)
#define GATV_TR(dst, areg, off) asm volatile("ds_read_b64_tr_b4 %0, %1 offset:%2" : "=v"(dst) : "v"(areg), "i"(off))
#define GATV_RD(r, u, g) do { unsigned a0_ = apx ^ (32u * (g)); asm volatile("" : "+v"(a0_));        \
            GATV_TR(r[0], a0_, (u) * 4096); GATV_TR(r[1], a0_, (u) * 4096 + 2048); } while (0)
#define GATV_WAIT(r, n) asm volatile("s_waitcnt lgkmcnt(" #n ")" : "+v"(r[0]), "+v"(r[1]) :: "memory")
#define GATV_MM(r, u, g, au) do { const i32x4 b_ = {(int)r[0].x, (int)r[0].y, (int)r[1].x, (int)r[1].y}; \
            acc[g] = __builtin_amdgcn_mfma_scale_f32_16x16x128_f8f6f4(GAT_A8(au), GAT_A8(b_), (u) == 0 ? (f32x4){0.f, 0.f, 0.f, 0.f} : acc[g], 4, 4, 0, sA, 0, s127); } while (0)
#define GATV_UNIT(u, aq, d0, d1, soffn) { asm volatile("s_waitcnt vmcnt(12)" ::: "memory"); \
            GATV_RD(ra, u, 0); GATV_RD(rb, u, 1); GATV_RD(rc, u, 2); GATV_RD(rd, u, 3); const i32x4 au_ = {(int)aq[u].x, (int)aq[u].y, (int)aq[u].z, (int)aq[u].w}; \
            GATV_WAIT(ra, 6); GATV_MM(ra, u, 0, au_); GATV_WAIT(rb, 4); GATV_MM(rb, u, 1, au_); GATV_WAIT(rc, 2); GATV_MM(rc, u, 2, au_); GATV_WAIT(rd, 0); GATV_MM(rd, u, 3, au_); \
            __builtin_amdgcn_sched_barrier(0); GATV_DMA(u, d0, d1, soffn); __builtin_amdgcn_sched_barrier(0); }
#define GATV_STEP(q, qn, cc, ccn, in0, in1) { GATV_IDS(in0, in1, qn); v4u aq_[4]; GATV_ACT(aq_, q); \
            GATV_UNIT(0, aq_, in0, in1, (ccn) * CHUNK_STRIDE) GATV_UNIT(1, aq_, in0, in1, (ccn) * CHUNK_STRIDE) GATV_UNIT(2, aq_, in0, in1, (ccn) * CHUNK_STRIDE) GATV_UNIT(3, aq_, in0, in1, (ccn) * CHUNK_STRIDE) \
            { float o_[4]; _Pragma("unroll") for (int g_ = 0; g_ < 4; ++g_) o_[g_] = ((acc[g_].x + acc[g_].y) + acc[g_].z) * osc[q]; \
              __builtin_amdgcn_raw_buffer_store_b64((v2u){pg8::cvt_pk_bf16(o_[0], o_[1]), pg8::cvt_pk_bf16(o_[2], o_[3])}, rsy, sto, (gw + (q) * NGW) * (D * 2) + (cc) * 512, 0); } \
            __builtin_amdgcn_sched_barrier(0); }
        f32x4 acc[4]; v2u ra[2], rb[2], rc[2], rd[2];
        const int sto = (lv & 15) * 32 + kbv * 8;
        GATV_IDS(idn0, idn1, 0);
        GATV_DMA(0, idn0, idn1, 0); GATV_DMA(1, idn0, idn1, 0); GATV_DMA(2, idn0, idn1, 0); GATV_DMA(3, idn0, idn1, 0);
#pragma nounroll
        for (int c = 0; c < 8; ++c) {
            const int cn = c < 7 ? c + 1 : 7;
            GATV_STEP(0, 1, c, c, idn0, idn1) GATV_STEP(1, 2, c, c, idn0, idn1) GATV_STEP(2, 3, c, c, idn0, idn1) GATV_STEP(3, 4, c, c, idn0, idn1)
            GATV_STEP(4, 5, c, c, idn0, idn1) GATV_STEP(5, 6, c, c, idn0, idn1) GATV_STEP(6, 7, c, c, idn0, idn1) GATV_STEP(7, 0, c, cn, idn0, idn1)
        }
    }
    asm volatile("s_waitcnt vmcnt(0)" ::: "memory");
    __builtin_amdgcn_fence(__ATOMIC_ACQUIRE, "agent");
#pragma nounroll
    for (int k = 0; k < 2; ++k) { int zz = 0; asm volatile("" : "+s"(zz));
        const int ll = __builtin_amdgcn_mbcnt_hi(-1, __builtin_amdgcn_mbcnt_lo(-1, zz));
        ln_res_rows<4>(xres, (const bf16*)ybuf, lng, lnb, of, ob, o8, sx8, (size_t)(gw + 4 * k * NGW) * D, (size_t)NGW * D, ll); }
}

template <int W> __device__ __forceinline__ void pool_item(const GAS v4u* hp, GAS v4u* op, int pos0) {
    constexpr int NR = 7 + W;
    v4u r[NR];
    const bool head = pos0 == 0;
#pragma unroll
    for (int k = 0; k < NR; ++k) { const int rel = k - (W - 1);
        const bool ok = rel >= 0 || (!head && (pos0 + rel >= 0));
        r[k] = ok ? hp[(long)rel * (D / 8)] : (v4u){0u, 0u, 0u, 0u}; }
    float run[8];
#pragma unroll
    for (int e = 0; e < 8; ++e) run[e] = 0.f;
#pragma unroll
    for (int k = 0; k < W - 1; ++k) { run[0] += bflo(r[k].x); run[1] += bfhi(r[k].x); run[2] += bflo(r[k].y); run[3] += bfhi(r[k].y); run[4] += bflo(r[k].z); run[5] += bfhi(r[k].z); run[6] += bflo(r[k].w); run[7] += bfhi(r[k].w); }
#pragma unroll
    for (int i = 0; i < 8; ++i) { const v4u c = r[W - 1 + i];
        const float cv[8] = {bflo(c.x), bfhi(c.x), bflo(c.y), bfhi(c.y), bflo(c.z), bfhi(c.z), bflo(c.w), bfhi(c.w)};
#pragma unroll
        for (int e = 0; e < 8; ++e) run[e] += cv[e];
        const int pos = pos0 + i; const int cnt = pos + 1 < W ? pos + 1 : W; const float ic = 1.0f / (float)cnt;
        v4u o; o.x = pk2(run[0] * ic - cv[0], run[1] * ic - cv[1]); o.y = pk2(run[2] * ic - cv[2], run[3] * ic - cv[3]); o.z = pk2(run[4] * ic - cv[4], run[5] * ic - cv[5]); o.w = pk2(run[6] * ic - cv[6], run[7] * ic - cv[7]);
        op[(long)i * (D / 8)] = o;
        const v4u d = r[i];
        run[0] -= bflo(d.x); run[1] -= bfhi(d.x); run[2] -= bflo(d.y); run[3] -= bfhi(d.y); run[4] -= bflo(d.z); run[5] -= bfhi(d.z); run[6] -= bflo(d.w); run[7] -= bfhi(d.w); }
}

#ifndef PHMASK
#define PHMASK 0xFFFFFFFFu
#endif
#define PHON(k) ((PHMASK >> (k)) & 1u)
#define x_in KARG(const float*, 0)
#define a_w_in KARG(const float*, 8)
#define a_b_in KARG(const float*, 16)
#define a_v_g KARG(const float*, 24)
#define a_v_b KARG(const float*, 32)
#define a_w_s KARG(const float*, 40)
#define a_b_s KARG(const float*, 48)
#define a_w_out KARG(const float*, 56)
#define b_w_in KARG(const float*, 64)
#define b_w_grp KARG(const float*, 72)
#define b_b_grp KARG(const float*, 80)
#define b_scale KARG(const float*, 88)
#define b_w_out KARG(const float*, 96)
#define ln_mix_g KARG(const float*, 104)
#define ln_mix_b KARG(const float*, 112)
#define ln_ffn_g KARG(const float*, 120)
#define ln_ffn_b KARG(const float*, 128)
#define peer_wq KARG(const float*, 136)
#define peer_sk KARG(const float*, 144)
#define peer_u KARG(const float*, 152)
#define peer_v KARG(const float*, 160)
#define W1I ((unsigned char*)(ws + WS_W1T))
#define XI0 ((unsigned char*)(ws + WS_XF))
#define SX0 ((float*)(ws + WS_SX0))
#define W2F ((unsigned char*)(ws + WS_W2T))
#define GF ((unsigned char*)(ws + WS_X1))
#define BINI ((unsigned char*)(ws + WS_BINT))
#define BOUTF ((unsigned char*)(ws + WS_BOUTT))
#define MIXED8 ((unsigned char*)(ws + WS_MIXED))
#define WQB ((bf16*)(ws + WS_WQT))
#define WQS ((bf16*)(ws + WS_WQS))
#define WQSI ((unsigned char*)(ws + WS_WQT))
#define SW ((float*)(ws + WS_SV + 131072))
#define BGT ((bf16*)(ws + WS_BGT))
#define BD ((bf16*)(ws + WS_BD))
#define BDSK ((bf16*)(ws + WS_BDSK))
#define XB ((bf16*)(ws + WS_XB))
#define UT ((unsigned char*)(ws + WS_UT))
#define SU ((float*)(ws + WS_SU))
#define SV ((float*)(ws + WS_SV))
#define VTAB ((unsigned char*)(ws + WS_VTAB))
#define UG ((bf16*)(ws + WS_UG))
#define ST ((float*)(ws + WS_ST))
#define POOL ((bf16*)(ws + WS_POOL))
#define MIXED ((bf16*)(ws + WS_MIXED))
#define VT ((bf16*)(ws + WS_VT))
#define Q ((bf16*)(ws + WS_Q))
#define X8H ((unsigned char*)(ws + WS_Q))
#define H ((bf16*)(ws + WS_H))
#define Y ((float*)(ws + WS_Y))
#define X1 ((float*)(ws + WS_X1))
#define EIDX ((int*)(ws + WS_EIDX))
#define GATE ((float*)(ws + WS_GATE))
struct Args { const float* in[21]; float* out; unsigned char* ws; int ph_lo, ph_hi; };
__global__ void __launch_bounds__(NTHREADS, 2) mega_fwd(Args args) {
    extern __shared__ __attribute__((aligned(16))) unsigned char lds_raw[];
    LAS unsigned char* lds = (LAS unsigned char*)lds_raw;
    volatile LAS unsigned* MISC = (volatile LAS unsigned*)(lds + MISC_OFF);
    typedef const char __attribute__((address_space(4)))* kap_t;
#define KARG(T, off) (*(T const __attribute__((address_space(4)))*)(ka + (off)))
#define PH_BEGIN kap_t ka = (kap_t)__builtin_amdgcn_kernarg_segment_ptr(); asm volatile("" : "+s"(ka)); unsigned char* ws = KARG(unsigned char*, 176); asm volatile("" : "+s"(ws));
#define OUT_PTR KARG(float*, 168)
#define IDX_BEGIN int bx = blockIdx.x, G = gridDim.x, wave = wave0, zero = 0; asm volatile("" : "+s"(bx), "+s"(G), "+s"(wave), "+s"(zero)); \
        const int lane = __builtin_amdgcn_mbcnt_hi(-1, __builtin_amdgcn_mbcnt_lo(-1, zero)), tid = wave * 64 + lane; \
        const int vcu = (G % 8 == 0) ? (bx % 8) * (G / 8) + bx / 8 : bx; const int gw = vcu * NWAVES + wave, NGW = G * NWAVES; (void)tid; (void)gw; (void)NGW; (void)vcu; (void)lane;
    for (int u = threadIdx.x; u < (LDS_BYTES - LDSCTL_OFF) / 4; u += NTHREADS) ((LAS unsigned*)(lds + LDSCTL_OFF))[u] = 0u;
    __syncthreads();
    int lo, hi; unsigned xcc; const int wave0 = __builtin_amdgcn_readfirstlane(threadIdx.x >> 6);
    { PH_BEGIN; lo = KARG(int, 184); hi = KARG(int, 188);
      xcc = xb_xcc_id();
      if (!MK_PER_PHASE && threadIdx.x == 0) (void)xb_add((unsigned*)(ws + WS_CTL) + CW_BAR + XB_XCNT(xcc), 1u); }
#pragma nounroll
    for (int ph = lo; ph < hi; ++ph) {
        const int ly = ph >= 13 ? 1 : 0;
        const int pk = ph >= 17 ? 14 : (ph >= 13 ? ph - 8 : ph);
#ifdef RPT_MASK
        for (int rep = 0; rep < (((RPT_MASK >> ph) & 1u) ? 2 : 1); ++rep)
#endif
        switch (pk) {
        case 0: if (PHON(0)) { PH_BEGIN; IDX_BEGIN;
            LAS float* scr = (LAS float*)(lds + RING_OFF + wave * 16384);
            constexpr int I_W1 = (D / 64) * (FFA / 32), I_W2 = (HA / 64) * (D / 32), I_SQ = (D / 64) * (D / 32), I_G = (512 / 64) * (512 / 32);
            constexpr int NITEMS = I_W1 + I_W2 + 2 * I_SQ + 4 * I_G;
            for (int it = gw; it < NITEMS; it += NGW) {
                int r = it;
                if (r < I_W1) { p0_transpose_item8<true>(a_w_in, D, FFA, W1I, W1_SCALE, scr, r, lane); continue; } r -= I_W1;
                if (r < I_W2) { p0_transpose_item8<false>(a_w_out, HA, D, W2F, W2_SCALE, scr, r, lane); continue; } r -= I_W2;
                if (r < I_SQ) { p0_transpose_item8<true>(b_w_in, D, D, BINI, W1_SCALE, scr, r, lane); continue; } r -= I_SQ;
                if (r < I_SQ) { p0_transpose_item8<false>(b_w_out, D, D, BOUTF, W2_SCALE, scr, r, lane); continue; } r -= I_SQ;
                { const int g = r / I_G; p0_transpose_item(b_w_grp + (size_t)g * 512 * 512, 512, 512, BGT + (size_t)g * 512 * 512, scr, r % I_G, lane); }
            }
            for (int m = gw; m < M_TOK; m += 4 * NGW) rows_to_i8<4>(x_in, XI0, SX0, m, NGW, lane);
            p0_convert(peer_wq, WQB, 2 * D * D / 512, gw, NGW, lane);
            for (int r = gw; r < 2 * NEXP; r += 2 * NGW) { const int r1 = r + NGW, la = r >= NEXP ? 1 : 0, lb = r1 >= NEXP ? 1 : 0;
                const float* const s2[2] = {peer_u + (size_t)r * D, peer_u + (size_t)r1 * D}; unsigned char* const d2[2] = {UT + (size_t)la * NEXP * (D / 2), UT + (size_t)lb * NEXP * (D / 2)};
                const int e2[2] = {r - la * NEXP, r1 - lb * NEXP}; float* const c2[2] = {SU + r, SU + r1};
                p0_row_fp4<2>(s2, d2, e2, c2, lane); }
            for (int r = gw; r < 2 * NEXP; r += 2 * NGW) { const int r1 = r + NGW, la = r >= NEXP ? 1 : 0, lb = r1 >= NEXP ? 1 : 0;
                const float* const s2[2] = {peer_v + (size_t)r * D, peer_v + (size_t)r1 * D}; unsigned char* const d2[2] = {VTAB + (size_t)la * NEXP * (D / 2), VTAB + (size_t)lb * NEXP * (D / 2)};
                const int e2[2] = {r - la * NEXP, r1 - lb * NEXP}; float* const c2[2] = {SV + r, SV + r1};
                p0_row_fp4t<2>(s2, d2, e2, c2, (LAS unsigned char*)scr, lane); }
            for (int i0 = gw * 64 + lane; i0 < NGA * 65536; i0 += 8 * NGW * 64) { float wv[8];
#pragma unroll
                for (int k = 0; k < 8; ++k) { int i = i0 + k * NGW * 64; i = i < NGA * 65536 ? i : NGA * 65536 - 1; const int h = i >> 16, t = (i >> 8) & 127, s = i & 127;
                    wv[k] = ((const GAS float*)a_w_s)[(h * 128 + t) * 128 + s]; }
                asm volatile("" : "+v"(wv[0]), "+v"(wv[1]), "+v"(wv[2]), "+v"(wv[3]), "+v"(wv[4]), "+v"(wv[5]), "+v"(wv[6]), "+v"(wv[7]));
#pragma unroll
                for (int k = 0; k < 8; ++k) { const int i = i0 + k * NGW * 64; const int tp = (i >> 8) & 255, sp = i & 255;
                    const float v = ((tp >> 7) == (sp >> 7) && (sp & 127) <= (tp & 127)) ? wv[k] : 0.f; if (i < NGA * 65536) ((GAS bf16*)BD)[i] = (bf16)f2bf(v); } }
            for (int i = gw * 64 + lane; i < 2 * 65536; i += NGW * 64) { const int l2 = i >> 16, r = (i >> 8) & 255, c = i & 255;
                const float kv = ((const GAS float*)peer_sk)[((l2 * 2 + (r >> 7)) * 128 + (r & 127)) * 128 + (c & 127)];
                const float v = ((r >> 7) == (c >> 7)) ? kv : 0.f; ((GAS bf16*)BDSK)[i] = (bf16)f2bf(v); }
        } break;
        case 1: if (PHON(1)) { PH_BEGIN; IDX_BEGIN;
            { pg8::AddrScores g{BDSK, WQB, 256, D, 256}; pg8::StaticOrder S; S.init(2 * D, D, G, bx); pg8::EpiBf16<0> E{WQS, D, nullptr, nullptr, nullptr};
              pg8::gemm_phase<pg8::EpiBf16<0>, pg8::AddrScores, pg8::StaticOrder, true, true>(lds + RING_OFF, g, S, E, tid); }
#ifdef G1_STAGGER
            { const int xs_ = (int)(xcc & 7u); for (int s_ = 0; s_ < xs_ * G1_STAGGER; ++s_) __builtin_amdgcn_s_sleep(75); }
#endif
            { pg8::AddrPlain8 g{XI0, W1I, D, D, D}; pg8::StaticOrder S; S.init(M_TOK, HA, G, bx); pg8::EpiGeluFp8 E{(unsigned char*)UG, HA, a_b_in, SX0, 1.0f / W1_SCALE, U_SCALE};
              pg8::gemm_phase<pg8::EpiGeluFp8, pg8::AddrPlain8, pg8::StaticOrder, true, true, 2>(lds + RING_OFF, g, S, E, tid); }
            { pg8::AddrPlain8 g{W1I + (size_t)HA * D, XI0, D, D, D}; pg8::StaticOrder S; S.init(HA, M_TOK, G, bx); pg8::EpiBf16<1, true> E{VT, M_TOK, nullptr, a_b_in + HA, nullptr, 1.0f / W1_SCALE, nullptr, SX0};
              pg8::gemm_phase<pg8::EpiBf16<1, true>, pg8::AddrPlain8, pg8::StaticOrder, true, true, 2>(lds + RING_OFF, g, S, E, tid); }
        } break;
        case 2: if (PHON(2)) { PH_BEGIN; IDX_BEGIN;
            for (int r = gw; r < 2 * D; r += 2 * NGW) rows_bf16_to_i8<2>(WQS, WQSI, SW, r, NGW, lane);
            LAS float* red = (LAS float*)(lds + RING_OFF);
            LAS float* stat = red + 64 * 64 * 2;
            const int rg = tid >> 3, j8 = tid & 7;
            for (int tb = vcu; tb < M_TOK / 64; tb += G) {
                const int t0 = tb * 64;
                float s[8], q[8];
#pragma unroll
                for (int e = 0; e < 8; ++e) { s[e] = 0.f; q[e] = 0.f; }
#pragma unroll 16
                for (int i = 0; i < 64; ++i) { const v4u w = *(const GAS v4u*)(VT + (size_t)(rg + 64 * i) * M_TOK + t0 + 8 * j8);
                    const float f[8] = {bflo(w.x), bfhi(w.x), bflo(w.y), bfhi(w.y), bflo(w.z), bfhi(w.z), bflo(w.w), bfhi(w.w)};
#pragma unroll
                    for (int e = 0; e < 8; ++e) { s[e] += f[e]; q[e] += f[e] * f[e]; } }
#pragma unroll
                for (int e = 0; e < 8; ++e) { red[(rg * 64 + 8 * j8 + e) * 2] = s[e]; red[(rg * 64 + 8 * j8 + e) * 2 + 1] = q[e]; }
                __syncthreads();
                if (tid < 128) { const int tok = tid & 63, wh = tid >> 6; float a = 0.f;
                    for (int r = 0; r < 64; ++r) a += red[(r * 64 + tok) * 2 + wh];
                    stat[tok * 2 + wh] = a; }
                __syncthreads();
                float mu[8], rs[8]; float inv_ha = 1.f / HA; asm volatile("" : "+v"(inv_ha));
#pragma unroll
                for (int e = 0; e < 8; ++e) { const float m = stat[(8 * j8 + e) * 2] * inv_ha; const float var = stat[(8 * j8 + e) * 2 + 1] * inv_ha - m * m; mu[e] = m; rs[e] = 1.f / sqrtf(fmaxf(var, 0.f) + LN_EPS); }
#pragma unroll 8
                for (int i = 0; i < 64; ++i) { const int c = rg + 64 * i; GAS v4u* p = (GAS v4u*)(VT + (size_t)c * M_TOK + t0 + 8 * j8); const v4u w = *p; const float gg = a_v_g[c], bb = a_v_b[c];
                    const float f[8] = {bflo(w.x), bfhi(w.x), bflo(w.y), bfhi(w.y), bflo(w.z), bfhi(w.z), bflo(w.w), bfhi(w.w)}; float o[8];
#pragma unroll
                    for (int e = 0; e < 8; ++e) o[e] = (f[e] - mu[e]) * rs[e] * gg + bb;
                    v4u ow; ow.x = pk2(o[0], o[1]); ow.y = pk2(o[2], o[3]); ow.z = pk2(o[4], o[5]); ow.w = pk2(o[6], o[7]); *p = ow; }
                __syncthreads();
            }
        } break;
        case 3: if (PHON(3)) { PH_BEGIN; IDX_BEGIN;
            pg8::AddrSpatial g{BD, VT, 256, M_TOK, 256}; pg8::StaticOrder S; S.init(M_TOK, HA, G, bx); pg8::EpiGate8 E{(const unsigned char*)UG, GF, HA, a_b_s, G_SCALE / U_SCALE};
            pg8::gemm_phase<pg8::EpiGate8, pg8::AddrSpatial, pg8::StaticOrder, true, true>(lds + RING_OFF, g, S, E, tid);
        } break;
        case 4: if (PHON(4)) { PH_BEGIN; IDX_BEGIN;
            pg8::AddrPlain8 g{GF, W2F, HA, HA, HA}; pg8::StaticOrder S; S.init(M_TOK, D, G, bx); pg8::EpiRes<false> E{(bf16*)Y, x_in, D, ALPHA, 1.0f / (G_SCALE * W2_SCALE)};
            pg8::gemm_phase<pg8::EpiRes<false>, pg8::AddrPlain8, pg8::StaticOrder, true, true, 1>(lds + RING_OFF, g, S, E, tid);
        } break;
        case 5: if (PHON(5)) { PH_BEGIN; IDX_BEGIN;
            for (int m = gw; m < M_TOK; m += 4 * NGW) ln_rows<4>((const bf16*)Y, ln_mix_g + ly * D, ln_mix_b + ly * D, XB, X8H, XI0, SX0, m, NGW, lane);
        } break;
        case 6: if (PHON(6)) { PH_BEGIN; IDX_BEGIN;
            pg8::AddrPlain8 g{WQSI + (size_t)ly * D * D, XI0, D, D, D}; pg8::StaticOrder S; S.init(D, M_TOK, G, bx); pg8::EpiBf16<0, true> E{(bf16*)ST, M_TOK, nullptr, nullptr, nullptr, 1.0f, SW + ly * D, SX0};
            pg8::gemm_phase<pg8::EpiBf16<0, true>, pg8::AddrPlain8, pg8::StaticOrder, true, true, 2>(lds + RING_OFF, g, S, E, tid);
        } break;
        case 7: if (PHON(7)) { PH_BEGIN; IDX_BEGIN;
            for (int it = gw; it < (M_TOK / 64) * HEADS; it += NGW) { const int h = it & 7, t = (it >> 3) * 64 + lane; topk_lane((const bf16*)ST, h, t, EIDX, GATE); }
        } break;
        case 8: if (PHON(8)) { PH_BEGIN; IDX_BEGIN;
            const unsigned char* ut = UT + (size_t)ly * NEXP * (D / 2); const unsigned char* vt = VTAB + (size_t)ly * NEXP * (D / 2);
            peer_chunked(ut, vt, SU + ly * NEXP, SV + ly * NEXP, EIDX, GATE, XB, X8H, Y, ln_ffn_g + ly * D, ln_ffn_b + ly * D, ly == 0 ? nullptr : OUT_PTR, ly == 0 ? XB : nullptr, ly == 0 ? XI0 : nullptr, SX0, gw, NGW, (LAS unsigned*)(lds + RING_OFF + wave * 16384), (LAS unsigned*)(lds + IDS16_OFF + wave * IDS16_WAVE));
        } break;
        case 9: if (PHON(9)) { PH_BEGIN; IDX_BEGIN;
            pg8::AddrPlain8 g{XI0, BINI, D, D, D}; pg8::StaticOrder S; S.init(M_TOK, D, G, bx); pg8::EpiBf16<0, true> E{H, D, nullptr, nullptr, nullptr, 1.0f / W1_SCALE, SX0, nullptr};
            pg8::gemm_phase<pg8::EpiBf16<0, true>, pg8::AddrPlain8, pg8::StaticOrder, true, true, 2>(lds + RING_OFF, g, S, E, tid);
        } break;
        case 10: if (PHON(10)) { PH_BEGIN; IDX_BEGIN;
            for (int it = gw; it < (M_TOK / 8) * 4; it += NGW) { const int t0 = (it >> 2) * 8, qd = it & 3, pos0 = t0 & (SEQ - 1);
                const GAS v4u* hp = (const GAS v4u*)(H + (size_t)t0 * D + qd * 512) + lane;
                if (qd == 0) pool_item<2>(hp, (GAS v4u*)(POOL + (size_t)t0 * D + qd * 512) + lane, pos0);
                else if (qd == 1) pool_item<4>(hp, (GAS v4u*)(POOL + (size_t)t0 * D + qd * 512) + lane, pos0);
                else if (qd == 2) pool_item<8>(hp, (GAS v4u*)(POOL + (size_t)t0 * D + qd * 512) + lane, pos0);
                else pool_item<16>(hp, (GAS v4u*)(POOL + (size_t)t0 * D + qd * 512) + lane, pos0); }
        } break;
        case 11: if (PHON(11)) { PH_BEGIN; IDX_BEGIN;
            pg8::AddrGrouped g{POOL, BGT, D, 512, 512}; pg8::StaticOrder S; S.init(M_TOK, D, G, bx); pg8::EpiFp8 E{MIXED8, D, b_b_grp, b_scale, M_SCALE};
            pg8::gemm_phase<pg8::EpiFp8, pg8::AddrGrouped, pg8::StaticOrder, true, true>(lds + RING_OFF, g, S, E, tid);
        } break;
#ifdef PROBE_L2
        case 14: { PH_BEGIN; IDX_BEGIN;
            peer_chunked(UT, VTAB, SU, SV, EIDX, GATE, XB, X8H, Y, ln_ffn_g, ln_ffn_b, nullptr, nullptr, nullptr, nullptr, gw, NGW, (LAS unsigned*)(lds + RING_OFF + wave * 16384), (LAS unsigned*)(lds + IDS16_OFF + wave * IDS16_WAVE), PROBE_L2);
        } break;
#endif
        default: if (PHON(12)) { PH_BEGIN; IDX_BEGIN;
            pg8::AddrPlain8 g{MIXED8, BOUTF, D, D, D}; pg8::StaticOrder S; S.init(M_TOK, D, G, bx); pg8::EpiRes<true> E{(bf16*)Y, XB, D, ALPHA, 1.0f / (M_SCALE * W2_SCALE)};
            pg8::gemm_phase<pg8::EpiRes<true>, pg8::AddrPlain8, pg8::StaticOrder, true, true, 1>(lds + RING_OFF, g, S, E, tid);
        } break;
        }
        if (ph + 1 < hi) { PH_BEGIN; unsigned xl = xcc; int w2 = wave0, z2 = 0; asm volatile("" : "+s"(xl), "+s"(w2), "+s"(z2));
            const int tidb = w2 * 64 + __builtin_amdgcn_mbcnt_hi(-1, __builtin_amdgcn_mbcnt_lo(-1, z2));
            XcdBarrier bar; bar.bar = (unsigned*)(ws + WS_CTL) + CW_BAR; bar.x = xl; bar.st = MISC + 8; xcd_barrier(bar, tidb); }
    }
}

extern "C" void kernel_launch(void* const* d_in, const int* in_sizes, int n_in, void* d_out, int out_size, void* d_ws, size_t ws_size, hipStream_t stream) {
    static int grid = 0;
    if (grid == 0) {
        if (n_in != 21 || out_size != M_TOK * D || ws_size < WS_END) { fprintf(stderr, "kernel_launch: unexpected problem (n_in %d, out %d, ws %zu)\n", n_in, out_size, ws_size); grid = -1; return; }
        int dev = 0, cus = 0, per_cu = 0;
        if (hipGetDevice(&dev) != hipSuccess || hipDeviceGetAttribute(&cus, hipDeviceAttributeMultiprocessorCount, dev) != hipSuccess) { grid = -1; return; }
        if (hipFuncSetAttribute((const void*)mega_fwd, hipFuncAttributeMaxDynamicSharedMemorySize, LDS_BYTES) != hipSuccess) { fprintf(stderr, "kernel_launch: hipFuncSetAttribute failed\n"); grid = -1; return; }
        if (hipOccupancyMaxActiveBlocksPerMultiprocessor(&per_cu, (const void*)mega_fwd, NTHREADS, LDS_BYTES) != hipSuccess || per_cu < 1) { fprintf(stderr, "kernel_launch: occupancy query says %d blocks per CU\n", per_cu); (void)hipGetLastError(); }
        grid = cus;
    }
    if (grid < 0) return;
    if (hipMemsetAsync((char*)d_ws + WS_CTL, 0, CTL_ZERO_BYTES, stream) != hipSuccess) return;
    Args a{};
    for (int i = 0; i < 21; ++i) a.in[i] = (const float*)d_in[i];
    a.out = (float*)d_out; a.ws = (unsigned char*)d_ws;
#if MK_PER_PHASE
    for (int p = 0; p < N_PHASES; ++p) { a.ph_lo = p; a.ph_hi = p + 1; hipLaunchKernelGGL(mega_fwd, dim3(grid), dim3(NTHREADS), LDS_BYTES, stream, a); }
#else
    a.ph_lo = 0; a.ph_hi = N_PHASES;
#ifdef PROBE_L2
    a.ph_hi = N_PHASES + 1;
#endif
    hipLaunchKernelGGL(mega_fwd, dim3(grid), dim3(NTHREADS), LDS_BYTES, stream, a);
#endif
}
```

```cpp
#include <hip/hip_runtime.h>
#include <cstdio>
#include <cstdint>

#ifndef MK_PER_PHASE
#define MK_PER_PHASE 0
#endif

namespace pg8 {
#define PG8_LAS __attribute__((address_space(3)))
#define PG8_GAS __attribute__((address_space(1)))
typedef unsigned short bf16_t;
typedef short bf16x8 __attribute__((ext_vector_type(8)));
typedef float f32x4 __attribute__((ext_vector_type(4)));
typedef float f32x2 __attribute__((ext_vector_type(2)));
typedef unsigned u32x4 __attribute__((ext_vector_type(4)));
constexpr int BM = 256, BK = 64, HALF = 128, HTB = HALF * BK * 2  , STAGE_BYTES = 8 * HTB, NXCD = 8, WGM = 8;

__host__ __device__ __forceinline__ int lds_byte(int r, int c) { const int st = (r >> 4) * 2 + (c >> 5), rr = r & 15, cc = c & 31, ob = rr * 64 + cc * 2; return st * 1024 + (ob ^ (((ob >> 9) & 1) << 5)); }
__host__ __device__ __forceinline__ void stage_rc(int b, int& R, int& C) { const int st = b / 1024, sb = b % 1024, swz = sb ^ (((sb >> 9) & 1) << 5); R = (st >> 1) * 16 + swz / 64; C = (st & 1) * 32 + (swz % 64) / 2; }
__host__ __device__ __forceinline__ int perm32(int rho) { const int n = rho >> 4, i = rho & 15; return 8 * (i >> 2) + 4 * n + (i & 3); }

typedef int i32x8 __attribute__((ext_vector_type(8)));
typedef int i32x4v __attribute__((ext_vector_type(4)));
__device__ __forceinline__ i32x8 pk32(bf16x8 a, bf16x8 b) { return __builtin_shufflevector(__builtin_bit_cast(i32x4v, a), __builtin_bit_cast(i32x4v, b), 0, 1, 2, 3, 4, 5, 6, 7); }
struct Unit { int pm, pn; };

struct StaticOrder {
    int nM, nN, nwg, G, c;
    __host__ __device__ void init(int M, int N, int G_, int c_) { nM = M / BM; nN = N / BM; nwg = nM * nN; G = G_; c = c_; }
    __host__ __device__ bool next(int i, Unit& u) const {
        const long L = (long)i * G + c; if (L >= nwg) return false;
        int wgid = (int)L; { const int q = nwg / NXCD, r = nwg % NXCD, xcd = wgid % NXCD, off = wgid / NXCD; wgid = (xcd < r ? xcd * (q + 1) : r * (q + 1) + (xcd - r) * q) + off; }
        const int nig = WGM * nN, gid = wgid / nig, fm = gid * WGM, gsz = (nM - fm) < WGM ? (nM - fm) : WGM;
        u.pm = fm + ((wgid % nig) % gsz); u.pn = (wgid % nig) / gsz; return true;
    }
    __device__ __forceinline__ void a_ready(const Unit&) const {}
    __device__ __forceinline__ void done(const Unit&) const {}
};

struct AddrPlain { const bf16_t* A; const bf16_t* Bt; int lda, ldb, K;
    __device__ __forceinline__ const char* a(const Unit& u) const { return (const char*)(A + (size_t)u.pm * BM * lda); }
    __device__ __forceinline__ const char* b(const Unit& u) const { return (const char*)(Bt + (size_t)u.pn * BM * ldb); } };
struct AddrPlain8 { const unsigned char* A; const unsigned char* Bt; int lda, ldb, K;
    __device__ __forceinline__ const char* a(const Unit& u) const { return (const char*)(A + (size_t)u.pm * BM * lda); }
    __device__ __forceinline__ const char* b(const Unit& u) const { return (const char*)(Bt + (size_t)u.pn * BM * ldb); } };
struct AddrSpatial { const bf16_t* BD; const bf16_t* VNT; int lda, ldb, K;
    __device__ __forceinline__ const char* a(const Unit& u) const { return (const char*)(BD + (size_t)u.pn * 65536); }
    __device__ __forceinline__ const char* b(const Unit& u) const { return (const char*)(VNT + (size_t)u.pn * 256 * 16384 + (size_t)u.pm * 256); } };
struct AddrScores { const bf16_t* BDsk; const bf16_t* Q; int lda, ldb, K;
    __device__ __forceinline__ const char* a(const Unit& u) const { return (const char*)(BDsk + (size_t)(u.pm >> 3) * 65536); }
    __device__ __forceinline__ const char* b(const Unit& u) const { return (const char*)(Q + (size_t)(u.pm >> 3) * 2048 * 2048 + (size_t)u.pn * 256 * 2048 + (size_t)(u.pm & 7) * 256); } };
struct AddrGrouped { const bf16_t* P; const bf16_t* BgT; int lda, ldb, K;
    __device__ __forceinline__ const char* a(const Unit& u) const { return (const char*)(P + (size_t)u.pm * 256 * 2048 + (size_t)(u.pn >> 1) * 512); }
    __device__ __forceinline__ const char* b(const Unit& u) const { return (const char*)(BgT + (size_t)(u.pn >> 1) * 512 * 512 + (size_t)(u.pn & 1) * 256 * 512); } };

__device__ __forceinline__ unsigned cvt_pk_bf16(float lo, float hi) { unsigned r; asm volatile("v_cvt_pk_bf16_f32 %0, %1, %2" : "=v"(r) : "v"(lo), "v"(hi)); return r; }
__device__ __forceinline__ float gelu_tanh(float v) {
    const float y2 = v * (1.5957691216f + 0.0713548163f * v * v);
    const float e = __builtin_amdgcn_exp2f(-1.4426950409f * y2);
    return v * __builtin_amdgcn_rcpf(1.0f + e);
}
__device__ __forceinline__ f32x4 gelu4(f32x4 v) { return (f32x4){gelu_tanh(v[0]), gelu_tanh(v[1]), gelu_tanh(v[2]), gelu_tanh(v[3])}; }
__device__ __forceinline__ u32x4 pack8(f32x4 v0, f32x4 v1) { u32x4 w; w.x = cvt_pk_bf16(v0[0], v0[1]); w.y = cvt_pk_bf16(v0[2], v0[3]); w.z = cvt_pk_bf16(v1[0], v1[1]); w.w = cvt_pk_bf16(v1[2], v1[3]); return w; }

typedef unsigned u32x2p __attribute__((ext_vector_type(2)));
__device__ __forceinline__ u32x4 pair16(u32x2p x, u32x2p y) {
    const auto s0 = __builtin_amdgcn_permlane16_swap(x.x, y.x, false, false), s1 = __builtin_amdgcn_permlane16_swap(x.y, y.y, false, false);
    return (u32x4){s0[0], s1[0], s0[1], s1[1]};
}
__device__ __forceinline__ void unpair16(u32x4 l, u32x2p& x, u32x2p& y) {
    const auto s0 = __builtin_amdgcn_permlane16_swap(l.x, l.z, false, false), s1 = __builtin_amdgcn_permlane16_swap(l.y, l.w, false, false);
    x = (u32x2p){s0[0], s1[0]}; y = (u32x2p){s0[1], s1[1]};
}
__device__ __forceinline__ u32x2p pk8_fp8(f32x4 v0, f32x4 v1) {
    int w0 = 0, w1 = 0;
    w0 = __builtin_amdgcn_cvt_pk_fp8_f32(__builtin_amdgcn_fmed3f(v0[0], -448.f, 448.f), __builtin_amdgcn_fmed3f(v0[1], -448.f, 448.f), w0, false);
    w0 = __builtin_amdgcn_cvt_pk_fp8_f32(__builtin_amdgcn_fmed3f(v0[2], -448.f, 448.f), __builtin_amdgcn_fmed3f(v0[3], -448.f, 448.f), w0, true);
    w1 = __builtin_amdgcn_cvt_pk_fp8_f32(__builtin_amdgcn_fmed3f(v1[0], -448.f, 448.f), __builtin_amdgcn_fmed3f(v1[1], -448.f, 448.f), w1, false);
    w1 = __builtin_amdgcn_cvt_pk_fp8_f32(__builtin_amdgcn_fmed3f(v1[2], -448.f, 448.f), __builtin_amdgcn_fmed3f(v1[3], -448.f, 448.f), w1, true);
    return (u32x2p){(unsigned)w0, (unsigned)w1};
}
__device__ __forceinline__ float bf_lo(unsigned w) { return __builtin_bit_cast(float, w << 16); }
__device__ __forceinline__ float bf_hi(unsigned w) { return __builtin_bit_cast(float, w & 0xffff0000u); }

template <int ACT, bool IACC = false> struct EpiBf16 {
    static constexpr bool PERM = true, AFTER_DRAIN = false;
    bf16_t* O; int ldc; const float* cbias; const float* rbias; const float* cscale; float ascale = 1.0f;
    const float* rs = nullptr; const float* cs = nullptr;
    __device__ __forceinline__ void operator()(const f32x4 (&acc)[2][2][4][2], const Unit& u, int wr, int wc, int fr, int fq) const {
        const int row0 = u.pm * BM + wr * 64 + fr, col0 = u.pn * BM + wc * 32 + 8 * fq;
        f32x4 bv[2][2], sv[2][2], cv[2][2]; float rsc[2][4], rb[2][4];
#pragma unroll
        for (int bj = 0; bj < 2; ++bj)
#pragma unroll
            for (int n = 0; n < 2; ++n) { bv[bj][n] = cbias ? *(const PG8_GAS f32x4*)(cbias + col0 + bj * HALF + 4 * n) : (f32x4){0.f, 0.f, 0.f, 0.f};
                                          sv[bj][n] = cscale ? *(const PG8_GAS f32x4*)(cscale + col0 + bj * HALF + 4 * n) : (f32x4){1.f, 1.f, 1.f, 1.f};
                                          cv[bj][n] = cs ? *(const PG8_GAS f32x4*)(cs + col0 + bj * HALF + 4 * n) : (f32x4){1.f, 1.f, 1.f, 1.f}; }
#pragma unroll
        for (int ai = 0; ai < 2; ++ai)
#pragma unroll
            for (int m = 0; m < 4; ++m) { const int r = row0 + ai * HALF + m * 16; rsc[ai][m] = (rs ? ((const PG8_GAS float*)rs)[r] : 1.0f) * ascale; rb[ai][m] = rbias ? ((const PG8_GAS float*)rbias)[r] : 0.f; }
#pragma unroll
        for (int ai = 0; ai < 2; ++ai)
#pragma unroll
            for (int m = 0; m < 4; ++m) { const int r = row0 + ai * HALF + m * 16; PG8_GAS bf16_t* rowp = (PG8_GAS bf16_t*)O + (size_t)r * ldc + col0;
#pragma unroll
                for (int bj = 0; bj < 2; ++bj) { f32x4 a0 = acc[ai][bj][m][0], a1 = acc[ai][bj][m][1];
                    if (IACC) { a0 = __builtin_convertvector(__builtin_bit_cast(i32x4v, a0), f32x4); a1 = __builtin_convertvector(__builtin_bit_cast(i32x4v, a1), f32x4); }
                    f32x4 v0 = a0 * (cv[bj][0] * rsc[ai][m]) + bv[bj][0] + rb[ai][m], v1 = a1 * (cv[bj][1] * rsc[ai][m]) + bv[bj][1] + rb[ai][m];
                    if (ACT == 1) { v0 = gelu4(v0); v1 = gelu4(v1); }
                    v0 = v0 * sv[bj][0]; v1 = v1 * sv[bj][1];
                    *(PG8_GAS u32x4*)(rowp + bj * HALF) = pack8(v0, v1); } }
    }
};
struct EpiF32 {
    static constexpr bool PERM = false, AFTER_DRAIN = false;
    float* C; int ldc;
    __device__ __forceinline__ void operator()(const f32x4 (&acc)[2][2][4][2], const Unit& u, int wr, int wc, int fr, int fq) const {
        const int row0 = u.pm * BM + wr * 64 + fr, col0 = u.pn * BM + wc * 32 + 4 * fq;
#pragma unroll
        for (int ai = 0; ai < 2; ++ai)
#pragma unroll
            for (int m = 0; m < 4; ++m) { float* rowp = C + (size_t)(row0 + ai * HALF + m * 16) * ldc + col0;
#pragma unroll
                for (int bj = 0; bj < 2; ++bj)
#pragma unroll
                    for (int n = 0; n < 2; ++n) *(f32x4*)(rowp + bj * HALF + n * 16) = acc[ai][bj][m][n]; }
    }
};
template <bool RBF> struct EpiRes {
    static constexpr bool PERM = true, AFTER_DRAIN = false;
    bf16_t* Y; const void* R; int ldc; float alpha; float ascale = 1.0f;
    __device__ __forceinline__ void operator()(const f32x4 (&acc)[2][2][4][2], const Unit& u, int wr, int wc, int fr, int fq) const {
        const int row0 = u.pm * BM + wr * 64 + fr, col0 = u.pn * BM + wc * 32 + 8 * fq;
#pragma unroll
        for (int ai = 0; ai < 2; ++ai) {
            f32x4 rv[4][2][2];
#pragma unroll
            for (int m = 0; m < 4; ++m) { const size_t off = (size_t)(row0 + ai * HALF + m * 16) * ldc + col0;
#pragma unroll
                for (int bj = 0; bj < 2; ++bj) {
                    if constexpr (RBF) { const u32x4 w = *(const PG8_GAS u32x4*)((const bf16_t*)R + off + bj * HALF);
                        rv[m][bj][0] = (f32x4){__builtin_bit_cast(float, w.x << 16), __builtin_bit_cast(float, w.x & 0xffff0000u), __builtin_bit_cast(float, w.y << 16), __builtin_bit_cast(float, w.y & 0xffff0000u)};
                        rv[m][bj][1] = (f32x4){__builtin_bit_cast(float, w.z << 16), __builtin_bit_cast(float, w.z & 0xffff0000u), __builtin_bit_cast(float, w.w << 16), __builtin_bit_cast(float, w.w & 0xffff0000u)}; }
                    else { rv[m][bj][0] = *(const PG8_GAS f32x4*)((const float*)R + off + bj * HALF); rv[m][bj][1] = *(const PG8_GAS f32x4*)((const float*)R + off + bj * HALF + 4); } } }
#pragma unroll
            for (int m = 0; m < 4; ++m) { const size_t off = (size_t)(row0 + ai * HALF + m * 16) * ldc + col0;
#pragma unroll
                for (int bj = 0; bj < 2; ++bj) *(PG8_GAS u32x4*)(Y + off + bj * HALF) = pack8(rv[m][bj][0] * alpha + acc[ai][bj][m][0] * ascale, rv[m][bj][1] * alpha + acc[ai][bj][m][1] * ascale); } }
    }
};
struct EpiGate {
    static constexpr bool PERM = true, AFTER_DRAIN = false;
    bf16_t* UG; int ldc; const float* bs;
    __device__ __forceinline__ void operator()(const f32x4 (&acc)[2][2][4][2], const Unit& u, int wr, int wc, int fr, int fq) const {
        const int row0 = u.pm * BM + wr * 64 + fr, col0 = u.pn * BM + wc * 32 + 8 * fq;
#pragma unroll
        for (int ai = 0; ai < 2; ++ai)
#pragma unroll
            for (int m = 0; m < 4; ++m) { const int r = row0 + ai * HALF + m * 16; bf16_t* rowp = UG + (size_t)r * ldc + col0; const float rb = bs[u.pn * 128 + (r & 127)];
#pragma unroll
                for (int bj = 0; bj < 2; ++bj) { const u32x4 uu = *(const u32x4*)(rowp + bj * HALF);
                    f32x4 v0 = acc[ai][bj][m][0] + rb, v1 = acc[ai][bj][m][1] + rb;
                    v0 = v0 * (f32x4){bf_lo(uu.x), bf_hi(uu.x), bf_lo(uu.y), bf_hi(uu.y)}; v1 = v1 * (f32x4){bf_lo(uu.z), bf_hi(uu.z), bf_lo(uu.w), bf_hi(uu.w)};
                    *(u32x4*)(rowp + bj * HALF) = pack8(v0, v1); } }
    }
};

struct EpiFp8 {
    static constexpr bool PERM = true, AFTER_DRAIN = false;
    unsigned char* O; int ldc; const float* cbias; const float* cscale; float oscale;
    __device__ __forceinline__ void operator()(const f32x4 (&acc)[2][2][4][2], const Unit& u, int wr, int wc, int fr, int fq) const {
        const int row0 = u.pm * BM + wr * 64 + fr, col0 = u.pn * BM + wc * 32 + 8 * fq, odd = fq & 1;
        f32x4 bv[2][2], sv[2][2];
#pragma unroll
        for (int bj = 0; bj < 2; ++bj)
#pragma unroll
            for (int n = 0; n < 2; ++n) { bv[bj][n] = *(const PG8_GAS f32x4*)(cbias + col0 + bj * HALF + 4 * n); sv[bj][n] = *(const PG8_GAS f32x4*)(cscale + col0 + bj * HALF + 4 * n) * oscale; }
#pragma unroll
        for (int ai = 0; ai < 2; ++ai)
#pragma unroll
            for (int mp = 0; mp < 2; ++mp) { const int r = row0 + ai * HALF + mp * 32 + 16 * odd;
#pragma unroll
                for (int bj = 0; bj < 2; ++bj) {
                    const u32x2p x = pk8_fp8((acc[ai][bj][2 * mp][0] + bv[bj][0]) * sv[bj][0], (acc[ai][bj][2 * mp][1] + bv[bj][1]) * sv[bj][1]);
                    const u32x2p y = pk8_fp8((acc[ai][bj][2 * mp + 1][0] + bv[bj][0]) * sv[bj][0], (acc[ai][bj][2 * mp + 1][1] + bv[bj][1]) * sv[bj][1]);
                    *(PG8_GAS u32x4*)(O + (size_t)r * ldc + col0 - 8 * odd + bj * HALF) = pair16(x, y); } }
    }
};
struct EpiGeluFp8 {
    static constexpr bool PERM = true, AFTER_DRAIN = false;
    unsigned char* O; int ldc; const float* cbias; const float* rs; float ascale; float oscale;
    __device__ __forceinline__ void operator()(const f32x4 (&acc)[2][2][4][2], const Unit& u, int wr, int wc, int fr, int fq) const {
        const int row0 = u.pm * BM + wr * 64 + fr, col0 = u.pn * BM + wc * 32 + 8 * fq, odd = fq & 1;
        f32x4 bv[2][2]; float rsc[2][4];
#pragma unroll
        for (int bj = 0; bj < 2; ++bj)
#pragma unroll
            for (int n = 0; n < 2; ++n) bv[bj][n] = *(const PG8_GAS f32x4*)(cbias + col0 + bj * HALF + 4 * n);
#pragma unroll
        for (int ai = 0; ai < 2; ++ai)
#pragma unroll
            for (int m = 0; m < 4; ++m) rsc[ai][m] = ((const PG8_GAS float*)rs)[row0 + ai * HALF + m * 16] * ascale;
#pragma unroll
        for (int ai = 0; ai < 2; ++ai)
#pragma unroll
            for (int mp = 0; mp < 2; ++mp) { const int r = row0 + ai * HALF + mp * 32 + 16 * odd;
#pragma unroll
                for (int bj = 0; bj < 2; ++bj) { u32x2p xy[2];
#pragma unroll
                    for (int h = 0; h < 2; ++h) { const int m = 2 * mp + h;
                        f32x4 v0 = __builtin_convertvector(__builtin_bit_cast(i32x4v, acc[ai][bj][m][0]), f32x4) * rsc[ai][m] + bv[bj][0], v1 = __builtin_convertvector(__builtin_bit_cast(i32x4v, acc[ai][bj][m][1]), f32x4) * rsc[ai][m] + bv[bj][1];
                        xy[h] = pk8_fp8(gelu4(v0) * oscale, gelu4(v1) * oscale); }
                    *(PG8_GAS u32x4*)(O + (size_t)r * ldc + col0 - 8 * odd + bj * HALF) = pair16(xy[0], xy[1]); } }
    }
};
struct EpiGate8 {
    static constexpr bool PERM = true, AFTER_DRAIN = false;
    const unsigned char* U; unsigned char* GF; int ldc; const float* bs; float gscale;
    __device__ __forceinline__ void operator()(const f32x4 (&acc)[2][2][4][2], const Unit& u, int wr, int wc, int fr, int fq) const {
        const int row0 = u.pm * BM + wr * 64 + fr, col0 = u.pn * BM + wc * 32 + 8 * fq, odd = fq & 1;
        u32x4 ul[2][2][2]; float rb[2][4];
#pragma unroll
        for (int ai = 0; ai < 2; ++ai) {
#pragma unroll
            for (int m = 0; m < 4; ++m) rb[ai][m] = ((const PG8_GAS float*)bs)[u.pn * 128 + ((row0 + ai * HALF + m * 16) & 127)];
#pragma unroll
            for (int mp = 0; mp < 2; ++mp)
#pragma unroll
                for (int bj = 0; bj < 2; ++bj) ul[ai][mp][bj] = *(const PG8_GAS u32x4*)(U + (size_t)(row0 + ai * HALF + mp * 32 + 16 * odd) * ldc + col0 - 8 * odd + bj * HALF); }
#pragma unroll
        for (int ai = 0; ai < 2; ++ai)
#pragma unroll
            for (int mp = 0; mp < 2; ++mp) { const int r = row0 + ai * HALF + mp * 32 + 16 * odd;
#pragma unroll
                for (int bj = 0; bj < 2; ++bj) { u32x2p ux[2], gx[2]; unpair16(ul[ai][mp][bj], ux[0], ux[1]);
#pragma unroll
                    for (int h = 0; h < 2; ++h) { const int m = 2 * mp + h;
                        f32x4 v0 = acc[ai][bj][m][0] + rb[ai][m], v1 = acc[ai][bj][m][1] + rb[ai][m];
                        const auto u01 = __builtin_amdgcn_cvt_pk_f32_fp8((int)ux[h].x, false), u23 = __builtin_amdgcn_cvt_pk_f32_fp8((int)ux[h].x, true), u45 = __builtin_amdgcn_cvt_pk_f32_fp8((int)ux[h].y, false), u67 = __builtin_amdgcn_cvt_pk_f32_fp8((int)ux[h].y, true);
                        gx[h] = pk8_fp8(v0 * (f32x4){u01[0], u01[1], u23[0], u23[1]} * gscale, v1 * (f32x4){u45[0], u45[1], u67[0], u67[1]} * gscale); }
                    *(PG8_GAS u32x4*)(GF + (size_t)r * ldc + col0 - 8 * odd + bj * HALF) = pair16(gx[0], gx[1]); } }
    }
};

template <class Epi, class Addr, class Sched, bool ALIGN_EPI = false, bool SP2 = false, int MODE = 0  >
__device__ __forceinline__ void gemm_phase(PG8_LAS unsigned char* lds, const Addr& g, const Sched& S, const Epi& E, const int tid  ) {
    const int wid = __builtin_amdgcn_readfirstlane(tid >> 6), lane = tid & 63, wr = wid >> 2, wc = wid & 3, fr = lane & 15, fq = lane >> 4;
    constexpr bool FP8 = MODE == 1, I8 = MODE == 2; constexpr int ES = MODE ? 1 : 2;
    const int K = g.K, nt = K / (BK * 2 / ES);
    unsigned voffA[2], voffB[2];
#pragma unroll
    for (int i = 0; i < 2; ++i) { int R, C; stage_rc(tid * 16 + i * 8192, R, C); const int Rb = Epi::PERM ? ((R & ~31) + perm32(R & 31)) : R;
        voffA[i] = (unsigned)(R * g.lda * ES + C * 2); voffB[i] = (unsigned)(Rb * g.ldb * ES + C * 2); }
    const size_t kstep = (size_t)(BK * 2);
    const size_t hsA = (size_t)HALF * g.lda * ES, hsB = (size_t)HALF * g.ldb * ES;
    const unsigned ldsw = (unsigned)wid * 1024u;
    const int aoff = lds_byte(wr * 64 + fr, fq * 8), boff = lds_byte(wc * 32 + fr, fq * 8);
#define PG8_SA(b, h) (((b) * 2 + (h)) * HTB)
#define PG8_SB(b, h) ((4 + (b) * 2 + (h)) * HTB)
#define PG8_STAGE(bufoff, gbase, voff) do { _Pragma("unroll") for (int _i = 0; _i < 2; ++_i) \
        __builtin_amdgcn_global_load_lds((const unsigned*)((const char*)(gbase) + (voff)[_i]), (PG8_LAS unsigned*)(lds + (bufoff) + ldsw + _i * 8192), 16, 0, 0); } while (0)
#define PG8_LDA(dst, b, h) do { _Pragma("unroll") for (int m = 0; m < 4; ++m) { if constexpr (FP8) { dst##8[m] = pk32(*(const PG8_LAS bf16x8*)(lds + PG8_SA(b, h) + aoff + m * 2048), *(const PG8_LAS bf16x8*)(lds + PG8_SA(b, h) + aoff + m * 2048 + 1024)); } \
        else { _Pragma("unroll") for (int k = 0; k < 2; ++k) dst[m][k] = *(const PG8_LAS bf16x8*)(lds + PG8_SA(b, h) + aoff + m * 2048 + k * 1024); } } } while (0)
#define PG8_LDB(dst, b, h) do { _Pragma("unroll") for (int n = 0; n < 2; ++n) { if constexpr (FP8) { dst##8[n] = pk32(*(const PG8_LAS bf16x8*)(lds + PG8_SB(b, h) + boff + n * 2048), *(const PG8_LAS bf16x8*)(lds + PG8_SB(b, h) + boff + n * 2048 + 1024)); } \
        else { _Pragma("unroll") for (int k = 0; k < 2; ++k) dst[n][k] = *(const PG8_LAS bf16x8*)(lds + PG8_SB(b, h) + boff + n * 2048 + k * 1024); } } } while (0)
#define PG8_MMA(ai, bj, At, Bt) do { __builtin_amdgcn_s_setprio(1); _Pragma("unroll") for (int m = 0; m < 4; ++m) _Pragma("unroll") for (int n = 0; n < 2; ++n) { \
        if constexpr (FP8) { asm volatile("v_mfma_scale_f32_16x16x128_f8f6f4 %0, %1, %2, %0, %3, %3 op_sel_hi:[0,0,0]" : "+v"(acc[ai][bj][m][n]) : "v"(Bt##8[n]), "v"(At##8[m]), "v"(sc127)); } \
        else if constexpr (I8) { _Pragma("unroll") for (int k = 0; k < 2; ++k) acc[ai][bj][m][n] = __builtin_bit_cast(f32x4, __builtin_amdgcn_mfma_i32_16x16x64_i8(__builtin_bit_cast(i32x4v, Bt[n][k]), __builtin_bit_cast(i32x4v, At[m][k]), __builtin_bit_cast(i32x4v, acc[ai][bj][m][n]), 0, 0, 0)); } \
        else { _Pragma("unroll") for (int k = 0; k < 2; ++k) acc[ai][bj][m][n] = __builtin_amdgcn_mfma_f32_16x16x32_bf16(Bt[n][k], At[m][k], acc[ai][bj][m][n], 0, 0, 0); } } __builtin_amdgcn_s_setprio(0); } while (0)
#define PG8_WAIT_V(n) asm volatile("s_waitcnt vmcnt(" #n ")" ::: "memory")
#define PG8_WAIT_L(n) asm volatile("s_waitcnt lgkmcnt(" #n ")" ::: "memory")
#define PG8_BAR __builtin_amdgcn_s_barrier()
#define PG8_SCHED __builtin_amdgcn_sched_barrier(0)
    Unit cur, nxt; int ui = 0;
    if (!S.next(0, cur)) return;
    f32x4 acc[2][2][4][2];
#pragma unroll
    for (int a = 0; a < 2; ++a)
#pragma unroll
        for (int b = 0; b < 2; ++b)
#pragma unroll
            for (int m = 0; m < 4; ++m)
#pragma unroll
                for (int n = 0; n < 2; ++n) acc[a][b][m][n] = (f32x4){0.f, 0.f, 0.f, 0.f};
    bf16x8 At[4][2], B0[2][2], B1[2][2]; i32x8 At8[4], B08[2], B18[2]; int sc127 = 127; if constexpr (FP8) asm volatile("" : "+v"(sc127));
    const char* cA = g.a(cur); const char* cB = g.b(cur);
    S.a_ready(cur);
    if constexpr (SP2) {
        PG8_STAGE(PG8_SB(0, 0), cB, voffB); PG8_STAGE(PG8_SB(0, 1), cB + hsB, voffB); PG8_STAGE(PG8_SA(0, 0), cA, voffA); PG8_STAGE(PG8_SA(0, 1), cA + hsA, voffA);
        if (wr == 1) PG8_BAR;
        PG8_WAIT_V(2); PG8_BAR;
        PG8_STAGE(PG8_SB(1, 0), cB + kstep, voffB); PG8_STAGE(PG8_SA(1, 0), cA + kstep, voffA); PG8_STAGE(PG8_SB(1, 1), cB + hsB + kstep, voffB);
        PG8_WAIT_V(6); PG8_BAR;
    } else {
        PG8_STAGE(PG8_SB(0, 0), cB, voffB); PG8_STAGE(PG8_SA(0, 0), cA, voffA); PG8_STAGE(PG8_SB(0, 1), cB + hsB, voffB); PG8_STAGE(PG8_SA(0, 1), cA + hsA, voffA);
        if (wr == 1) PG8_BAR;
        PG8_WAIT_V(4); PG8_BAR;
        PG8_STAGE(PG8_SB(1, 0), cB + kstep, voffB); PG8_STAGE(PG8_SA(1, 0), cA + kstep, voffA); PG8_STAGE(PG8_SB(1, 1), cB + hsB + kstep, voffB);
        PG8_WAIT_V(6); PG8_BAR;
    }
    for (;;) {
        const bool has_next = S.next(ui + 1, nxt);
        const char* nA = has_next ? g.a(nxt) : cA; const char* nB = has_next ? g.b(nxt) : cB;
        for (int t = 0; t < nt; t += 2) {
            const bool last = (t == nt - 2);
            const char* a1 = cA + (size_t)(t + 1) * kstep;
            const char* a2 = last ? nA : cA + (size_t)(t + 2) * kstep; const char* b2 = last ? nB : cB + (size_t)(t + 2) * kstep;
            const char* a3 = a2 + kstep; const char* b3 = b2 + kstep;
            if (last && has_next) S.a_ready(nxt);
            if constexpr (SP2) {
            PG8_LDB(B0, 0, 0); PG8_LDB(B1, 0, 1); PG8_SCHED; PG8_LDA(At, 0, 0); PG8_STAGE(PG8_SA(1, 1), a1 + hsA, voffA);
            PG8_WAIT_V(8); PG8_WAIT_L(0); PG8_BAR; PG8_MMA(0, 0, At, B0); PG8_MMA(0, 1, At, B1); PG8_BAR; PG8_SCHED;
            PG8_LDA(At, 0, 1); PG8_STAGE(PG8_SB(0, 0), b2, voffB); PG8_STAGE(PG8_SB(0, 1), b2 + hsB, voffB); PG8_STAGE(PG8_SA(0, 0), a2, voffA);
            PG8_WAIT_V(8); PG8_WAIT_L(0); PG8_BAR; PG8_MMA(1, 0, At, B0); PG8_MMA(1, 1, At, B1); PG8_BAR; PG8_SCHED;
            PG8_LDB(B0, 1, 0); PG8_LDB(B1, 1, 1); PG8_SCHED; PG8_LDA(At, 1, 0); PG8_STAGE(PG8_SA(0, 1), a2 + hsA, voffA);
            PG8_WAIT_V(8); PG8_WAIT_L(0); PG8_BAR; PG8_MMA(0, 0, At, B0); PG8_MMA(0, 1, At, B1); PG8_BAR; PG8_SCHED;
            PG8_LDA(At, 1, 1); PG8_STAGE(PG8_SB(1, 0), b3, voffB); PG8_STAGE(PG8_SB(1, 1), b3 + hsB, voffB); PG8_STAGE(PG8_SA(1, 0), a3, voffA);
            PG8_WAIT_V(8); PG8_WAIT_L(0); PG8_BAR; PG8_MMA(1, 0, At, B0); PG8_MMA(1, 1, At, B1); PG8_BAR; PG8_SCHED;
            } else {
            PG8_LDB(B0, 0, 0); PG8_SCHED; PG8_LDA(At, 0, 0); PG8_STAGE(PG8_SA(1, 1), a1 + hsA, voffA);
            PG8_WAIT_L(8); PG8_BAR; PG8_WAIT_L(0); PG8_MMA(0, 0, At, B0); PG8_BAR; PG8_SCHED;
            PG8_LDB(B1, 0, 1); PG8_STAGE(PG8_SB(0, 0), b2, voffB);
            PG8_BAR; PG8_WAIT_L(0); PG8_MMA(0, 1, At, B1); PG8_BAR;
            PG8_LDA(At, 0, 1); PG8_STAGE(PG8_SA(0, 0), a2, voffA);
            PG8_BAR; PG8_WAIT_L(0); PG8_MMA(1, 0, At, B0); PG8_BAR; PG8_SCHED;
            PG8_STAGE(PG8_SB(0, 1), b2 + hsB, voffB);
            PG8_WAIT_V(6); PG8_BAR; PG8_MMA(1, 1, At, B1); PG8_BAR;
            PG8_LDB(B0, 1, 0); PG8_SCHED; PG8_LDA(At, 1, 0); PG8_STAGE(PG8_SA(0, 1), a2 + hsA, voffA);
            PG8_WAIT_L(8); PG8_BAR; PG8_WAIT_L(0); PG8_MMA(0, 0, At, B0); PG8_BAR; PG8_SCHED;
            PG8_LDB(B1, 1, 1); PG8_STAGE(PG8_SB(1, 0), b3, voffB);
            PG8_BAR; PG8_WAIT_L(0); PG8_MMA(0, 1, At, B1); PG8_BAR;
            PG8_LDA(At, 1, 1); PG8_STAGE(PG8_SA(1, 0), a3, voffA);
            PG8_BAR; PG8_WAIT_L(0); PG8_MMA(1, 0, At, B0); PG8_BAR; PG8_SCHED;
            PG8_STAGE(PG8_SB(1, 1), b3 + hsB, voffB);
            PG8_WAIT_V(6); PG8_BAR; PG8_MMA(1, 1, At, B1); PG8_BAR;
            }
        }
        if constexpr (ALIGN_EPI) { if (wr == 0) PG8_BAR; }
        if constexpr (FP8) asm volatile("s_nop 15\n\ts_nop 15" ::: "memory");
#ifdef PG8_EPI2
        if constexpr (!Epi::AFTER_DRAIN && PG8_EPI2(Epi)) { E(acc, cur, wr, wc, fr, fq); asm volatile("" ::: "memory"); }
#endif
        if constexpr (!Epi::AFTER_DRAIN) { E(acc, cur, wr, wc, fr, fq); S.done(cur); }
        if (!has_next) break;
#pragma unroll
        for (int a = 0; a < 2; ++a)
#pragma unroll
            for (int b = 0; b < 2; ++b)
#pragma unroll
                for (int m = 0; m < 4; ++m)
#pragma unroll
                    for (int n = 0; n < 2; ++n) acc[a][b][m][n] = (f32x4){0.f, 0.f, 0.f, 0.f};
        cur = nxt; cA = nA; cB = nB; ++ui;
        if constexpr (ALIGN_EPI) { if (wr == 1) PG8_BAR; }
    }
    PG8_WAIT_V(0);
    if constexpr (!ALIGN_EPI) { if (wr == 0) PG8_BAR; }
    PG8_BAR;
    if constexpr (Epi::AFTER_DRAIN) { E.fused(acc, cur, wr, wc, fr, fq, lds, wid, lane); S.done(cur); }
#undef PG8_SA
#undef PG8_SB
#undef PG8_STAGE
#undef PG8_LDA
#undef PG8_LDB
#undef PG8_MMA
#undef PG8_WAIT_V
#undef PG8_WAIT_L
#undef PG8_BAR
#undef PG8_SCHED
}
}

constexpr int NWAVES = 8, NTHREADS = NWAVES * 64;
constexpr int M_TOK = 16384, SEQ = 4096, D = 2048, FFA = 8192, HA = 4096, NGA = 16, CHUNK = 128;
constexpr int NKEYS = 128, NEXP = 16384, HEADS = 8, TOPK = 16, NSEL = HEADS * TOPK;
constexpr float ALPHA = 1.41421356237f, LN_EPS = 1e-5f;
constexpr float X4_SCALE = 1.25f;
constexpr float M_SCALE = 32.0f;
constexpr float U_SCALE = 16.0f;
constexpr float G_SCALE = 16.0f, W2_SCALE = 2048.0f;
constexpr float W1_SCALE = 1024.0f;
constexpr int N_PHASES = 17;

constexpr size_t MiB = 1u << 20;
constexpr size_t WS_CTL = 0, CTL_ZERO_BYTES = 1 * MiB;
constexpr size_t WS_W1T = 2 * MiB, WS_W2T = 34 * MiB, WS_BINT = 50 * MiB, WS_BOUTT = 58 * MiB, WS_WQT = 66 * MiB  , WS_BGT = 82 * MiB, WS_BD = 84 * MiB, WS_BDSK = 86 * MiB  ;
constexpr size_t WS_SU = 87 * MiB, WS_SV = 87 * MiB + 131072;
constexpr size_t WS_XB = 88 * MiB;
constexpr size_t WS_UT = 152 * MiB, WS_VTAB = 280 * MiB;
constexpr size_t WS_UG = 408 * MiB;
constexpr size_t WS_ST = 408 * MiB, WS_POOL = 408 * MiB, WS_MIXED = 472 * MiB;
constexpr size_t WS_VT = 536 * MiB;
constexpr size_t WS_Q = 536 * MiB, WS_H = 600 * MiB;
constexpr size_t WS_Y = 664 * MiB;
constexpr size_t WS_X1 = 792 * MiB;
constexpr size_t WS_EIDX = 920 * MiB, WS_GATE = 928 * MiB;
constexpr size_t WS_WQS = 936 * MiB;
constexpr size_t WS_XF = 952 * MiB;
constexpr size_t WS_SX0 = 984 * MiB;
constexpr size_t WS_END = 985 * MiB;
constexpr int CW_BAR = 4096;

constexpr int RING_OFF = 0, RING_BYTES = 131072;
constexpr int LDSCTL_OFF = RING_BYTES, MISC_OFF = LDSCTL_OFF + 320;
constexpr int IDS16_OFF = LDSCTL_OFF + 1024;
constexpr int IDS16_WAVE = 3584;
constexpr int LDS_BYTES = IDS16_OFF + 8 * IDS16_WAVE;
static_assert(MISC_OFF + 128 <= LDS_BYTES, "LDS map");

#define GAS __attribute__((address_space(1)))
#define LAS __attribute__((address_space(3)))
typedef unsigned short bf16;
typedef unsigned v4u __attribute__((ext_vector_type(4)));
typedef unsigned v2u __attribute__((ext_vector_type(2)));
typedef float f32x4 __attribute__((ext_vector_type(4)));
typedef __bf16 bf16x2_t __attribute__((ext_vector_type(2)));
typedef GAS unsigned gu32;
#define RLX_AGENT __ATOMIC_RELAXED, __HIP_MEMORY_SCOPE_AGENT
#define LDS_WAIT() asm volatile("s_waitcnt lgkmcnt(0)" ::: "memory")
#define VM_WAIT() asm volatile("s_waitcnt vmcnt(0)" ::: "memory")
__device__ __forceinline__ unsigned f2bf(float f) { unsigned u = __builtin_bit_cast(unsigned, f); return (u + 0x7fffu + ((u >> 16) & 1u)) >> 16; }
__device__ __forceinline__ unsigned pk2(float lo, float hi) { return f2bf(lo) | (f2bf(hi) << 16); }
__device__ __forceinline__ float bflo(unsigned w) { return __builtin_bit_cast(float, w << 16); }
__device__ __forceinline__ float bfhi(unsigned w) { return __builtin_bit_cast(float, w & 0xffff0000u); }
__device__ __forceinline__ float dot2_bf16(unsigned w, unsigned x, float acc) { return __builtin_amdgcn_fdot2_f32_bf16(__builtin_bit_cast(bf16x2_t, w), __builtin_bit_cast(bf16x2_t, x), acc, false); }
__device__ __forceinline__ float shx(float v, int m, int lane) { return __builtin_bit_cast(float, __builtin_amdgcn_ds_bpermute((lane ^ m) << 2, __builtin_bit_cast(int, v))); }
__device__ __forceinline__ float wave_sum_l(float v, int lane) {
#pragma unroll
    for (int o = 1; o < 64; o <<= 1) v += shx(v, o, lane);
    return v;
}

#define XB_TMO      128
#define XB_XCNT(j)  (256  + 64 * (j))
#define XB_XSUB(j)  (1280 + 64 * (j))
#define XB_XGEN(j)  (2304 + 64 * (j))
#define XB_TOP      3328
#define XB_TOPGEN   3392
#define XCD_BAR_WORDS 3456
#define XB_SPIN_CAP (1u << 20)

__device__ __forceinline__ unsigned xb_ld(unsigned* p)              { return __hip_atomic_load(p, __ATOMIC_RELAXED, __HIP_MEMORY_SCOPE_AGENT); }
__device__ __forceinline__ unsigned xb_add(unsigned* p, unsigned v) { return __hip_atomic_fetch_add(p, v, __ATOMIC_RELAXED, __HIP_MEMORY_SCOPE_AGENT); }
__device__ __forceinline__ unsigned xb_xcc_id() { return (unsigned)__builtin_amdgcn_s_getreg((3 << 11) | 20) & 0xFu; }
#define XB_SPIN(cond, bar) do { unsigned _sp = 0; while (cond) { __builtin_amdgcn_s_sleep(1); \
    if ((++_sp & 255u) == 0u) { if (xb_ld(&(bar)[XB_TMO])) break; if (_sp > XB_SPIN_CAP) { atomicAdd(&(bar)[XB_TMO], 1u); break; } } } } while (0)

struct XcdBarrier { unsigned* bar; unsigned x; volatile LAS unsigned* st; };

__device__ __forceinline__ XcdBarrier xcd_barrier_post(unsigned* bar, volatile LAS unsigned* st) {
    XcdBarrier b; b.bar = bar; b.x = xb_xcc_id(); b.st = st;
    if (threadIdx.x == 0) (void)xb_add(&bar[XB_XCNT(b.x)], 1u);
    return b;
}
__device__ __forceinline__ void xcd_barrier_complete(unsigned* bar, unsigned x, unsigned& nloc, unsigned& nx) {
    const unsigned G = gridDim.x * gridDim.y * gridDim.z;
    unsigned sum, cnt, mine, sp = 0u;
    for (;;) {
        sum = 0u; cnt = 0u; mine = 0u;
#pragma unroll
        for (unsigned j = 0; j < 16; ++j) { const unsigned c = xb_ld(&bar[XB_XCNT(j)]); sum += c; cnt += (c > 0u) ? 1u : 0u; mine = (j == x) ? c : mine; }
        if (sum == G) break;
        __builtin_amdgcn_s_sleep(1);
        if ((++sp & 255u) == 0u) { if (xb_ld(&bar[XB_TMO])) break; if (sp > XB_SPIN_CAP) { atomicAdd(&bar[XB_TMO], 1u); break; } }
    }
    nloc = mine > 0u ? mine : 1u; nx = cnt > 0u ? cnt : 1u;
}
__device__ __forceinline__ void xcd_barrier(const XcdBarrier& b, const int tid) {
    asm volatile("s_waitcnt vmcnt(0)" ::: "memory");
    __syncthreads();
    if (tid == 0) {
        unsigned* bar = b.bar;
        __builtin_amdgcn_s_waitcnt(0);
        unsigned nloc = b.st[0], nx = b.st[1];
        if (nloc == 0u) { xcd_barrier_complete(bar, b.x, nloc, nx); b.st[0] = nloc; b.st[1] = nx; }
        const unsigned old = xb_add(&bar[XB_XSUB(b.x)], 1u);
        const unsigned gen = old / nloc;
        if (old + 1u == (gen + 1u) * nloc) {
            __builtin_amdgcn_fence(__ATOMIC_RELEASE, "agent");
            asm volatile("s_waitcnt vmcnt(0)" ::: "memory");
            const unsigned og = xb_add(&bar[XB_TOP], 1u);
            const unsigned tg = og / nx;
            if (og + 1u == (tg + 1u) * nx) xb_add(&bar[XB_TOPGEN], 1u);
            else XB_SPIN(xb_ld(&bar[XB_TOPGEN]) == tg, bar);
            __builtin_amdgcn_fence(__ATOMIC_ACQUIRE, "agent");
            xb_add(&bar[XB_XGEN(b.x)], 1u);
            asm volatile("s_waitcnt vmcnt(0)" ::: "memory");
        } else {
            XB_SPIN(xb_ld(&bar[XB_XGEN(b.x)]) == gen, bar);
            __builtin_amdgcn_fence(__ATOMIC_ACQUIRE, "agent");
            asm volatile("s_waitcnt vmcnt(0)" ::: "memory");
        }
    }
    __syncthreads();
}

__device__ __forceinline__ void p0_transpose_item(const float* W, int K, int N, bf16* WT, LAS float* scr, int item, int lane) {
    const int nblk = N / 32, kb = item / nblk, nb = item % nblk, k0 = 64 * kb, n0 = 32 * nb;
    float t[32];
#pragma unroll
    for (int i = 0; i < 32; ++i) t[i] = W[(size_t)(k0 + 2 * i + (lane >> 5)) * N + n0 + (lane & 31)];
#pragma unroll
    for (int i = 0; i < 32; ++i) scr[(2 * i + (lane >> 5)) * 33 + (lane & 31)] = t[i];
    LDS_WAIT(); asm volatile("" ::: "memory");
    const int c = lane & 7;
#pragma unroll
    for (int j = 0; j < 4; ++j) { const int n = (lane >> 3) + 8 * j; const LAS float* s = scr + (8 * c) * 33 + n;
        v4u o; o.x = pk2(s[0 * 33], s[1 * 33]); o.y = pk2(s[2 * 33], s[3 * 33]); o.z = pk2(s[4 * 33], s[5 * 33]); o.w = pk2(s[6 * 33], s[7 * 33]);
        *(GAS v4u*)(WT + (size_t)(n0 + n) * K + k0 + 8 * c) = o; }
    LDS_WAIT(); asm volatile("" ::: "memory");
}
__device__ __forceinline__ void p0_convert(const float* src, bf16* dst, int nchunks, int gw, int NGW, int lane) {
    for (int c0 = gw; c0 < nchunks; c0 += 4 * NGW) {
        f32x4 a[4][2];
#pragma unroll
        for (int q = 0; q < 4; ++q) { const int c = c0 + q * NGW; if (c < nchunks) { const GAS f32x4* s = (const GAS f32x4*)(src + (size_t)c * 512 + lane * 8); a[q][0] = s[0]; a[q][1] = s[1]; } }
#pragma unroll
        for (int q = 0; q < 4; ++q) { const int c = c0 + q * NGW; if (c < nchunks) { v4u o; o.x = pk2(a[q][0].x, a[q][0].y); o.y = pk2(a[q][0].z, a[q][0].w); o.z = pk2(a[q][1].x, a[q][1].y); o.w = pk2(a[q][1].z, a[q][1].w);
            *(GAS v4u*)(dst + (size_t)c * 512 + lane * 8) = o; } }
    }
}

__device__ __forceinline__ float clamp448(float v) { return __builtin_amdgcn_fmed3f(v, -448.0f, 448.0f); }
__device__ __forceinline__ unsigned pk4_fp8(float a, float b, float c, float d) { int w = 0; w = __builtin_amdgcn_cvt_pk_fp8_f32(clamp448(a), clamp448(b), w, false); w = __builtin_amdgcn_cvt_pk_fp8_f32(clamp448(c), clamp448(d), w, true); return (unsigned)w; }
__device__ __forceinline__ unsigned pk4_i8c(float a, float b, float c, float d) {
    const int q0 = (int)__builtin_rintf(__builtin_amdgcn_fmed3f(a, -127.f, 127.f)), q1 = (int)__builtin_rintf(__builtin_amdgcn_fmed3f(b, -127.f, 127.f)), q2 = (int)__builtin_rintf(__builtin_amdgcn_fmed3f(c, -127.f, 127.f)), q3 = (int)__builtin_rintf(__builtin_amdgcn_fmed3f(d, -127.f, 127.f));
    return ((unsigned)q0 & 0xffu) | (((unsigned)q1 & 0xffu) << 8) | (((unsigned)q2 & 0xffu) << 16) | ((unsigned)q3 << 24);
}
template <int NR> __device__ __forceinline__ void rows_to_i8(const float* x, unsigned char* o8, float* sx, int m0, int stride, int lane) {
    f32x4 v[NR][8];
#pragma unroll
    for (int k = 0; k < NR; ++k) { const GAS f32x4* xr = (const GAS f32x4*)(x + (size_t)(m0 + k * stride) * D) + lane;
#pragma unroll
        for (int j = 0; j < 8; ++j) v[k][j] = xr[64 * j]; }
#pragma unroll
    for (int k = 0; k < NR; ++k) { float am = 0.f;
#pragma unroll
        for (int j = 0; j < 8; ++j) am = fmaxf(am, fmaxf(fmaxf(fabsf(v[k][j].x), fabsf(v[k][j].y)), fmaxf(fabsf(v[k][j].z), fabsf(v[k][j].w))));
#pragma unroll
        for (int o = 1; o < 64; o <<= 1) am = fmaxf(am, shx(am, o, lane));
        const float inv = am > 0.f ? 127.0f / am : 0.f; const size_t ro = (size_t)(m0 + k * stride) * D;
#pragma unroll
        for (int j = 0; j < 8; ++j) ((GAS unsigned*)(o8 + ro) + lane)[64 * j] = pk4_i8c(v[k][j].x * inv, v[k][j].y * inv, v[k][j].z * inv, v[k][j].w * inv);
        if (lane == 0) ((GAS float*)sx)[m0 + k * stride] = am * (1.0f / 127.0f); }
}
template <bool I8> __device__ __forceinline__ void p0_transpose_item8(const float* W, int K, int N, unsigned char* WT, float scale, LAS float* scr, int item, int lane) {
    const int nblk = N / 32, kb = item / nblk, nb = item % nblk, k0 = 64 * kb, n0 = 32 * nb;
    float t[32];
#pragma unroll
    for (int i = 0; i < 32; ++i) t[i] = W[(size_t)(k0 + 2 * i + (lane >> 5)) * N + n0 + (lane & 31)];
#pragma unroll
    for (int i = 0; i < 32; ++i) scr[(2 * i + (lane >> 5)) * 33 + (lane & 31)] = t[i] * scale;
    LDS_WAIT(); asm volatile("" ::: "memory");
    const int c = lane & 7;
#pragma unroll
    for (int j = 0; j < 4; ++j) { const int n = (lane >> 3) + 8 * j; const LAS float* s = scr + (8 * c) * 33 + n;
        v2u o; if (I8) { o.x = pk4_i8c(s[0 * 33], s[1 * 33], s[2 * 33], s[3 * 33]); o.y = pk4_i8c(s[4 * 33], s[5 * 33], s[6 * 33], s[7 * 33]); } else { o.x = pk4_fp8(s[0 * 33], s[1 * 33], s[2 * 33], s[3 * 33]); o.y = pk4_fp8(s[4 * 33], s[5 * 33], s[6 * 33], s[7 * 33]); }
        *(GAS v2u*)(WT + (size_t)(n0 + n) * K + k0 + 8 * c) = o; }
    LDS_WAIT(); asm volatile("" ::: "memory");
}
__device__ __forceinline__ void p0_convert8(const float* src, unsigned char* dst, float scale, int nchunks, int gw, int NGW, int lane) {
    for (int c0 = gw; c0 < nchunks; c0 += 8 * NGW) {
        f32x4 a[8][2];
#pragma unroll
        for (int q = 0; q < 8; ++q) { const int c = c0 + q * NGW; if (c < nchunks) { const GAS f32x4* s = (const GAS f32x4*)(src + (size_t)c * 512 + lane * 8); a[q][0] = s[0]; a[q][1] = s[1]; } }
#pragma unroll
        for (int q = 0; q < 8; ++q) { const int c = c0 + q * NGW; if (c < nchunks) { v2u o; o.x = pk4_fp8(a[q][0].x * scale, a[q][0].y * scale, a[q][0].z * scale, a[q][0].w * scale); o.y = pk4_fp8(a[q][1].x * scale, a[q][1].y * scale, a[q][1].z * scale, a[q][1].w * scale);
            *(GAS v2u*)(dst + (size_t)c * 512 + lane * 8) = o; } }
    }
}
__device__ __forceinline__ void p0_row_fp8(const float* src, unsigned char* dst, int e, float* scale, int lane) {
    f32x4 v[2][4]; float am = 0.f;
#pragma unroll
    for (int i = 0; i < 2; ++i)
#pragma unroll
        for (int q = 0; q < 4; ++q) { v[i][q] = *(const GAS f32x4*)(src + i * 1024 + lane * 16 + 4 * q);
            am = fmaxf(am, fmaxf(fmaxf(fabsf(v[i][q].x), fabsf(v[i][q].y)), fmaxf(fabsf(v[i][q].z), fabsf(v[i][q].w)))); }
#pragma unroll
    for (int o = 1; o < 64; o <<= 1) am = fmaxf(am, shx(am, o, lane));
    const float inv = am > 0.f ? 256.0f / am : 0.f;
#pragma unroll
    for (int i = 0; i < 2; ++i) { v4u w;
#pragma unroll
        for (int q = 0; q < 4; ++q) { int d = 0; d = __builtin_amdgcn_cvt_pk_fp8_f32(v[i][q].x * inv, v[i][q].y * inv, d, false); d = __builtin_amdgcn_cvt_pk_fp8_f32(v[i][q].z * inv, v[i][q].w * inv, d, true); w[q] = (unsigned)d; }
        *(GAS v4u*)(dst + (size_t)(i * 8 + (lane >> 3)) * (NEXP * 128) + (size_t)e * 128 + (lane & 7) * 16) = w; }
    if (lane == 0) *scale = am * (1.0f / 256.0f);
}

template <int NR> __device__ __forceinline__ void p0_row_fp4(const float* const (&src)[NR], unsigned char* const (&dst)[NR], const int (&e)[NR], float* const (&scale)[NR], int lane) {
    f32x4 v[NR][2][4];
#pragma unroll
    for (int k = 0; k < NR; ++k)
#pragma unroll
        for (int i = 0; i < 2; ++i)
#pragma unroll
            for (int q = 0; q < 4; ++q) v[k][i][q] = *(const GAS f32x4*)(src[k] + i * 1024 + lane * 16 + 4 * q);
#pragma unroll
    for (int k = 0; k < NR; ++k) { float am = 0.f;
#pragma unroll
        for (int i = 0; i < 2; ++i)
#pragma unroll
            for (int q = 0; q < 4; ++q) am = fmaxf(am, fmaxf(fmaxf(fabsf(v[k][i][q].x), fabsf(v[k][i][q].y)), fmaxf(fabsf(v[k][i][q].z), fabsf(v[k][i][q].w))));
#pragma unroll
        for (int o = 1; o < 64; o <<= 1) am = fmaxf(am, shx(am, o, lane));
        const float inv = am > 0.f ? 6.0f / am : 0.f;
#pragma unroll
        for (int i = 0; i < 2; ++i) { unsigned w0 = 0, w1 = 0;
            w0 = __builtin_amdgcn_cvt_scalef32_pk_fp4_f32(w0, v[k][i][0].x * inv, v[k][i][0].y * inv, 1.0f, 0); w0 = __builtin_amdgcn_cvt_scalef32_pk_fp4_f32(w0, v[k][i][0].z * inv, v[k][i][0].w * inv, 1.0f, 1);
            w0 = __builtin_amdgcn_cvt_scalef32_pk_fp4_f32(w0, v[k][i][1].x * inv, v[k][i][1].y * inv, 1.0f, 2); w0 = __builtin_amdgcn_cvt_scalef32_pk_fp4_f32(w0, v[k][i][1].z * inv, v[k][i][1].w * inv, 1.0f, 3);
            w1 = __builtin_amdgcn_cvt_scalef32_pk_fp4_f32(w1, v[k][i][2].x * inv, v[k][i][2].y * inv, 1.0f, 0); w1 = __builtin_amdgcn_cvt_scalef32_pk_fp4_f32(w1, v[k][i][2].z * inv, v[k][i][2].w * inv, 1.0f, 1);
            w1 = __builtin_amdgcn_cvt_scalef32_pk_fp4_f32(w1, v[k][i][3].x * inv, v[k][i][3].y * inv, 1.0f, 2); w1 = __builtin_amdgcn_cvt_scalef32_pk_fp4_f32(w1, v[k][i][3].z * inv, v[k][i][3].w * inv, 1.0f, 3);
            *(GAS v2u*)(dst[k] + (size_t)(i * 4 + (lane >> 4)) * (NEXP * 128) + (size_t)e[k] * 128 + (lane & 15) * 8) = (v2u){w0, w1}; }
        if (lane == 0) *(GAS float*)scale[k] = am * (1.0f / 6.0f); }
}

template <int NR> __device__ __forceinline__ void p0_row_fp4t(const float* const (&src)[NR], unsigned char* const (&dst)[NR], const int (&e)[NR], float* const (&scale)[NR], LAS unsigned char* scr, int lane) {
    f32x4 v[NR][2][4];
#pragma unroll
    for (int k = 0; k < NR; ++k)
#pragma unroll
        for (int i = 0; i < 2; ++i)
#pragma unroll
            for (int q = 0; q < 4; ++q) v[k][i][q] = *(const GAS f32x4*)(src[k] + i * 1024 + lane * 16 + 4 * q);
#pragma unroll
    for (int k = 0; k < NR; ++k) { float am = 0.f;
#pragma unroll
        for (int i = 0; i < 2; ++i)
#pragma unroll
            for (int q = 0; q < 4; ++q) am = fmaxf(am, fmaxf(fmaxf(fabsf(v[k][i][q].x), fabsf(v[k][i][q].y)), fmaxf(fabsf(v[k][i][q].z), fabsf(v[k][i][q].w))));
#pragma unroll
        for (int o = 1; o < 64; o <<= 1) am = fmaxf(am, shx(am, o, lane));
        const float inv = am > 0.f ? 6.0f / am : 0.f;
#pragma unroll
        for (int i = 0; i < 2; ++i) { unsigned w0 = 0, w1 = 0;
            w0 = __builtin_amdgcn_cvt_scalef32_pk_fp4_f32(w0, v[k][i][0].x * inv, v[k][i][0].y * inv, 1.0f, 0); w0 = __builtin_amdgcn_cvt_scalef32_pk_fp4_f32(w0, v[k][i][0].z * inv, v[k][i][0].w * inv, 1.0f, 1);
            w0 = __builtin_amdgcn_cvt_scalef32_pk_fp4_f32(w0, v[k][i][1].x * inv, v[k][i][1].y * inv, 1.0f, 2); w0 = __builtin_amdgcn_cvt_scalef32_pk_fp4_f32(w0, v[k][i][1].z * inv, v[k][i][1].w * inv, 1.0f, 3);
            w1 = __builtin_amdgcn_cvt_scalef32_pk_fp4_f32(w1, v[k][i][2].x * inv, v[k][i][2].y * inv, 1.0f, 0); w1 = __builtin_amdgcn_cvt_scalef32_pk_fp4_f32(w1, v[k][i][2].z * inv, v[k][i][2].w * inv, 1.0f, 1);
            w1 = __builtin_amdgcn_cvt_scalef32_pk_fp4_f32(w1, v[k][i][3].x * inv, v[k][i][3].y * inv, 1.0f, 2); w1 = __builtin_amdgcn_cvt_scalef32_pk_fp4_f32(w1, v[k][i][3].z * inv, v[k][i][3].w * inv, 1.0f, 3);
            *(LAS v4u*)(scr + lane * 16) = (v4u){w0 & 0x0f0f0f0fu, (w0 >> 4) & 0x0f0f0f0fu, w1 & 0x0f0f0f0fu, (w1 >> 4) & 0x0f0f0f0fu};
            const int jj = lane & 15, oo = 4 * (jj & 3) + (jj >> 2), pos = (oo & 8) + ((oo & 1) << 2) + ((oo >> 1) & 3);
            const LAS unsigned char* col = scr + (lane & 48) * 16 + pos;
            unsigned o0 = 0, o1 = 0;
#pragma unroll
            for (int n = 0; n < 8; ++n) { o0 |= (unsigned)col[n * 16] << (4 * n); o1 |= (unsigned)col[(n + 8) * 16] << (4 * n); }
            *(GAS v2u*)(dst[k] + (size_t)(i * 4 + (lane >> 4)) * (NEXP * 128) + (size_t)e[k] * 128 + jj * 8) = (v2u){o0, o1};
            asm volatile("s_waitcnt lgkmcnt(0)" ::: "memory"); }
        if (lane == 0) *(GAS float*)scale[k] = am * (1.0f / 6.0f); }
}

#define LN8_HI(e) hi = __builtin_amdgcn_cvt_scalef32_pk_fp4_f32(hi, o[2 * e] * X4_SCALE, o[2 * e + 1] * X4_SCALE, 1.0f, e)
#define LN8_LO(e) { const auto hv = __builtin_amdgcn_cvt_scalef32_pk_f32_fp4(hi, 1.0f, e); lo = __builtin_amdgcn_cvt_scalef32_pk_fp4_f32(lo, (o[2 * e] * X4_SCALE - hv[0]) * 4.0f, (o[2 * e + 1] * X4_SCALE - hv[1]) * 4.0f, 1.0f, e); }
#define LN8_UNPACK(q_) {bflo((q_)[0]), bfhi((q_)[0]), bflo((q_)[1]), bfhi((q_)[1]), bflo((q_)[2]), bfhi((q_)[2]), bflo((q_)[3]), bfhi((q_)[3])}
template <int NR> __device__ __forceinline__ void ln_rows(const bf16* y, const float* g, const float* b, bf16* ob, unsigned char* o8h, unsigned char* o8, float* sx, int m0, int stride, int lane) {
    float v[NR][4][8];
#pragma unroll
    for (int k = 0; k < NR; ++k) { const GAS v4u* yr = (const GAS v4u*)(y + (size_t)(m0 + k * stride) * D) + lane; v4u w[4];
#pragma unroll
        for (int j = 0; j < 4; ++j) w[j] = yr[64 * j];
#pragma unroll
        for (int j = 0; j < 4; ++j) { const float f[8] = LN8_UNPACK(w[j]);
#pragma unroll
            for (int e = 0; e < 8; ++e) v[k][j][e] = f[e]; } }
    const GAS f32x4* g4 = (const GAS f32x4*)g + 2 * lane; const GAS f32x4* b4 = (const GAS f32x4*)b + 2 * lane;
#pragma unroll
    for (int k = 0; k < NR; ++k) { float s = 0.f;
#pragma unroll
        for (int j = 0; j < 4; ++j) s += ((v[k][j][0] + v[k][j][1]) + (v[k][j][2] + v[k][j][3])) + ((v[k][j][4] + v[k][j][5]) + (v[k][j][6] + v[k][j][7]));
        const float mean = wave_sum_l(s, lane) * (1.f / D); float s2 = 0.f;
#pragma unroll
        for (int j = 0; j < 4; ++j)
#pragma unroll
            for (int e = 0; e < 8; ++e) { v[k][j][e] -= mean; s2 += v[k][j][e] * v[k][j][e]; }
        const float rstd = 1.f / sqrtf(wave_sum_l(s2, lane) * (1.f / D) + LN_EPS);
        const size_t ro = (size_t)(m0 + k * stride) * D; float am = 0.f;
#pragma unroll
        for (int j = 0; j < 4; ++j) { const f32x4 ga = g4[128 * j], gb = g4[128 * j + 1], ba = b4[128 * j], bb = b4[128 * j + 1];
            const float gg[8] = {ga.x, ga.y, ga.z, ga.w, gb.x, gb.y, gb.z, gb.w}, be[8] = {ba.x, ba.y, ba.z, ba.w, bb.x, bb.y, bb.z, bb.w}; float o[8];
#pragma unroll
            for (int e = 0; e < 8; ++e) { o[e] = v[k][j][e] * rstd * gg[e] + be[e]; v[k][j][e] = o[e]; am = fmaxf(am, fabsf(o[e])); }
            ((GAS v4u*)(ob + ro) + lane)[64 * j] = (v4u){pk2(o[0], o[1]), pk2(o[2], o[3]), pk2(o[4], o[5]), pk2(o[6], o[7])};
 }
        {
#pragma unroll
            for (int o2 = 1; o2 < 64; o2 <<= 1) am = fmaxf(am, shx(am, o2, lane));
            const float inv = am > 0.f ? 127.0f / am : 0.f;
#pragma unroll
            for (int j = 0; j < 4; ++j) ((GAS v2u*)(o8 + ro) + lane)[64 * j] = (v2u){pk4_i8c(v[k][j][0] * inv, v[k][j][1] * inv, v[k][j][2] * inv, v[k][j][3] * inv), pk4_i8c(v[k][j][4] * inv, v[k][j][5] * inv, v[k][j][6] * inv, v[k][j][7] * inv)};
            if (lane == 0) ((GAS float*)sx)[ro / D] = am * (1.0f / 127.0f); }
    }
}
template <int NR> __device__ __forceinline__ void rows_bf16_to_i8(const bf16* x, unsigned char* o8, float* sx, int m0, int stride, int lane) {
#pragma unroll
    for (int k = 0; k < NR; ++k) { const size_t ro = (size_t)(m0 + k * stride) * D; const GAS v2u* xr = (const GAS v2u*)(x + ro) + lane; f32x4 v[8]; float am = 0.f;
#pragma unroll
        for (int j = 0; j < 8; ++j) { const v2u w = xr[64 * j]; v[j] = (f32x4){bflo(w.x), bfhi(w.x), bflo(w.y), bfhi(w.y)};
            am = fmaxf(am, fmaxf(fmaxf(fabsf(v[j].x), fabsf(v[j].y)), fmaxf(fabsf(v[j].z), fabsf(v[j].w)))); }
#pragma unroll
        for (int o = 1; o < 64; o <<= 1) am = fmaxf(am, shx(am, o, lane));
        const float inv = am > 0.f ? 127.0f / am : 0.f;
#pragma unroll
        for (int j = 0; j < 8; ++j) ((GAS unsigned*)(o8 + ro) + lane)[64 * j] = pk4_i8c(v[j].x * inv, v[j].y * inv, v[j].z * inv, v[j].w * inv);
        if (lane == 0) ((GAS float*)sx)[m0 + k * stride] = am * (1.0f / 127.0f); }
}

__device__ __forceinline__ void ins16(float (&L)[16], float key) {
#pragma unroll
    for (int j = 15; j >= 1; --j) L[j] = __builtin_amdgcn_fmed3f(L[j - 1], L[j], key);
    L[0] = fmaxf(L[0], key);
}
#define FENCE16(L) do { _Pragma("unroll") for (int _j = 0; _j < 16; ++_j) asm("" : "+v"(L[_j])); } while (0)
__device__ __forceinline__ void topk_lane(const bf16* ST, int h, int t, int* eidx, float* gate) {
    const float NEG = -__builtin_inff();
    float L1[16], L2[16];
#pragma unroll
    for (int j = 0; j < 16; ++j) { L1[j] = NEG; L2[j] = NEG; }
    const GAS bf16* s1 = (const GAS bf16*)ST + (size_t)(h * 256) * M_TOK + t;
    const GAS bf16* s2 = s1 + (size_t)128 * M_TOK;
#pragma nounroll
    for (int n0 = 0; n0 < NKEYS; n0 += 32) {
        unsigned ca[32], cb[32];
#pragma unroll
        for (int q = 0; q < 32; ++q) { ca[q] = s1[(size_t)(n0 + q) * M_TOK]; cb[q] = s2[(size_t)(n0 + q) * M_TOK]; }
#pragma unroll
        for (int q = 0; q < 32; ++q) {
            const unsigned tag = (unsigned)(127 - n0 - q);
            const float ka = __builtin_bit_cast(float, (ca[q] << 16) | tag);
            const float kb = __builtin_bit_cast(float, (cb[q] << 16) | tag);
            ins16(L1, ka); ins16(L2, kb);
            FENCE16(L1); FENCE16(L2);
        }
    }
    unsigned long long p1lo = 0, p1hi = 0, p2lo = 0, p2hi = 0;
#pragma unroll
    for (int j = 0; j < 8; ++j) {
        p1lo |= (unsigned long long)(127u - (__builtin_bit_cast(unsigned, L1[j]) & 127u)) << (8 * j); p1hi |= (unsigned long long)(127u - (__builtin_bit_cast(unsigned, L1[j + 8]) & 127u)) << (8 * j);
        p2lo |= (unsigned long long)(127u - (__builtin_bit_cast(unsigned, L2[j]) & 127u)) << (8 * j); p2hi |= (unsigned long long)(127u - (__builtin_bit_cast(unsigned, L2[j + 8]) & 127u)) << (8 * j); }
    float T[16];
#pragma unroll
    for (int j = 0; j < 16; ++j) T[j] = NEG;
#pragma unroll
    for (int a = 0; a < 16; ++a)
#pragma unroll
        for (int b = 0; b < 16; ++b)
            if ((a + 1) * (b + 1) <= 16) { const float sm = L1[a] + L2[b];
                ins16(T, __builtin_bit_cast(float, (__builtin_bit_cast(unsigned, sm) & ~255u) | (unsigned)(255 - (a * 16 + b)))); FENCE16(T); }
    float e[16], sum = 0.f; int I[16];
#pragma unroll
    for (int j = 0; j < 16; ++j) { e[j] = __builtin_amdgcn_exp2f((T[j] - T[0]) * 1.4426950409f); sum += e[j];
        const unsigned code = 255u - (__builtin_bit_cast(unsigned, T[j]) & 255u); const unsigned a = code >> 4, b = code & 15u;
        const unsigned long long wa = (a & 8u) ? p1hi : p1lo, wb = (b & 8u) ? p2hi : p2lo;
        const unsigned ia = (unsigned)(wa >> ((a & 7u) * 8u)) & 127u, ib = (unsigned)(wb >> ((b & 7u) * 8u)) & 127u;
        I[j] = (int)(ia * NKEYS + ib); }
    const float inv = 1.0f / sum;
    GAS int* eo = (GAS int*)eidx + (size_t)t * NSEL + h * TOPK; GAS float* go = (GAS float*)gate + (size_t)t * NSEL + h * TOPK;
#pragma unroll
    for (int j = 0; j < 16; j += 4) { typedef int i32x4 __attribute__((ext_vector_type(4)));
        *(GAS i32x4*)(eo + j) = (i32x4){I[j], I[j + 1], I[j + 2], I[j + 3]}; *(GAS f32x4*)(go + j) = (f32x4){e[j] * inv, e[j + 1] * inv, e[j + 2] * inv, e[j + 3] * inv}; }
}

constexpr int CHUNK_STRIDE = NEXP * 128;
typedef float f32x2 __attribute__((ext_vector_type(2)));
typedef int i32x4 __attribute__((ext_vector_type(4)));
#define PIN8(a, b) asm volatile("" : "+v"(a[b]), "+v"(a[b + 1]), "+v"(a[b + 2]), "+v"(a[b + 3]), "+v"(a[b + 4]), "+v"(a[b + 5]), "+v"(a[b + 6]), "+v"(a[b + 7]) :: "memory")
__device__ __forceinline__ f32x2 shx2(f32x2 v, int m, int lane) { return (f32x2){shx(v.x, m, lane), shx(v.y, m, lane)}; }

#define GAT_FETCHV(dst, rs, voff, soff) dst = __builtin_bit_cast(v4u, __builtin_amdgcn_raw_buffer_load_b128(rs, (int)(voff), soff, 0))
template <int NR> __device__ __forceinline__ void ln_res_rows(const bf16* x, const bf16* o, const float* g, const float* b, float* of, bf16* ob, unsigned char* o8, float* sx, size_t ro0, size_t rstride, int lane) {
    float v[NR][4][8];
#pragma unroll
    for (int k = 0; k < NR; ++k) { const GAS v4u* xr = (const GAS v4u*)(x + ro0 + k * rstride) + lane; const GAS v4u* orr = (const GAS v4u*)(o + ro0 + k * rstride) + lane; v4u xw[4], ow[4];
#pragma unroll
        for (int j = 0; j < 4; ++j) { xw[j] = xr[64 * j]; ow[j] = orr[64 * j]; }
#pragma unroll
        for (int j = 0; j < 4; ++j) { const float xf[8] = LN8_UNPACK(xw[j]), of8[8] = LN8_UNPACK(ow[j]);
#pragma unroll
            for (int e = 0; e < 8; ++e) v[k][j][e] = xf[e] * ALPHA + of8[e]; } }
    const GAS f32x4* g4 = (const GAS f32x4*)g + 2 * lane; const GAS f32x4* b4 = (const GAS f32x4*)b + 2 * lane;
#pragma unroll
    for (int k = 0; k < NR; ++k) { float s = 0.f;
#pragma unroll
        for (int j = 0; j < 4; ++j) s += ((v[k][j][0] + v[k][j][1]) + (v[k][j][2] + v[k][j][3])) + ((v[k][j][4] + v[k][j][5]) + (v[k][j][6] + v[k][j][7]));
        const float mean = wave_sum_l(s, lane) * (1.f / D); float s2 = 0.f;
#pragma unroll
        for (int j = 0; j < 4; ++j)
#pragma unroll
            for (int e = 0; e < 8; ++e) { v[k][j][e] -= mean; s2 += v[k][j][e] * v[k][j][e]; }
        const float rstd = 1.f / sqrtf(wave_sum_l(s2, lane) * (1.f / D) + LN_EPS);
        const size_t ro = ro0 + k * rstride;
        float am = 0.f;
#pragma unroll
        for (int j = 0; j < 4; ++j) { const f32x4 ga = g4[128 * j], gb = g4[128 * j + 1], ba = b4[128 * j], bb = b4[128 * j + 1];
            const float gg[8] = {ga.x, ga.y, ga.z, ga.w, gb.x, gb.y, gb.z, gb.w}, be[8] = {ba.x, ba.y, ba.z, ba.w, bb.x, bb.y, bb.z, bb.w}; float q[8];
#pragma unroll
            for (int e = 0; e < 8; ++e) { q[e] = v[k][j][e] * rstd * gg[e] + be[e]; v[k][j][e] = q[e]; am = fmaxf(am, fabsf(q[e])); }
            if (of) { ((GAS f32x4*)(of + ro) + 2 * lane)[128 * j] = (f32x4){q[0], q[1], q[2], q[3]}; ((GAS f32x4*)(of + ro) + 2 * lane)[128 * j + 1] = (f32x4){q[4], q[5], q[6], q[7]}; }
            if (ob) ((GAS v4u*)(ob + ro) + lane)[64 * j] = (v4u){pk2(q[0], q[1]), pk2(q[2], q[3]), pk2(q[4], q[5]), pk2(q[6], q[7])}; }
        if (o8) {
#pragma unroll
            for (int o2 = 1; o2 < 64; o2 <<= 1) am = fmaxf(am, shx(am, o2, lane));
            const float inv = am > 0.f ? 127.0f / am : 0.f;
#pragma unroll
            for (int j = 0; j < 4; ++j) ((GAS v2u*)(o8 + ro) + lane)[64 * j] = (v2u){pk4_i8c(v[k][j][0] * inv, v[k][j][1] * inv, v[k][j][2] * inv, v[k][j][3] * inv), pk4_i8c(v[k][j][4] * inv, v[k][j][5] * inv, v[k][j][6] * inv, v[k][j][7] * inv)};
            if (lane == 0) ((GAS float*)sx)[ro / D] = am * (1.0f / 127.0f); }
    }
}
#if defined(GAT_PMASK)
#define GAT_PM(R) (rep + 1 < (R) ? (unsigned)GAT_PMASK : 0x3fffu)
#else
#define GAT_PM(R) 0xffffffffu
#endif
#define GAT_FETCH4(rs, voff, soff) __builtin_amdgcn_raw_buffer_load_b128(rs, (int)(voff), soff, 0)
#define GAT_ACC(c, d) c = __builtin_fmaf(d.x, wq.x, __builtin_fmaf(d.y, wq.y, __builtin_fmaf(d.z, wq.z, __builtin_fmaf(d.w, wq.w, c))))
#define GAT_A8(a4) __builtin_shufflevector(a4, a4, 0, 1, 2, 3, -1, -1, -1, -1)
__device__ __forceinline__ void gat_u_mfma(float (&ccur)[8], float (&cprev)[8], f32x4 (&dp)[2], i32x4 (&A)[16], const i32x4 b1h, const i32x4 b2h, const i32x4 b1l, const i32x4 b2l, const LAS unsigned* enx, __amdgpu_buffer_rsrc_t rs, int soffn,
                                           const unsigned pofs, const f32x4 wq, const int s127, const int s125, const unsigned pm = 0xffffffffu) {
    unsigned en0 = enx[0], en1 = enx[8];
    f32x4 d0 = dp[0], d1 = dp[1];
#pragma unroll
    for (int g = 0; g < 8; ++g) {
        const unsigned en2 = enx[((g + 2) & 7) * 8];
        f32x4 d = __builtin_amdgcn_mfma_scale_f32_16x16x128_f8f6f4(GAT_A8(A[2 * g]), GAT_A8(b1h), (f32x4){0.f, 0.f, 0.f, 0.f}, 4, 4, 0, s127, 0, s127);
        d = __builtin_amdgcn_mfma_scale_f32_16x16x128_f8f6f4(GAT_A8(A[2 * g + 1]), GAT_A8(b2h), d, 4, 4, 0, s127, 0, s127);
        d = __builtin_amdgcn_mfma_scale_f32_16x16x128_f8f6f4(GAT_A8(A[2 * g]), GAT_A8(b1l), d, 4, 4, 0, s127, 0, s125);
        d = __builtin_amdgcn_mfma_scale_f32_16x16x128_f8f6f4(GAT_A8(A[2 * g + 1]), GAT_A8(b2l), d, 4, 4, 0, s127, 0, s125);
        A[2 * g] = __builtin_bit_cast(i32x4, GAT_FETCH4(rs, ((en0 & 0xffffu & pm) << 7) + pofs, soffn)); A[2 * g + 1] = __builtin_bit_cast(i32x4, GAT_FETCH4(rs, (((en0 >> 16) & pm) << 7) + pofs, soffn));
        if (g == 0) GAT_ACC(cprev[6], d0); else if (g == 1) GAT_ACC(cprev[7], d0); else GAT_ACC(ccur[g - 2], d0);
        d0 = d1; d1 = d; en0 = en1; en1 = en2;
        __builtin_amdgcn_sched_barrier(0);
    }
    dp[0] = d0; dp[1] = d1;
}
__device__ __forceinline__ float quad_sum(float v) {
    v += __builtin_bit_cast(float, __builtin_amdgcn_update_dpp(0, __builtin_bit_cast(int, v), 0xB1, 0xf, 0xf, false));
    v += __builtin_bit_cast(float, __builtin_amdgcn_update_dpp(0, __builtin_bit_cast(int, v), 0x4E, 0xf, 0xf, false));
    return v;
}
__device__ __forceinline__ f32x2 gat_v_step8(const float (&act)[16], float (&actn)[16], const LAS float* apn, v4u (&w)[16], const LAS unsigned* enx, __amdgpu_buffer_rsrc_t rs, int soffn, const unsigned jofs, int lane, const unsigned pm = 0xffffffffu) {
    f32x2 acc[8];
#pragma unroll
    for (int p = 0; p < 8; ++p) acc[p] = (f32x2){0.f, 0.f};
    v4u e0 = *(const LAS v4u*)(enx), e1 = e0;
#pragma unroll
    for (int i = 0; i < 16; ++i) { const f32x2 aa = {act[i], act[i]};
        if ((i & 3) == 0 && i < 12) e1 = *(const LAS v4u*)(enx + i + 4);
        if ((i & 3) == 1) { const f32x4 a4 = *(const LAS f32x4*)(apn + (i >> 2) * 4); actn[(i >> 2) * 4] = a4.x; actn[(i >> 2) * 4 + 1] = a4.y; actn[(i >> 2) * 4 + 2] = a4.z; actn[(i >> 2) * 4 + 3] = a4.w; }
#pragma unroll
        for (int c = 0; c < 4; ++c) { const f32x2 lo = __builtin_amdgcn_cvt_pk_f32_fp8((int)w[i][c], false), hi = __builtin_amdgcn_cvt_pk_f32_fp8((int)w[i][c], true);
            acc[2 * c] = __builtin_elementwise_fma(lo, aa, acc[2 * c]); acc[2 * c + 1] = __builtin_elementwise_fma(hi, aa, acc[2 * c + 1]); }
        asm volatile("" : "+v"(acc[0]), "+v"(acc[1]), "+v"(acc[2]), "+v"(acc[3]), "+v"(acc[4]), "+v"(acc[5]), "+v"(acc[6]), "+v"(acc[7]) :: "memory");
        GAT_FETCHV(w[i], rs, ((e0[i & 3] & pm) << 7) + jofs, soffn);
        if ((i & 3) == 3) e0 = e1;
        __builtin_amdgcn_sched_barrier(0);
    }
    const bool b3 = lane & 8, b4 = lane & 16, b5 = lane & 32;
    f32x2 ka[4], kb[2];
#pragma unroll
    for (int i = 0; i < 4; ++i) { const f32x2 keep = b3 ? acc[4 + i] : acc[i], send = b3 ? acc[i] : acc[4 + i]; ka[i] = keep + shx2(send, 8, lane); }
#pragma unroll
    for (int i = 0; i < 2; ++i) { const f32x2 keep = b4 ? ka[2 + i] : ka[i], send = b4 ? ka[i] : ka[2 + i]; kb[i] = keep + shx2(send, 16, lane); }
    const f32x2 keep = b5 ? kb[1] : kb[0], send = b5 ? kb[0] : kb[1];
    return keep + shx2(send, 32, lane);
}
__device__ __forceinline__ void peer_chunked(const unsigned char* utab, const unsigned char* vtab, const float* su, const float* sv, const int* eidx, const float* gate, const bf16* xres, const unsigned char* x8h,
                                             float* ybuf, const float* lng, const float* lnb, float* of, bf16* ob, unsigned char* o8, float* sx8, int gw, int NGW, LAS unsigned* vol, LAS unsigned* vids, const unsigned emask = 0x3fffu) {
    const __amdgpu_buffer_rsrc_t rsxh = __builtin_amdgcn_make_buffer_rsrc((void*)x8h, (short)0, M_TOK * (D / 2), 0x00020000), rsxl = __builtin_amdgcn_make_buffer_rsrc((void*)(x8h + (size_t)M_TOK * (D / 2)), (short)0, M_TOK * (D / 2), 0x00020000);
    const __amdgpu_buffer_rsrc_t rsy = __builtin_amdgcn_make_buffer_rsrc((void*)ybuf, (short)0, M_TOK * D * 2, 0x00020000);
    const __amdgpu_buffer_rsrc_t rsu = __builtin_amdgcn_make_buffer_rsrc((void*)utab, (short)0, NEXP * (D / 2), 0x00020000), rsv = __builtin_amdgcn_make_buffer_rsrc((void*)vtab, (short)0, NEXP * (D / 2), 0x00020000);
    LAS unsigned* et = vids;
    {   int zz = 0; asm volatile("" : "+s"(zz));
        const int lane = __builtin_amdgcn_mbcnt_hi(-1, __builtin_amdgcn_mbcnt_lo(-1, zz));
#pragma unroll
        for (int q = 0; q < 8; ++q) { const v2u v = *(const GAS v2u*)(eidx + (size_t)(gw + q * NGW) * NSEL + 2 * lane); et[q * 64 + lane] = (v.x & emask) | ((v.y & emask) << 16); }
        asm volatile("s_waitcnt lgkmcnt(0)" ::: "memory");
    }
    float osc[8];
#ifdef GAT_UREP
#pragma nounroll
    for (int rep = 0; rep < GAT_UREP; ++rep)
#endif
    {   int zz = 0; asm volatile("" : "+s"(zz));
        const int lu = __builtin_amdgcn_mbcnt_hi(-1, __builtin_amdgcn_mbcnt_lo(-1, zz));
        const int kbu = lu >> 4, q4 = lu & 3;
        const LAS unsigned* eu = et + 2 * ((lu >> 2) & 3) + (kbu >> 1);
        {   LAS unsigned* xs = vol;
#pragma unroll
            for (int q = 0; q < 8; ++q) { const GAS v4u* xr = (const GAS v4u*)(xres + (size_t)(gw + q * NGW) * D) + lu; v4u w[4];
#pragma unroll
                for (int j = 0; j < 4; ++j) w[j] = xr[64 * j];
#pragma unroll
                for (int j = 0; j < 4; ++j) { const float o[8] = LN8_UNPACK(w[j]); unsigned hi = 0, lo = 0;
                    LN8_HI(0); LN8_HI(1); LN8_HI(2); LN8_HI(3); LN8_LO(0) LN8_LO(1) LN8_LO(2) LN8_LO(3)
                    xs[q * 512 + 64 * j + lu] = hi; xs[q * 512 + 256 + 64 * j + lu] = lo; } }
            asm volatile("s_waitcnt lgkmcnt(0)" ::: "memory"); }
        const unsigned pofs = (unsigned)(4 * (kbu & 1) + q4) * 16u;
        const bool bon = (kbu >> 1) == ((lu >> 3) & 1);
        const int m1 = (bon && ((lu >> 2) & 1) == 0) ? -1 : 0, m2 = (bon && ((lu >> 2) & 1) == 1) ? -1 : 0;
        int s127 = 127, s125 = 125; asm volatile("" : "+v"(s127), "+v"(s125));
        f32x4 wq = {q4 == 0 ? 1.f : 0.f, q4 == 1 ? 1.f : 0.f, q4 == 2 ? 1.f : 0.f, q4 == 3 ? 1.f : 0.f}; asm volatile("" : "+v"(wq));
        float cacc[8][8]; f32x4 dp[2] = {{0.f, 0.f, 0.f, 0.f}, {0.f, 0.f, 0.f, 0.f}};
#pragma unroll
        for (int q = 0; q < 8; ++q)
#pragma unroll
            for (int g = 0; g < 8; ++g) cacc[q][g] = 0.f;
        i32x4 A[16], xh0, xl0, xh1, xl1;
#define GAT_XLOAD8(dh, dl, q, cc) do { const LAS i32x4* xp_ = (const LAS i32x4*)((const LAS unsigned char*)vol + (q) * 2048 + (cc) * 128 + pofs); dh = xp_[0]; dl = xp_[64]; } while (0)
#define GAT_BUILD(b, r, m) const i32x4 b = {r[0] & m, r[1] & m, r[2] & m, r[3] & m}
#define GAT_USTEP(q, qn, cc, xhc, xlc, xhn, xln) { GAT_XLOAD8(xhn, xln, qn, cc); GAT_BUILD(b1h, xhc, m1); GAT_BUILD(b2h, xhc, m2); GAT_BUILD(b1l, xlc, m1); GAT_BUILD(b2l, xlc, m2); \
            gat_u_mfma(cacc[q], cacc[((q) + 7) & 7], dp, A, b1h, b2h, b1l, b2l, eu + (qn) * 64, rsu, (cc) * CHUNK_STRIDE, pofs, wq, s127, s125, GAT_PM(GAT_UREP)); }
        GAT_XLOAD8(xh0, xl0, 0, 0);
#pragma unroll
        for (int g = 0; g < 8; ++g) { const unsigned en = eu[g * 8];
            A[2 * g] = __builtin_bit_cast(i32x4, GAT_FETCH4(rsu, ((en & 0xffffu) << 7) + pofs, 0)); A[2 * g + 1] = __builtin_bit_cast(i32x4, GAT_FETCH4(rsu, ((en >> 16) << 7) + pofs, 0)); }
#pragma nounroll
        for (int c = 0; c < 8; ++c) {
            const int cn = c < 7 ? c + 1 : 7;
            GAT_USTEP(0, 1, c, xh0, xl0, xh1, xl1) GAT_USTEP(1, 2, c, xh1, xl1, xh0, xl0) GAT_USTEP(2, 3, c, xh0, xl0, xh1, xl1) GAT_USTEP(3, 4, c, xh1, xl1, xh0, xl0)
            GAT_USTEP(4, 5, c, xh0, xl0, xh1, xl1) GAT_USTEP(5, 6, c, xh1, xl1, xh0, xl0) GAT_USTEP(6, 7, c, xh0, xl0, xh1, xl1) GAT_USTEP(7, 0, cn, xh1, xl1, xh0, xl0)
        }
        GAT_ACC(cacc[7][6], dp[0]); GAT_ACC(cacc[7][7], dp[1]);
        const int ei = lu >> 2;
        LAS unsigned char* codes = (LAS unsigned char*)vol + 4096;
#pragma unroll
        for (int q = 0; q < 8; ++q) {
            float pe = 0.f, po = 0.f;
#pragma unroll
            for (int g = 0; g < 8; ++g) { const float s = quad_sum(cacc[q][g]);
                if (g & 1) po = (q4 == (g >> 1)) ? s : po; else pe = (q4 == (g >> 1)) ? s : pe; }
            const int pb = (2 * q4) * 16 + ei;
            const unsigned e0 = ((const LAS unsigned short*)et)[q * 128 + pb], e1 = ((const LAS unsigned short*)et)[q * 128 + pb + 16];
            const GAS float* gp = (const GAS float*)(gate + (size_t)(gw + q * NGW) * NSEL + pb);
            const float g0 = gp[0], g1 = gp[16];
            const float a0 = g0 * pg8::gelu_tanh(pe * (((const GAS float*)su)[e0] * (1.0f / X4_SCALE))) * ((const GAS float*)sv)[e0], a1 = g1 * pg8::gelu_tanh(po * (((const GAS float*)su)[e1] * (1.0f / X4_SCALE))) * ((const GAS float*)sv)[e1];
            float mx = fmaxf(fabsf(a0), fabsf(a1));
#pragma unroll
            for (int o = 1; o < 64; o <<= 1) mx = fmaxf(mx, shx(mx, o, lu));
            const float sc = mx > 0.f ? 6.0f / mx : 0.f;
            osc[q] = __builtin_bit_cast(float, __builtin_amdgcn_readfirstlane(__builtin_bit_cast(int, mx * (1.0f / 6.0f))));
            const float t0 = a0 * sc, t1 = a1 * sc;
            const unsigned ch = __builtin_amdgcn_cvt_scalef32_pk_fp4_f32(0u, t0, t1, 1.0f, 0); const auto vh = __builtin_amdgcn_cvt_scalef32_pk_f32_fp4(ch, 1.0f, 0);
            const float r0 = (t0 - vh[0]) * 4.0f, r1 = (t1 - vh[1]) * 4.0f;
            const unsigned cm = __builtin_amdgcn_cvt_scalef32_pk_fp4_f32(0u, r0, r1, 1.0f, 0); const auto vm = __builtin_amdgcn_cvt_scalef32_pk_f32_fp4(cm, 1.0f, 0);
            const unsigned cl = __builtin_amdgcn_cvt_scalef32_pk_fp4_f32(0u, (r0 - vm[0]) * 4.0f, (r1 - vm[1]) * 4.0f, 1.0f, 0);
            LAS unsigned char* cq = codes + q * 384 + pb;
            cq[0] = (unsigned char)(ch & 15u); cq[16] = (unsigned char)((ch >> 4) & 15u); cq[128] = (unsigned char)(cm & 15u); cq[144] = (unsigned char)((cm >> 4) & 15u);
            cq[256] = (unsigned char)(cl & 15u); cq[272] = (unsigned char)((cl >> 4) & 15u);
        }
        {   const int qq = lu >> 3, r8 = lu & 7; unsigned pk[8];
#pragma unroll
            for (int k = 0; k < 8; ++k) pk[k] = (unsigned)((const LAS unsigned short*)et)[qq * 128 + 16 * k + r8] | ((unsigned)((const LAS unsigned short*)et)[qq * 128 + 16 * k + 8 + r8] << 16);
            asm volatile("s_waitcnt lgkmcnt(0)" : "+v"(pk[0]), "+v"(pk[1]), "+v"(pk[2]), "+v"(pk[3]), "+v"(pk[4]), "+v"(pk[5]), "+v"(pk[6]), "+v"(pk[7]) :: "memory");
            *(LAS v4u*)(vids + lu * 8) = (v4u){pk[0], pk[1], pk[2], pk[3]}; *(LAS v4u*)(vids + lu * 8 + 4) = (v4u){pk[4], pk[5], pk[6], pk[7]}; }
        {   const int mrow = lu & 15, kbv = lu >> 4;
            const LAS unsigned char* cb = (const LAS unsigned char*)vol + 4096 + (mrow < 3 ? mrow : 2) * 128 + kbv * 32;
#pragma unroll
            for (int q = 0; q < 8; ++q) { const v4u c0 = *(const LAS v4u*)(cb + q * 384), c1 = *(const LAS v4u*)(cb + q * 384 + 16); unsigned h[8];
#pragma unroll
                for (int k = 0; k < 8; ++k) { const unsigned w = k < 4 ? c0[k] : c1[k - 4]; const unsigned t = (w | (w >> 4)) & 0x00ff00ffu; h[k] = (t | (t >> 8)) & 0xffffu; }
                *(LAS v4u*)((LAS unsigned char*)vids + 2048 + q * 192 + (mrow < 3 ? mrow : 2) * 64 + kbv * 16) = (v4u){h[0] | (h[1] << 16), h[2] | (h[3] << 16), h[4] | (h[5] << 16), h[6] | (h[7] << 16)}; }
        }
        __builtin_amdgcn_sched_barrier(0);
    }
#ifdef GAT_VREP
#pragma nounroll
    for (int rep = 0; rep < GAT_VREP; ++rep)
#endif
    {   int zz = 0; asm volatile("" : "+s"(zz));
        const int lv = __builtin_amdgcn_mbcnt_hi(-1, __builtin_amdgcn_mbcnt_lo(-1, zz));
        const int r8 = lv >> 3, kbv = lv >> 4, mrow = lv & 15;
        const unsigned pofsE = 16u * (unsigned)((lv & 7) ^ (r8 >> 1)), pofsO = pofsE ^ 64u;
        const unsigned ringa = (unsigned)(size_t)(LAS unsigned char*)vol;
        const unsigned idsa = (unsigned)(size_t)(LAS unsigned char*)vids + (unsigned)r8 * 32u;
        const unsigned apx = (((ringa + (unsigned)mrow * 128u) | (16u * (unsigned)(mrow >> 1))) ^ (16u * (unsigned)(kbv >> 1))) + 8u * (unsigned)(kbv & 1);
        const int term = mrow & 3;
        const unsigned keep = (term < 3 && (mrow >> 2) == kbv) ? 0xffffffffu : 0u;
        const unsigned acta = (unsigned)(size_t)(LAS unsigned char*)vids + 2048u + (unsigned)(term < 3 ? term : 2) * 64u;
        int sA = 127 - 2 * (term < 2 ? term : 2), s127 = 127; asm volatile("" : "+v"(sA), "+v"(s127));
        asm volatile("s_waitcnt lgkmcnt(0)" ::: "memory");
        __builtin_amdgcn_sched_barrier(0);
        v4u idn0, idn1;
#define GATV_IDS(d0, d1, q) asm volatile("ds_read_b128 %0, %2\n\tds_read_b128 %1, %2 offset:16\n\ts_waitcnt lgkmcnt(0)" : "=&v"(d0), "=&v"(d1) : "v"(idsa + (unsigned)(q) * 256u) : "memory")
#define GATV_ACT(d, q) do { asm volatile("ds_read_b128 %0, %4\n\tds_read_b128 %1, %4 offset:16\n\tds_read_b128 %2, %4 offset:32\n\tds_read_b128 %3, %4 offset:48\n\ts_waitcnt lgkmcnt(0)" : "=&v"(d[0]), "=&v"(d[1]), "=&v"(d[2]), "=&v"(d[3]) : "v"(acta + (unsigned)(q) * 192u) : "memory"); \
            _Pragma("unroll") for (int u_ = 0; u_ < 4; ++u_) d[u_] = (v4u){d[u_].x & keep, d[u_].y & keep, d[u_].z & keep, d[u_].w & keep}; } while (0)
#define GATV_ID(d0, d1, k) ((((k) < 8 ? d0[(k) >> 1] : d1[((k) - 8) >> 1]) >> (16 * ((k) & 1))) & 0xffffu)
#define GATV_DMA(u, d0, d1, soff) do { _Pragma("unroll") for (int w_ = 0; w_ < 4; ++w_) \
            __builtin_amdgcn_raw_ptr_buffer_load_lds(rsv, (LAS void*)((LAS unsigned char*)vol + (u) * 4096 + w_ * 1024), 16, (int)(((GATV_ID(d0, d1, (u) * 4 + w_) & GAT_PM(GAT_VREP)) << 7) + ((w_ & 1) ? pofsO : pofsE)), soff, 0, 0); } while (0)
#define GATV_TR(dst, areg, off) asm volatile("ds_read_b64_tr_b4 %0, %1 offset:%2" : "=v"(dst) : "v"(areg), "i"(off))
#define GATV_RD(r, u, g) do { unsigned a0_ = apx ^ (32u * (g)); asm volatile("" : "+v"(a0_));        \
            GATV_TR(r[0], a0_, (u) * 4096); GATV_TR(r[1], a0_, (u) * 4096 + 2048); } while (0)
#define GATV_WAIT(r, n) asm volatile("s_waitcnt lgkmcnt(" #n ")" : "+v"(r[0]), "+v"(r[1]) :: "memory")
#define GATV_MM(r, u, g, au) do { const i32x4 b_ = {(int)r[0].x, (int)r[0].y, (int)r[1].x, (int)r[1].y}; \
            acc[g] = __builtin_amdgcn_mfma_scale_f32_16x16x128_f8f6f4(GAT_A8(au), GAT_A8(b_), (u) == 0 ? (f32x4){0.f, 0.f, 0.f, 0.f} : acc[g], 4, 4, 0, sA, 0, s127); } while (0)
#define GATV_UNIT(u, aq, d0, d1, soffn) { asm volatile("s_waitcnt vmcnt(12)" ::: "memory"); \
            GATV_RD(ra, u, 0); GATV_RD(rb, u, 1); GATV_RD(rc, u, 2); GATV_RD(rd, u, 3); const i32x4 au_ = {(int)aq[u].x, (int)aq[u].y, (int)aq[u].z, (int)aq[u].w}; \
            GATV_WAIT(ra, 6); GATV_MM(ra, u, 0, au_); GATV_WAIT(rb, 4); GATV_MM(rb, u, 1, au_); GATV_WAIT(rc, 2); GATV_MM(rc, u, 2, au_); GATV_WAIT(rd, 0); GATV_MM(rd, u, 3, au_); \
            __builtin_amdgcn_sched_barrier(0); GATV_DMA(u, d0, d1, soffn); __builtin_amdgcn_sched_barrier(0); }
#define GATV_STEP(q, qn, cc, ccn, in0, in1) { GATV_IDS(in0, in1, qn); v4u aq_[4]; GATV_ACT(aq_, q); \
            GATV_UNIT(0, aq_, in0, in1, (ccn) * CHUNK_STRIDE) GATV_UNIT(1, aq_, in0, in1, (ccn) * CHUNK_STRIDE) GATV_UNIT(2, aq_, in0, in1, (ccn) * CHUNK_STRIDE) GATV_UNIT(3, aq_, in0, in1, (ccn) * CHUNK_STRIDE) \
            { float o_[4]; _Pragma("unroll") for (int g_ = 0; g_ < 4; ++g_) o_[g_] = ((acc[g_].x + acc[g_].y) + acc[g_].z) * osc[q]; \
              __builtin_amdgcn_raw_buffer_store_b64((v2u){pg8::cvt_pk_bf16(o_[0], o_[1]), pg8::cvt_pk_bf16(o_[2], o_[3])}, rsy, sto, (gw + (q) * NGW) * (D * 2) + (cc) * 512, 0); } \
            __builtin_amdgcn_sched_barrier(0); }
        f32x4 acc[4]; v2u ra[2], rb[2], rc[2], rd[2];
        const int sto = (lv & 15) * 32 + kbv * 8;
        GATV_IDS(idn0, idn1, 0);
        GATV_DMA(0, idn0, idn1, 0); GATV_DMA(1, idn0, idn1, 0); GATV_DMA(2, idn0, idn1, 0); GATV_DMA(3, idn0, idn1, 0);
#pragma nounroll
        for (int c = 0; c < 8; ++c) {
            const int cn = c < 7 ? c + 1 : 7;
            GATV_STEP(0, 1, c, c, idn0, idn1) GATV_STEP(1, 2, c, c, idn0, idn1) GATV_STEP(2, 3, c, c, idn0, idn1) GATV_STEP(3, 4, c, c, idn0, idn1)
            GATV_STEP(4, 5, c, c, idn0, idn1) GATV_STEP(5, 6, c, c, idn0, idn1) GATV_STEP(6, 7, c, c, idn0, idn1) GATV_STEP(7, 0, c, cn, idn0, idn1)
        }
    }
    asm volatile("s_waitcnt vmcnt(0)" ::: "memory");
    __builtin_amdgcn_fence(__ATOMIC_ACQUIRE, "agent");
#pragma nounroll
    for (int k = 0; k < 2; ++k) { int zz = 0; asm volatile("" : "+s"(zz));
        const int ll = __builtin_amdgcn_mbcnt_hi(-1, __builtin_amdgcn_mbcnt_lo(-1, zz));
        ln_res_rows<4>(xres, (const bf16*)ybuf, lng, lnb, of, ob, o8, sx8, (size_t)(gw + 4 * k * NGW) * D, (size_t)NGW * D, ll); }
}

template <int W> __device__ __forceinline__ void pool_item(const GAS v4u* hp, GAS v4u* op, int pos0) {
    constexpr int NR = 7 + W;
    v4u r[NR];
    const bool head = pos0 == 0;
#pragma unroll
    for (int k = 0; k < NR; ++k) { const int rel = k - (W - 1);
        const bool ok = rel >= 0 || (!head && (pos0 + rel >= 0));
        r[k] = ok ? hp[(long)rel * (D / 8)] : (v4u){0u, 0u, 0u, 0u}; }
    float run[8];
#pragma unroll
    for (int e = 0; e < 8; ++e) run[e] = 0.f;
#pragma unroll
    for (int k = 0; k < W - 1; ++k) { run[0] += bflo(r[k].x); run[1] += bfhi(r[k].x); run[2] += bflo(r[k].y); run[3] += bfhi(r[k].y); run[4] += bflo(r[k].z); run[5] += bfhi(r[k].z); run[6] += bflo(r[k].w); run[7] += bfhi(r[k].w); }
#pragma unroll
    for (int i = 0; i < 8; ++i) { const v4u c = r[W - 1 + i];
        const float cv[8] = {bflo(c.x), bfhi(c.x), bflo(c.y), bfhi(c.y), bflo(c.z), bfhi(c.z), bflo(c.w), bfhi(c.w)};
#pragma unroll
        for (int e = 0; e < 8; ++e) run[e] += cv[e];
        const int pos = pos0 + i; const int cnt = pos + 1 < W ? pos + 1 : W; const float ic = 1.0f / (float)cnt;
        v4u o; o.x = pk2(run[0] * ic - cv[0], run[1] * ic - cv[1]); o.y = pk2(run[2] * ic - cv[2], run[3] * ic - cv[3]); o.z = pk2(run[4] * ic - cv[4], run[5] * ic - cv[5]); o.w = pk2(run[6] * ic - cv[6], run[7] * ic - cv[7]);
        op[(long)i * (D / 8)] = o;
        const v4u d = r[i];
        run[0] -= bflo(d.x); run[1] -= bfhi(d.x); run[2] -= bflo(d.y); run[3] -= bfhi(d.y); run[4] -= bflo(d.z); run[5] -= bfhi(d.z); run[6] -= bflo(d.w); run[7] -= bfhi(d.w); }
}

#ifndef PHMASK
#define PHMASK 0xFFFFFFFFu
#endif
#define PHON(k) ((PHMASK >> (k)) & 1u)
#define x_in KARG(const float*, 0)
#define a_w_in KARG(const float*, 8)
#define a_b_in KARG(const float*, 16)
#define a_v_g KARG(const float*, 24)
#define a_v_b KARG(const float*, 32)
#define a_w_s KARG(const float*, 40)
#define a_b_s KARG(const float*, 48)
#define a_w_out KARG(const float*, 56)
#define b_w_in KARG(const float*, 64)
#define b_w_grp KARG(const float*, 72)
#define b_b_grp KARG(const float*, 80)
#define b_scale KARG(const float*, 88)
#define b_w_out KARG(const float*, 96)
#define ln_mix_g KARG(const float*, 104)
#define ln_mix_b KARG(const float*, 112)
#define ln_ffn_g KARG(const float*, 120)
#define ln_ffn_b KARG(const float*, 128)
#define peer_wq KARG(const float*, 136)
#define peer_sk KARG(const float*, 144)
#define peer_u KARG(const float*, 152)
#define peer_v KARG(const float*, 160)
#define W1I ((unsigned char*)(ws + WS_W1T))
#define XI0 ((unsigned char*)(ws + WS_XF))
#define SX0 ((float*)(ws + WS_SX0))
#define W2F ((unsigned char*)(ws + WS_W2T))
#define GF ((unsigned char*)(ws + WS_X1))
#define BINI ((unsigned char*)(ws + WS_BINT))
#define BOUTF ((unsigned char*)(ws + WS_BOUTT))
#define MIXED8 ((unsigned char*)(ws + WS_MIXED))
#define WQB ((bf16*)(ws + WS_WQT))
#define WQS ((bf16*)(ws + WS_WQS))
#define WQSI ((unsigned char*)(ws + WS_WQT))
#define SW ((float*)(ws + WS_SV + 131072))
#define BGT ((bf16*)(ws + WS_BGT))
#define BD ((bf16*)(ws + WS_BD))
#define BDSK ((bf16*)(ws + WS_BDSK))
#define XB ((bf16*)(ws + WS_XB))
#define UT ((unsigned char*)(ws + WS_UT))
#define SU ((float*)(ws + WS_SU))
#define SV ((float*)(ws + WS_SV))
#define VTAB ((unsigned char*)(ws + WS_VTAB))
#define UG ((bf16*)(ws + WS_UG))
#define ST ((float*)(ws + WS_ST))
#define POOL ((bf16*)(ws + WS_POOL))
#define MIXED ((bf16*)(ws + WS_MIXED))
#define VT ((bf16*)(ws + WS_VT))
#define Q ((bf16*)(ws + WS_Q))
#define X8H ((unsigned char*)(ws + WS_Q))
#define H ((bf16*)(ws + WS_H))
#define Y ((float*)(ws + WS_Y))
#define X1 ((float*)(ws + WS_X1))
#define EIDX ((int*)(ws + WS_EIDX))
#define GATE ((float*)(ws + WS_GATE))
struct Args { const float* in[21]; float* out; unsigned char* ws; int ph_lo, ph_hi; };
__global__ void __launch_bounds__(NTHREADS, 2) mega_fwd(Args args) {
    extern __shared__ __attribute__((aligned(16))) unsigned char lds_raw[];
    LAS unsigned char* lds = (LAS unsigned char*)lds_raw;
    volatile LAS unsigned* MISC = (volatile LAS unsigned*)(lds + MISC_OFF);
    typedef const char __attribute__((address_space(4)))* kap_t;
#define KARG(T, off) (*(T const __attribute__((address_space(4)))*)(ka + (off)))
#define PH_BEGIN kap_t ka = (kap_t)__builtin_amdgcn_kernarg_segment_ptr(); asm volatile("" : "+s"(ka)); unsigned char* ws = KARG(unsigned char*, 176); asm volatile("" : "+s"(ws));
#define OUT_PTR KARG(float*, 168)
#define IDX_BEGIN int bx = blockIdx.x, G = gridDim.x, wave = wave0, zero = 0; asm volatile("" : "+s"(bx), "+s"(G), "+s"(wave), "+s"(zero)); \
        const int lane = __builtin_amdgcn_mbcnt_hi(-1, __builtin_amdgcn_mbcnt_lo(-1, zero)), tid = wave * 64 + lane; \
        const int vcu = (G % 8 == 0) ? (bx % 8) * (G / 8) + bx / 8 : bx; const int gw = vcu * NWAVES + wave, NGW = G * NWAVES; (void)tid; (void)gw; (void)NGW; (void)vcu; (void)lane;
    for (int u = threadIdx.x; u < (LDS_BYTES - LDSCTL_OFF) / 4; u += NTHREADS) ((LAS unsigned*)(lds + LDSCTL_OFF))[u] = 0u;
    __syncthreads();
    int lo, hi; unsigned xcc; const int wave0 = __builtin_amdgcn_readfirstlane(threadIdx.x >> 6);
    { PH_BEGIN; lo = KARG(int, 184); hi = KARG(int, 188);
      xcc = xb_xcc_id();
      if (!MK_PER_PHASE && threadIdx.x == 0) (void)xb_add((unsigned*)(ws + WS_CTL) + CW_BAR + XB_XCNT(xcc), 1u); }
#pragma nounroll
    for (int ph = lo; ph < hi; ++ph) {
        const int ly = ph >= 13 ? 1 : 0;
        const int pk = ph >= 17 ? 14 : (ph >= 13 ? ph - 8 : ph);
#ifdef RPT_MASK
        for (int rep = 0; rep < (((RPT_MASK >> ph) & 1u) ? 2 : 1); ++rep)
#endif
        switch (pk) {
        case 0: if (PHON(0)) { PH_BEGIN; IDX_BEGIN;
            LAS float* scr = (LAS float*)(lds + RING_OFF + wave * 16384);
            constexpr int I_W1 = (D / 64) * (FFA / 32), I_W2 = (HA / 64) * (D / 32), I_SQ = (D / 64) * (D / 32), I_G = (512 / 64) * (512 / 32);
            constexpr int NITEMS = I_W1 + I_W2 + 2 * I_SQ + 4 * I_G;
            for (int it = gw; it < NITEMS; it += NGW) {
                int r = it;
                if (r < I_W1) { p0_transpose_item8<true>(a_w_in, D, FFA, W1I, W1_SCALE, scr, r, lane); continue; } r -= I_W1;
                if (r < I_W2) { p0_transpose_item8<false>(a_w_out, HA, D, W2F, W2_SCALE, scr, r, lane); continue; } r -= I_W2;
                if (r < I_SQ) { p0_transpose_item8<true>(b_w_in, D, D, BINI, W1_SCALE, scr, r, lane); continue; } r -= I_SQ;
                if (r < I_SQ) { p0_transpose_item8<false>(b_w_out, D, D, BOUTF, W2_SCALE, scr, r, lane); continue; } r -= I_SQ;
                { const int g = r / I_G; p0_transpose_item(b_w_grp + (size_t)g * 512 * 512, 512, 512, BGT + (size_t)g * 512 * 512, scr, r % I_G, lane); }
            }
            for (int m = gw; m < M_TOK; m += 4 * NGW) rows_to_i8<4>(x_in, XI0, SX0, m, NGW, lane);
            p0_convert(peer_wq, WQB, 2 * D * D / 512, gw, NGW, lane);
            for (int r = gw; r < 2 * NEXP; r += 2 * NGW) { const int r1 = r + NGW, la = r >= NEXP ? 1 : 0, lb = r1 >= NEXP ? 1 : 0;
                const float* const s2[2] = {peer_u + (size_t)r * D, peer_u + (size_t)r1 * D}; unsigned char* const d2[2] = {UT + (size_t)la * NEXP * (D / 2), UT + (size_t)lb * NEXP * (D / 2)};
                const int e2[2] = {r - la * NEXP, r1 - lb * NEXP}; float* const c2[2] = {SU + r, SU + r1};
                p0_row_fp4<2>(s2, d2, e2, c2, lane); }
            for (int r = gw; r < 2 * NEXP; r += 2 * NGW) { const int r1 = r + NGW, la = r >= NEXP ? 1 : 0, lb = r1 >= NEXP ? 1 : 0;
                const float* const s2[2] = {peer_v + (size_t)r * D, peer_v + (size_t)r1 * D}; unsigned char* const d2[2] = {VTAB + (size_t)la * NEXP * (D / 2), VTAB + (size_t)lb * NEXP * (D / 2)};
                const int e2[2] = {r - la * NEXP, r1 - lb * NEXP}; float* const c2[2] = {SV + r, SV + r1};
                p0_row_fp4t<2>(s2, d2, e2, c2, (LAS unsigned char*)scr, lane); }
            for (int i0 = gw * 64 + lane; i0 < NGA * 65536; i0 += 8 * NGW * 64) { float wv[8];
#pragma unroll
                for (int k = 0; k < 8; ++k) { int i = i0 + k * NGW * 64; i = i < NGA * 65536 ? i : NGA * 65536 - 1; const int h = i >> 16, t = (i >> 8) & 127, s = i & 127;
                    wv[k] = ((const GAS float*)a_w_s)[(h * 128 + t) * 128 + s]; }
                asm volatile("" : "+v"(wv[0]), "+v"(wv[1]), "+v"(wv[2]), "+v"(wv[3]), "+v"(wv[4]), "+v"(wv[5]), "+v"(wv[6]), "+v"(wv[7]));
#pragma unroll
                for (int k = 0; k < 8; ++k) { const int i = i0 + k * NGW * 64; const int tp = (i >> 8) & 255, sp = i & 255;
                    const float v = ((tp >> 7) == (sp >> 7) && (sp & 127) <= (tp & 127)) ? wv[k] : 0.f; if (i < NGA * 65536) ((GAS bf16*)BD)[i] = (bf16)f2bf(v); } }
            for (int i = gw * 64 + lane; i < 2 * 65536; i += NGW * 64) { const int l2 = i >> 16, r = (i >> 8) & 255, c = i & 255;
                const float kv = ((const GAS float*)peer_sk)[((l2 * 2 + (r >> 7)) * 128 + (r & 127)) * 128 + (c & 127)];
                const float v = ((r >> 7) == (c >> 7)) ? kv : 0.f; ((GAS bf16*)BDSK)[i] = (bf16)f2bf(v); }
        } break;
        case 1: if (PHON(1)) { PH_BEGIN; IDX_BEGIN;
            { pg8::AddrScores g{BDSK, WQB, 256, D, 256}; pg8::StaticOrder S; S.init(2 * D, D, G, bx); pg8::EpiBf16<0> E{WQS, D, nullptr, nullptr, nullptr};
              pg8::gemm_phase<pg8::EpiBf16<0>, pg8::AddrScores, pg8::StaticOrder, true, true>(lds + RING_OFF, g, S, E, tid); }
#ifdef G1_STAGGER
            { const int xs_ = (int)(xcc & 7u); for (int s_ = 0; s_ < xs_ * G1_STAGGER; ++s_) __builtin_amdgcn_s_sleep(75); }
#endif
            { pg8::AddrPlain8 g{XI0, W1I, D, D, D}; pg8::StaticOrder S; S.init(M_TOK, HA, G, bx); pg8::EpiGeluFp8 E{(unsigned char*)UG, HA, a_b_in, SX0, 1.0f / W1_SCALE, U_SCALE};
              pg8::gemm_phase<pg8::EpiGeluFp8, pg8::AddrPlain8, pg8::StaticOrder, true, true, 2>(lds + RING_OFF, g, S, E, tid); }
            { pg8::AddrPlain8 g{W1I + (size_t)HA * D, XI0, D, D, D}; pg8::StaticOrder S; S.init(HA, M_TOK, G, bx); pg8::EpiBf16<1, true> E{VT, M_TOK, nullptr, a_b_in + HA, nullptr, 1.0f / W1_SCALE, nullptr, SX0};
              pg8::gemm_phase<pg8::EpiBf16<1, true>, pg8::AddrPlain8, pg8::StaticOrder, true, true, 2>(lds + RING_OFF, g, S, E, tid); }
        } break;
        case 2: if (PHON(2)) { PH_BEGIN; IDX_BEGIN;
            for (int r = gw; r < 2 * D; r += 2 * NGW) rows_bf16_to_i8<2>(WQS, WQSI, SW, r, NGW, lane);
            LAS float* red = (LAS float*)(lds + RING_OFF);
            LAS float* stat = red + 64 * 64 * 2;
            const int rg = tid >> 3, j8 = tid & 7;
            for (int tb = vcu; tb < M_TOK / 64; tb += G) {
                const int t0 = tb * 64;
                float s[8], q[8];
#pragma unroll
                for (int e = 0; e < 8; ++e) { s[e] = 0.f; q[e] = 0.f; }
#pragma unroll 16
                for (int i = 0; i < 64; ++i) { const v4u w = *(const GAS v4u*)(VT + (size_t)(rg + 64 * i) * M_TOK + t0 + 8 * j8);
                    const float f[8] = {bflo(w.x), bfhi(w.x), bflo(w.y), bfhi(w.y), bflo(w.z), bfhi(w.z), bflo(w.w), bfhi(w.w)};
#pragma unroll
                    for (int e = 0; e < 8; ++e) { s[e] += f[e]; q[e] += f[e] * f[e]; } }
#pragma unroll
                for (int e = 0; e < 8; ++e) { red[(rg * 64 + 8 * j8 + e) * 2] = s[e]; red[(rg * 64 + 8 * j8 + e) * 2 + 1] = q[e]; }
                __syncthreads();
                if (tid < 128) { const int tok = tid & 63, wh = tid >> 6; float a = 0.f;
                    for (int r = 0; r < 64; ++r) a += red[(r * 64 + tok) * 2 + wh];
                    stat[tok * 2 + wh] = a; }
                __syncthreads();
                float mu[8], rs[8]; float inv_ha = 1.f / HA; asm volatile("" : "+v"(inv_ha));
#pragma unroll
                for (int e = 0; e < 8; ++e) { const float m = stat[(8 * j8 + e) * 2] * inv_ha; const float var = stat[(8 * j8 + e) * 2 + 1] * inv_ha - m * m; mu[e] = m; rs[e] = 1.f / sqrtf(fmaxf(var, 0.f) + LN_EPS); }
#pragma unroll 8
                for (int i = 0; i < 64; ++i) { const int c = rg + 64 * i; GAS v4u* p = (GAS v4u*)(VT + (size_t)c * M_TOK + t0 + 8 * j8); const v4u w = *p; const float gg = a_v_g[c], bb = a_v_b[c];
                    const float f[8] = {bflo(w.x), bfhi(w.x), bflo(w.y), bfhi(w.y), bflo(w.z), bfhi(w.z), bflo(w.w), bfhi(w.w)}; float o[8];
#pragma unroll
                    for (int e = 0; e < 8; ++e) o[e] = (f[e] - mu[e]) * rs[e] * gg + bb;
                    v4u ow; ow.x = pk2(o[0], o[1]); ow.y = pk2(o[2], o[3]); ow.z = pk2(o[4], o[5]); ow.w = pk2(o[6], o[7]); *p = ow; }
                __syncthreads();
            }
        } break;
        case 3: if (PHON(3)) { PH_BEGIN; IDX_BEGIN;
            pg8::AddrSpatial g{BD, VT, 256, M_TOK, 256}; pg8::StaticOrder S; S.init(M_TOK, HA, G, bx); pg8::EpiGate8 E{(const unsigned char*)UG, GF, HA, a_b_s, G_SCALE / U_SCALE};
            pg8::gemm_phase<pg8::EpiGate8, pg8::AddrSpatial, pg8::StaticOrder, true, true>(lds + RING_OFF, g, S, E, tid);
        } break;
        case 4: if (PHON(4)) { PH_BEGIN; IDX_BEGIN;
            pg8::AddrPlain8 g{GF, W2F, HA, HA, HA}; pg8::StaticOrder S; S.init(M_TOK, D, G, bx); pg8::EpiRes<false> E{(bf16*)Y, x_in, D, ALPHA, 1.0f / (G_SCALE * W2_SCALE)};
            pg8::gemm_phase<pg8::EpiRes<false>, pg8::AddrPlain8, pg8::StaticOrder, true, true, 1>(lds + RING_OFF, g, S, E, tid);
        } break;
        case 5: if (PHON(5)) { PH_BEGIN; IDX_BEGIN;
            for (int m = gw; m < M_TOK; m += 4 * NGW) ln_rows<4>((const bf16*)Y, ln_mix_g + ly * D, ln_mix_b + ly * D, XB, X8H, XI0, SX0, m, NGW, lane);
        } break;
        case 6: if (PHON(6)) { PH_BEGIN; IDX_BEGIN;
            pg8::AddrPlain8 g{WQSI + (size_t)ly * D * D, XI0, D, D, D}; pg8::StaticOrder S; S.init(D, M_TOK, G, bx); pg8::EpiBf16<0, true> E{(bf16*)ST, M_TOK, nullptr, nullptr, nullptr, 1.0f, SW + ly * D, SX0};
            pg8::gemm_phase<pg8::EpiBf16<0, true>, pg8::AddrPlain8, pg8::StaticOrder, true, true, 2>(lds + RING_OFF, g, S, E, tid);
        } break;
        case 7: if (PHON(7)) { PH_BEGIN; IDX_BEGIN;
            for (int it = gw; it < (M_TOK / 64) * HEADS; it += NGW) { const int h = it & 7, t = (it >> 3) * 64 + lane; topk_lane((const bf16*)ST, h, t, EIDX, GATE); }
        } break;
        case 8: if (PHON(8)) { PH_BEGIN; IDX_BEGIN;
            const unsigned char* ut = UT + (size_t)ly * NEXP * (D / 2); const unsigned char* vt = VTAB + (size_t)ly * NEXP * (D / 2);
            peer_chunked(ut, vt, SU + ly * NEXP, SV + ly * NEXP, EIDX, GATE, XB, X8H, Y, ln_ffn_g + ly * D, ln_ffn_b + ly * D, ly == 0 ? nullptr : OUT_PTR, ly == 0 ? XB : nullptr, ly == 0 ? XI0 : nullptr, SX0, gw, NGW, (LAS unsigned*)(lds + RING_OFF + wave * 16384), (LAS unsigned*)(lds + IDS16_OFF + wave * IDS16_WAVE));
        } break;
        case 9: if (PHON(9)) { PH_BEGIN; IDX_BEGIN;
            pg8::AddrPlain8 g{XI0, BINI, D, D, D}; pg8::StaticOrder S; S.init(M_TOK, D, G, bx); pg8::EpiBf16<0, true> E{H, D, nullptr, nullptr, nullptr, 1.0f / W1_SCALE, SX0, nullptr};
            pg8::gemm_phase<pg8::EpiBf16<0, true>, pg8::AddrPlain8, pg8::StaticOrder, true, true, 2>(lds + RING_OFF, g, S, E, tid);
        } break;
        case 10: if (PHON(10)) { PH_BEGIN; IDX_BEGIN;
            for (int it = gw; it < (M_TOK / 8) * 4; it += NGW) { const int t0 = (it >> 2) * 8, qd = it & 3, pos0 = t0 & (SEQ - 1);
                const GAS v4u* hp = (const GAS v4u*)(H + (size_t)t0 * D + qd * 512) + lane;
                if (qd == 0) pool_item<2>(hp, (GAS v4u*)(POOL + (size_t)t0 * D + qd * 512) + lane, pos0);
                else if (qd == 1) pool_item<4>(hp, (GAS v4u*)(POOL + (size_t)t0 * D + qd * 512) + lane, pos0);
                else if (qd == 2) pool_item<8>(hp, (GAS v4u*)(POOL + (size_t)t0 * D + qd * 512) + lane, pos0);
                else pool_item<16>(hp, (GAS v4u*)(POOL + (size_t)t0 * D + qd * 512) + lane, pos0); }
        } break;
        case 11: if (PHON(11)) { PH_BEGIN; IDX_BEGIN;
            pg8::AddrGrouped g{POOL, BGT, D, 512, 512}; pg8::StaticOrder S; S.init(M_TOK, D, G, bx); pg8::EpiFp8 E{MIXED8, D, b_b_grp, b_scale, M_SCALE};
            pg8::gemm_phase<pg8::EpiFp8, pg8::AddrGrouped, pg8::StaticOrder, true, true>(lds + RING_OFF, g, S, E, tid);
        } break;
#ifdef PROBE_L2
        case 14: { PH_BEGIN; IDX_BEGIN;
            peer_chunked(UT, VTAB, SU, SV, EIDX, GATE, XB, X8H, Y, ln_ffn_g, ln_ffn_b, nullptr, nullptr, nullptr, nullptr, gw, NGW, (LAS unsigned*)(lds + RING_OFF + wave * 16384), (LAS unsigned*)(lds + IDS16_OFF + wave * IDS16_WAVE), PROBE_L2);
        } break;
#endif
        default: if (PHON(12)) { PH_BEGIN; IDX_BEGIN;
            pg8::AddrPlain8 g{MIXED8, BOUTF, D, D, D}; pg8::StaticOrder S; S.init(M_TOK, D, G, bx); pg8::EpiRes<true> E{(bf16*)Y, XB, D, ALPHA, 1.0f / (M_SCALE * W2_SCALE)};
            pg8::gemm_phase<pg8::EpiRes<true>, pg8::AddrPlain8, pg8::StaticOrder, true, true, 1>(lds + RING_OFF, g, S, E, tid);
        } break;
        }
        if (ph + 1 < hi) { PH_BEGIN; unsigned xl = xcc; int w2 = wave0, z2 = 0; asm volatile("" : "+s"(xl), "+s"(w2), "+s"(z2));
            const int tidb = w2 * 64 + __builtin_amdgcn_mbcnt_hi(-1, __builtin_amdgcn_mbcnt_lo(-1, z2));
            XcdBarrier bar; bar.bar = (unsigned*)(ws + WS_CTL) + CW_BAR; bar.x = xl; bar.st = MISC + 8; xcd_barrier(bar, tidb); }
    }
}

extern "C" void kernel_launch(void* const* d_in, const int* in_sizes, int n_in, void* d_out, int out_size, void* d_ws, size_t ws_size, hipStream_t stream) {
    static int grid = 0;
    if (grid == 0) {
        if (n_in != 21 || out_size != M_TOK * D || ws_size < WS_END) { fprintf(stderr, "kernel_launch: unexpected problem (n_in %d, out %d, ws %zu)\n", n_in, out_size, ws_size); grid = -1; return; }
        int dev = 0, cus = 0, per_cu = 0;
        if (hipGetDevice(&dev) != hipSuccess || hipDeviceGetAttribute(&cus, hipDeviceAttributeMultiprocessorCount, dev) != hipSuccess) { grid = -1; return; }
        if (hipFuncSetAttribute((const void*)mega_fwd, hipFuncAttributeMaxDynamicSharedMemorySize, LDS_BYTES) != hipSuccess) { fprintf(stderr, "kernel_launch: hipFuncSetAttribute failed\n"); grid = -1; return; }
        if (hipOccupancyMaxActiveBlocksPerMultiprocessor(&per_cu, (const void*)mega_fwd, NTHREADS, LDS_BYTES) != hipSuccess || per_cu < 1) { fprintf(stderr, "kernel_launch: occupancy query says %d blocks per CU\n", per_cu); (void)hipGetLastError(); }
        grid = cus;
    }
    if (grid < 0) return;
    if (hipMemsetAsync((char*)d_ws + WS_CTL, 0, CTL_ZERO_BYTES, stream) != hipSuccess) return;
    Args a{};
    for (int i = 0; i < 21; ++i) a.in[i] = (const float*)d_in[i];
    a.out = (float*)d_out; a.ws = (unsigned char*)d_ws;
#if MK_PER_PHASE
    for (int p = 0; p < N_PHASES; ++p) { a.ph_lo = p; a.ph_hi = p + 1; hipLaunchKernelGGL(mega_fwd, dim3(grid), dim3(NTHREADS), LDS_BYTES, stream, a); }
#else
    a.ph_lo = 0; a.ph_hi = N_PHASES;
#ifdef PROBE_L2
    a.ph_hi = N_PHASES + 1;
#endif
    hipLaunchKernelGGL(mega_fwd, dim3(grid), dim3(NTHREADS), LDS_BYTES, stream, a);
#endif
}
```
